# Optimizing an MI355X kernel written in HIP

```python
import math
import jax
import jax.numpy as jnp
from jax import lax
import numpy as np

D_MODEL = 1024
BATCH = 8
SEQ = 2048
DEPTH = 2

N_A_LAYERS = DEPTH // 2
N_B_LAYERS = DEPTH - N_A_LAYERS
SSM_WIDTH = D_MODEL
GROUP = 16
N_GROUPS = SSM_WIDTH // GROUP
STATE = 64
DT_MIN = 1e-3
DT_MAX = 1e-1
N_HEADS = 16
HEAD_DIM = D_MODEL // N_HEADS
ATTN_WIDTH = N_HEADS * HEAD_DIM
Q_BLOCK = 128
EPS = 1e-6

kernel_name = "yoco_s5_fox_adaln_hybrid"


def _rms(x, g):
    xf = x.astype(jnp.float32)
    y = xf * lax.rsqrt(jnp.mean(xf * xf, axis=-1, keepdims=True) + EPS)
    return (y * g.astype(jnp.float32)).astype(x.dtype)


def _modulation(c, w, b, n):
    m = jax.nn.silu(c) @ w + b
    return jnp.split(m[:, None, :], n, axis=-1)


def _cplx_combine(e1, e2):
    a1r, a1i, b1r, b1i = e1
    a2r, a2i, b2r, b2i = e2
    ar = a1r * a2r - a1i * a2i
    ai = a1r * a2i + a1i * a2r
    br = a2r * b1r - a2i * b1i + b2r
    bi = a2r * b1i + a2i * b1r + b2i
    return (ar, ai, br, bi)


def _s5_mixer(h, w_in, log_dt, A_re, A_im, B_re, B_im, C_re, C_im, D, w_glu, b_glu, w_out):
    bsz, L, _ = h.shape
    u, z = jnp.split(h @ w_in, 2, axis=-1)
    f32 = jnp.float32
    dt = jnp.exp(log_dt.astype(f32))[:, None]
    ar, ai = A_re.astype(f32), A_im.astype(f32)
    mag = jnp.exp(ar * dt)
    abar_r, abar_i = mag * jnp.cos(ai * dt), mag * jnp.sin(ai * dt)
    den = ar * ar + ai * ai
    nr = abar_r - 1.0
    coef_r = (nr * ar + abar_i * ai) / den
    coef_i = (abar_i * ar - nr * ai) / den
    br, bi = B_re.astype(f32), B_im.astype(f32)
    bb_r = coef_r[..., None] * br - coef_i[..., None] * bi
    bb_i = coef_r[..., None] * bi + coef_i[..., None] * br
    ug = u.astype(f32).reshape(bsz, L, N_GROUPS, GROUP)
    bu_r = jnp.einsum('blgc,gpc->blgp', ug, bb_r)
    bu_i = jnp.einsum('blgc,gpc->blgp', ug, bb_i)
    a_r = jnp.broadcast_to(abar_r[None, None], (1, L, N_GROUPS, STATE))
    a_i = jnp.broadcast_to(abar_i[None, None], (1, L, N_GROUPS, STATE))
    _, _, s_r, s_i = lax.associative_scan(_cplx_combine, (a_r, a_i, bu_r, bu_i), axis=1)
    y = (jnp.einsum('blgp,gcp->blgc', s_r, C_re.astype(f32))
         - jnp.einsum('blgp,gcp->blgc', s_i, C_im.astype(f32)))
    y = y.reshape(bsz, L, SSM_WIDTH) + D.astype(f32) * u.astype(f32)
    y = jax.nn.gelu(y)
    y = y * jax.nn.sigmoid(y @ w_glu.astype(f32) + b_glu.astype(f32))
    y = y * jax.nn.silu(z.astype(f32))
    return y.astype(h.dtype) @ w_out


def _head_rms(t, g):
    tf = t.astype(jnp.float32)
    return tf * lax.rsqrt(jnp.mean(tf * tf, axis=-1, keepdims=True) + EPS) * g.astype(jnp.float32)


def _shared_kv(x, c, g, mod_w, mod_b, kv_w, f_bias, k_norm_g):
    bsz, L, _ = x.shape
    shift, scale = _modulation(c, mod_w, mod_b, 2)
    h = _rms(x, g) * (1.0 + scale) + shift
    kvf = h @ kv_w
    k = kvf[..., :ATTN_WIDTH].reshape(bsz, L, N_HEADS, HEAD_DIM)
    v = kvf[..., ATTN_WIDTH:2 * ATTN_WIDTH].reshape(bsz, L, N_HEADS, HEAD_DIM)
    f_logit = kvf[..., 2 * ATTN_WIDTH:].astype(jnp.float32) + f_bias.astype(jnp.float32)
    k = _head_rms(k, k_norm_g)
    F = jnp.cumsum(jax.nn.log_sigmoid(f_logit), axis=1)
    return k, v, F


def _fox_mixer(h, k, v, F, w_in, q_norm_g, w_out):
    bsz, L, _ = h.shape
    nblk = L // Q_BLOCK
    q, z = jnp.split(h @ w_in, 2, axis=-1)
    q = _head_rms(q.reshape(bsz, L, N_HEADS, HEAD_DIM), q_norm_g) * (HEAD_DIM ** -0.5)
    qb = q.reshape(bsz, nblk, Q_BLOCK, N_HEADS, HEAD_DIM).transpose(1, 0, 3, 2, 4)
    fq = F.reshape(bsz, nblk, Q_BLOCK, N_HEADS).transpose(1, 0, 3, 2)
    kt = k.transpose(0, 2, 1, 3)
    vt = v.astype(jnp.float32).transpose(0, 2, 1, 3)
    fk = F.transpose(0, 2, 1)
    kpos = jnp.arange(L)

    def one_block(args):
        qi, fqi, i = args
        s = jnp.einsum('bhqd,bhkd->bhqk', qi, kt)
        s = s + fqi[..., None] - fk[:, :, None, :]
        qpos = i * Q_BLOCK + jnp.arange(Q_BLOCK)
        s = jnp.where(kpos[None, :] <= qpos[:, None], s, -jnp.inf)
        p = jax.nn.softmax(s, axis=-1)
        return jnp.einsum('bhqk,bhkd->bhqd', p, vt)

    o = lax.map(one_block, (qb, fq, jnp.arange(nblk)))
    o = o.transpose(1, 0, 3, 2, 4).reshape(bsz, L, ATTN_WIDTH)
    o = o * jax.nn.silu(z.astype(jnp.float32))
    return o.astype(h.dtype) @ w_out


def setup_inputs(seed: int = 0) -> dict:
    key = jax.random.key(seed)
    ks = iter(jax.random.split(key, 40))
    f32 = jnp.float32

    def nrm(shape, scale):
        return scale * jax.random.normal(next(ks), shape, f32)

    D, E, G, P, NA, NB = D_MODEL, SSM_WIDTH, N_GROUPS, STATE, N_A_LAYERS, N_B_LAYERS
    AW, H = ATTN_WIDTH, N_HEADS
    inp = {}
    inp['x'] = nrm((BATCH, SEQ, D), 1.0)
    inp['c'] = nrm((BATCH, D), 1.0)
    inp['a_norm_g'] = 1.0 + nrm((NA, D), 0.02)
    inp['a_mod_w'] = nrm((NA, D, 3 * D), 0.5 * D ** -0.5)
    inp['a_mod_b'] = nrm((NA, 3 * D), 0.02)
    inp['a_w_in'] = nrm((NA, D, 2 * E), D ** -0.5)
    inp['a_log_dt'] = jax.random.uniform(next(ks), (NA, G), f32, math.log(DT_MIN), math.log(DT_MAX))
    inp['a_A_re'] = -0.5 + nrm((NA, G, P), 0.01)
    inp['a_A_im'] = math.pi * jnp.broadcast_to(jnp.arange(P, dtype=f32), (NA, G, P)) + nrm((NA, G, P), 0.01)
    inp['a_B_re'] = nrm((NA, G, P, GROUP), (2 * GROUP) ** -0.5)
    inp['a_B_im'] = nrm((NA, G, P, GROUP), (2 * GROUP) ** -0.5)
    inp['a_C_re'] = nrm((NA, G, GROUP, P), 0.5)
    inp['a_C_im'] = nrm((NA, G, GROUP, P), 0.5)
    inp['a_D'] = nrm((NA, E), 1.0)
    inp['a_w_glu'] = nrm((NA, E, E), E ** -0.5)
    inp['a_b_glu'] = nrm((NA, E), 0.02)
    inp['a_w_out'] = nrm((NA, E, D), E ** -0.5)
    inp['kv_norm_g'] = 1.0 + nrm((D,), 0.02)
    inp['kv_mod_w'] = nrm((D, 2 * D), 0.5 * D ** -0.5)
    inp['kv_mod_b'] = nrm((2 * D,), 0.02)
    inp['kv_w'] = nrm((D, 2 * AW + H), D ** -0.5)
    inp['kv_f_bias'] = jax.random.uniform(next(ks), (H,), f32, 1.0, 4.0)
    inp['k_norm_g'] = 1.0 + nrm((HEAD_DIM,), 0.02)
    inp['b_norm_g'] = 1.0 + nrm((NB, D), 0.02)
    inp['b_mod_w'] = nrm((NB, D, 3 * D), 0.5 * D ** -0.5)
    inp['b_mod_b'] = nrm((NB, 3 * D), 0.02)
    inp['b_w_in'] = nrm((NB, D, 2 * AW), D ** -0.5)
    inp['q_norm_g'] = 1.0 + nrm((NB, HEAD_DIM), 0.02)
    inp['b_w_out'] = nrm((NB, AW, D), AW ** -0.5)
    return inp


def reference(x, c, a_norm_g, a_mod_w, a_mod_b, a_w_in, a_log_dt, a_A_re, a_A_im,
              a_B_re, a_B_im, a_C_re, a_C_im, a_D, a_w_glu, a_b_glu, a_w_out,
              kv_norm_g, kv_mod_w, kv_mod_b, kv_w, kv_f_bias, k_norm_g,
              b_norm_g, b_mod_w, b_mod_b, b_w_in, q_norm_g, b_w_out):
    k = v = F = None
    for layer in range(DEPTH):
        if layer < N_A_LAYERS:
            i = layer
            shift, scale, gate = _modulation(c, a_mod_w[i], a_mod_b[i], 3)
            h = _rms(x, a_norm_g[i]) * (1.0 + scale) + shift
            y = _s5_mixer(h, a_w_in[i], a_log_dt[i], a_A_re[i], a_A_im[i], a_B_re[i], a_B_im[i],
                          a_C_re[i], a_C_im[i], a_D[i], a_w_glu[i], a_b_glu[i], a_w_out[i])
            x = x + gate * y
        else:
            if layer == N_A_LAYERS:
                k, v, F = _shared_kv(x, c, kv_norm_g, kv_mod_w, kv_mod_b, kv_w, kv_f_bias, k_norm_g)
            j = layer - N_A_LAYERS
            shift, scale, gate = _modulation(c, b_mod_w[j], b_mod_b[j], 3)
            h = _rms(x, b_norm_g[j]) * (1.0 + scale) + shift
            y = _fox_mixer(h, k, v, F, b_w_in[j], q_norm_g[j], b_w_out[j])
            x = x + gate * y
    return x
```

```cpp
#include <hip/hip_runtime.h>
#include <hip/hip_cooperative_groups.h>
#include <cstdio>
#include <cstdint>
namespace cg = cooperative_groups;
namespace pg8 {
#define PG8_LAS __attribute__((address_space(3)))
typedef unsigned short bf16_t;
typedef short bf16x8 __attribute__((ext_vector_type(8)));
typedef float f32x4 __attribute__((ext_vector_type(4)));
typedef unsigned u32x4 __attribute__((ext_vector_type(4)));
constexpr int BM = 256, BK = 64, HALF = 128, HTB = HALF * BK * 2  , STAGE_BYTES = 8 * HTB, NXCD = 8, WGM = 8;

__host__ __device__ __forceinline__ int lds_byte(int r, int c) { const int st = (r >> 4) * 2 + (c >> 5), rr = r & 15, cc = c & 31, ob = rr * 64 + cc * 2; return st * 1024 + (ob ^ (((ob >> 9) & 1) << 5)); }
__host__ __device__ __forceinline__ void stage_rc(int b, int& R, int& C) { const int st = b / 1024, sb = b % 1024, swz = sb ^ (((sb >> 9) & 1) << 5); R = (st >> 1) * 16 + swz / 64; C = (st & 1) * 32 + (swz % 64) / 2; }
__host__ __device__ __forceinline__ int perm32(int rho) { const int n = rho >> 4, i = rho & 15; return 8 * (i >> 2) + 4 * n + (i & 3); }

struct Unit { int pm, pn; };
struct Gemm { const bf16_t* A; const bf16_t* Bt; int M, N, K; };

struct StaticOrder {
    int nM, nN, nwg, G, c;
    __host__ __device__ void init(int M, int N, int G_, int c_) { nM = M / BM; nN = N / BM; nwg = nM * nN; G = G_; c = c_; }
    __host__ __device__ bool next(int i, Unit& u) const {
        const long L = (long)i * G + c; if (L >= nwg) return false;
        int wgid = (int)L; { const int q = nwg / NXCD, r = nwg % NXCD, xcd = wgid % NXCD, off = wgid / NXCD; wgid = (xcd < r ? xcd * (q + 1) : r * (q + 1) + (xcd - r) * q) + off; }
        const int nig = WGM * nN, gid = wgid / nig, fm = gid * WGM, gsz = (nM - fm) < WGM ? (nM - fm) : WGM;
        u.pm = fm + ((wgid % nig) % gsz); u.pn = (wgid % nig) / gsz; return true;
    }
    __device__ __forceinline__ void a_ready(const Unit&) const {}
    __device__ __forceinline__ void done(const Unit&) const {}
};

__device__ __forceinline__ unsigned cvt_pk_bf16(float lo, float hi) { unsigned r; asm volatile("v_cvt_pk_bf16_f32 %0, %1, %2" : "=v"(r) : "v"(lo), "v"(hi)); return r; }
typedef float f32x2 __attribute__((ext_vector_type(2)));
typedef unsigned u32x4e __attribute__((ext_vector_type(4)));
__device__ __forceinline__ float bf_lo(unsigned u) { return __uint_as_float(u << 16); }
__device__ __forceinline__ float bf_hi(unsigned u) { return __uint_as_float(u & 0xffff0000u); }
__device__ __forceinline__ float sigm(float x) { return __builtin_amdgcn_rcpf(1.0f + __builtin_amdgcn_exp2f(-1.4426950408889634f * x)); }
__device__ __forceinline__ u32x4e pack8(const f32x4& a, const f32x4& b) { u32x4e w; w.x = cvt_pk_bf16(a[0], a[1]); w.y = cvt_pk_bf16(a[2], a[3]); w.z = cvt_pk_bf16(b[0], b[1]); w.w = cvt_pk_bf16(b[2], b[3]); return w; }

struct EpiStore {
    static constexpr bool PERM = true, AFTER_DRAIN = false;
    bf16_t* O; int ldc;
    __device__ __forceinline__ void operator()(const f32x4 (&acc)[2][2][4][2], const Unit& u, int wr, int wc, int fr, int fq) const {
        const int row0 = u.pm * BM + wr * 64 + fr, colb = u.pn * BM + wc * 64 + 8 * fq;
#pragma unroll
        for (int ai = 0; ai < 2; ++ai)
#pragma unroll
            for (int m = 0; m < 4; ++m) { bf16_t* rowp = O + (size_t)(row0 + ai * HALF + m * 16) * ldc + colb;
#pragma unroll
                for (int bj = 0; bj < 2; ++bj) *(u32x4e*)(rowp + bj * 32) = pack8(acc[ai][bj][m][0], acc[ai][bj][m][1]); }
    }
};
struct EpiGlu {
    static constexpr bool PERM = true, AFTER_DRAIN = false;
    const bf16_t* Y1; const bf16_t* Z; const float* bias; bf16_t* O;
    __device__ __forceinline__ void operator()(const f32x4 (&acc)[2][2][4][2], const Unit& u, int wr, int wc, int fr, int fq) const {
        const int row0 = u.pm * BM + wr * 64 + fr, colb = u.pn * BM + wc * 64 + 8 * fq;
        f32x4 bv[2][2];
#pragma unroll
        for (int bj = 0; bj < 2; ++bj)
#pragma unroll
            for (int n = 0; n < 2; ++n) bv[bj][n] = *(const f32x4*)(bias + colb + bj * 32 + 4 * n);
#pragma unroll
        for (int ai = 0; ai < 2; ++ai)
#pragma unroll
            for (int m = 0; m < 4; ++m) { const size_t row = (size_t)(row0 + ai * HALF + m * 16);
#pragma unroll
                for (int bj = 0; bj < 2; ++bj) { const int col = colb + bj * 32;
                    const u32x4e yv = *(const u32x4e*)(Y1 + row * 1024 + col), zv = *(const u32x4e*)(Z + row * 2048 + col);
                    f32x4 o0, o1;
#pragma unroll
                    for (int k = 0; k < 2; ++k) { const float g0 = acc[ai][bj][m][0][2 * k] + bv[bj][0][2 * k], g1 = acc[ai][bj][m][0][2 * k + 1] + bv[bj][0][2 * k + 1];
                        const float z0 = bf_lo(zv[k]), z1 = bf_hi(zv[k]);
                        o0[2 * k] = bf_lo(yv[k]) * sigm(g0) * z0 * sigm(z0); o0[2 * k + 1] = bf_hi(yv[k]) * sigm(g1) * z1 * sigm(z1); }
#pragma unroll
                    for (int k = 0; k < 2; ++k) { const float g0 = acc[ai][bj][m][1][2 * k] + bv[bj][1][2 * k], g1 = acc[ai][bj][m][1][2 * k + 1] + bv[bj][1][2 * k + 1];
                        const float z0 = bf_lo(zv[2 + k]), z1 = bf_hi(zv[2 + k]);
                        o1[2 * k] = bf_lo(yv[2 + k]) * sigm(g0) * z0 * sigm(z0); o1[2 * k + 1] = bf_hi(yv[2 + k]) * sigm(g1) * z1 * sigm(z1); }
                    *(u32x4e*)(O + row * 1024 + col) = pack8(o0, o1); } }
    }
};
struct EpiRes {
    static constexpr bool PERM = true, AFTER_DRAIN = false;
    const float* X; const float* gate; float* OUT;
    __device__ __forceinline__ void operator()(const f32x4 (&acc)[2][2][4][2], const Unit& u, int wr, int wc, int fr, int fq) const {
        const int row0 = u.pm * BM + wr * 64 + fr, colb = u.pn * BM + wc * 64 + 8 * fq;
        const float* gp = gate + (size_t)(u.pm >> 3) * 1024 + colb;
        f32x4 gv[2][2];
#pragma unroll
        for (int bj = 0; bj < 2; ++bj)
#pragma unroll
            for (int n = 0; n < 2; ++n) gv[bj][n] = *(const f32x4*)(gp + bj * 32 + 4 * n);
#pragma unroll
        for (int ai = 0; ai < 2; ++ai)
#pragma unroll
            for (int m = 0; m < 4; ++m) { const size_t off = (size_t)(row0 + ai * HALF + m * 16) * 1024 + colb;
#pragma unroll
                for (int bj = 0; bj < 2; ++bj)
#pragma unroll
                    for (int n = 0; n < 2; ++n) { const f32x4 xv = *(const f32x4*)(X + off + bj * 32 + 4 * n);
                        *(f32x4*)(OUT + off + bj * 32 + 4 * n) = xv + gv[bj][n] * acc[ai][bj][m][n]; } }
    }
};
template <bool SILU> struct EpiHeadNorm {
    static constexpr bool PERM = true, AFTER_DRAIN = false;
    bf16_t* O0; bf16_t* O1; const float* g; float scale;
    __device__ __forceinline__ void operator()(const f32x4 (&acc)[2][2][4][2], const Unit& u, int wr, int wc, int fr, int fq) const {
        const int row0 = u.pm * BM + wr * 64 + fr;
        if (u.pn < 4) {
            const int colb = u.pn * BM + wc * 64 + 8 * fq;
            f32x4 gv[2][2];
#pragma unroll
            for (int bj = 0; bj < 2; ++bj)
#pragma unroll
                for (int n = 0; n < 2; ++n) gv[bj][n] = *(const f32x4*)(g + bj * 32 + 8 * fq + 4 * n) * scale;
#pragma unroll
            for (int ai = 0; ai < 2; ++ai)
#pragma unroll
                for (int m = 0; m < 4; ++m) { float s = 0.f;
#pragma unroll
                    for (int bj = 0; bj < 2; ++bj)
#pragma unroll
                        for (int n = 0; n < 2; ++n) { const f32x4 x = acc[ai][bj][m][n]; s += (x[0] * x[0] + x[1] * x[1]) + (x[2] * x[2] + x[3] * x[3]); }
                    s += __shfl_xor(s, 16); s += __shfl_xor(s, 32);
                    const float r = 1.0f / sqrtf(s * (1.0f / 64.0f) + 1e-6f);
                    bf16_t* rowp = O0 + (size_t)(row0 + ai * HALF + m * 16) * 1024 + colb;
#pragma unroll
                    for (int bj = 0; bj < 2; ++bj) *(u32x4e*)(rowp + bj * 32) = pack8(acc[ai][bj][m][0] * r * gv[bj][0], acc[ai][bj][m][1] * r * gv[bj][1]); }
        } else {
            const int colb = (u.pn - 4) * BM + wc * 64 + 8 * fq;
#pragma unroll
            for (int ai = 0; ai < 2; ++ai)
#pragma unroll
                for (int m = 0; m < 4; ++m) { bf16_t* rowp = O1 + (size_t)(row0 + ai * HALF + m * 16) * 1024 + colb;
#pragma unroll
                    for (int bj = 0; bj < 2; ++bj) { f32x4 a = acc[ai][bj][m][0], b = acc[ai][bj][m][1];
                        if (SILU) {
#pragma unroll
                            for (int k = 0; k < 4; ++k) { a[k] = a[k] * sigm(a[k]); b[k] = b[k] * sigm(b[k]); } }
                        *(u32x4e*)(rowp + bj * 32) = pack8(a, b); } }
        }
    }
};
template <class Epi, class Sched, bool ALIGN_EPI = false, bool SP2 = false>
__device__ __forceinline__ void gemm_phase(PG8_LAS unsigned char* lds, const Gemm g, const Sched& S, const Epi& E) {
    const int tid = threadIdx.x, wid = __builtin_amdgcn_readfirstlane(tid >> 6), lane = tid & 63, wr = wid >> 2, wc = wid & 3, fr = lane & 15, fq = lane >> 4;
    const int K = g.K, nt = K / BK;
    unsigned voffA[2], voffB[2];
#pragma unroll
    for (int i = 0; i < 2; ++i) { int R, C; stage_rc(tid * 16 + i * 8192, R, C); const int Rb = Epi::PERM ? ((R & ~31) + perm32(R & 31)) : R;
        voffA[i] = (unsigned)(R * K + C) * 2u; voffB[i] = (unsigned)(Rb * K + C) * 2u; }
    const size_t kstep = (size_t)(BK * 2);
    const size_t hstep = (size_t)HALF * K * 2;
    const size_t tstep = 2 * hstep;
    const unsigned ldsw = (unsigned)wid * 1024u;
    const int aoff = lds_byte(wr * 64 + fr, fq * 8), boff = lds_byte(wc * 32 + fr, fq * 8);
#define PG8_SA(b, h) (((b) * 2 + (h)) * HTB)
#define PG8_SB(b, h) ((4 + (b) * 2 + (h)) * HTB)
#define PG8_STAGE(bufoff, gbase, voff) do { _Pragma("unroll") for (int _i = 0; _i < 2; ++_i) \
        __builtin_amdgcn_global_load_lds((const unsigned*)((const char*)(gbase) + (voff)[_i]), (PG8_LAS unsigned*)(lds + (bufoff) + ldsw + _i * 8192), 16, 0, 0); } while (0)
#define PG8_LDA(dst, b, h) do { _Pragma("unroll") for (int m = 0; m < 4; ++m) _Pragma("unroll") for (int k = 0; k < 2; ++k) dst[m][k] = *(const PG8_LAS bf16x8*)(lds + PG8_SA(b, h) + aoff + m * 2048 + k * 1024); } while (0)
#define PG8_LDB(dst, b, h) do { _Pragma("unroll") for (int n = 0; n < 2; ++n) _Pragma("unroll") for (int k = 0; k < 2; ++k) dst[n][k] = *(const PG8_LAS bf16x8*)(lds + PG8_SB(b, h) + boff + n * 2048 + k * 1024); } while (0)
#define PG8_MMA(ai, bj, At, Bt) do { __builtin_amdgcn_s_setprio(1); _Pragma("unroll") for (int m = 0; m < 4; ++m) _Pragma("unroll") for (int n = 0; n < 2; ++n) _Pragma("unroll") for (int k = 0; k < 2; ++k) \
        acc[ai][bj][m][n] = __builtin_amdgcn_mfma_f32_16x16x32_bf16(Bt[n][k], At[m][k], acc[ai][bj][m][n], 0, 0, 0); __builtin_amdgcn_s_setprio(0); } while (0)
#define PG8_WAIT_V(n) asm volatile("s_waitcnt vmcnt(" #n ")" ::: "memory")
#define PG8_WAIT_L(n) asm volatile("s_waitcnt lgkmcnt(" #n ")" ::: "memory")
#define PG8_BAR __builtin_amdgcn_s_barrier()
#define PG8_SCHED __builtin_amdgcn_sched_barrier(0)
    Unit cur, nxt; int ui = 0;
    if (!S.next(0, cur)) return;
    f32x4 acc[2][2][4][2];
#pragma unroll
    for (int a = 0; a < 2; ++a)
#pragma unroll
        for (int b = 0; b < 2; ++b)
#pragma unroll
            for (int m = 0; m < 4; ++m)
#pragma unroll
                for (int n = 0; n < 2; ++n) acc[a][b][m][n] = (f32x4){0.f, 0.f, 0.f, 0.f};
    bf16x8 At[4][2], B0[2][2], B1[2][2];
    const char* cA = (const char*)g.A + (size_t)cur.pm * tstep; const char* cB = (const char*)g.Bt + (size_t)cur.pn * tstep;
    S.a_ready(cur);
    if constexpr (SP2) {
        PG8_STAGE(PG8_SB(0, 0), cB, voffB); PG8_STAGE(PG8_SB(0, 1), cB + hstep, voffB); PG8_STAGE(PG8_SA(0, 0), cA, voffA); PG8_STAGE(PG8_SA(0, 1), cA + hstep, voffA);
        if (wr == 1) PG8_BAR;
        PG8_WAIT_V(2); PG8_BAR;
        PG8_STAGE(PG8_SB(1, 0), cB + kstep, voffB); PG8_STAGE(PG8_SA(1, 0), cA + kstep, voffA); PG8_STAGE(PG8_SB(1, 1), cB + hstep + kstep, voffB);
        PG8_WAIT_V(6); PG8_BAR;
    } else {
        PG8_STAGE(PG8_SB(0, 0), cB, voffB); PG8_STAGE(PG8_SA(0, 0), cA, voffA); PG8_STAGE(PG8_SB(0, 1), cB + hstep, voffB); PG8_STAGE(PG8_SA(0, 1), cA + hstep, voffA);
        if (wr == 1) PG8_BAR;
        PG8_WAIT_V(4); PG8_BAR;
        PG8_STAGE(PG8_SB(1, 0), cB + kstep, voffB); PG8_STAGE(PG8_SA(1, 0), cA + kstep, voffA); PG8_STAGE(PG8_SB(1, 1), cB + hstep + kstep, voffB);
        PG8_WAIT_V(6); PG8_BAR;
    }
    for (;;) {
        const bool has_next = S.next(ui + 1, nxt);
        const char* nA = has_next ? (const char*)g.A + (size_t)nxt.pm * tstep : cA; const char* nB = has_next ? (const char*)g.Bt + (size_t)nxt.pn * tstep : cB;
        for (int t = 0; t < nt; t += 2) {
            const bool last = (t == nt - 2);
            const char* a1 = cA + (size_t)(t + 1) * kstep;
            const char* a2 = last ? nA : cA + (size_t)(t + 2) * kstep; const char* b2 = last ? nB : cB + (size_t)(t + 2) * kstep;
            const char* a3 = a2 + kstep; const char* b3 = b2 + kstep;
            if (last && has_next) S.a_ready(nxt);
            if constexpr (SP2) {
            PG8_LDB(B0, 0, 0); PG8_LDB(B1, 0, 1); PG8_SCHED; PG8_LDA(At, 0, 0); PG8_STAGE(PG8_SA(1, 1), a1 + hstep, voffA);
            PG8_WAIT_V(8); PG8_WAIT_L(0); PG8_BAR; PG8_MMA(0, 0, At, B0); PG8_MMA(0, 1, At, B1); PG8_BAR; PG8_SCHED;
            PG8_LDA(At, 0, 1); PG8_STAGE(PG8_SB(0, 0), b2, voffB); PG8_STAGE(PG8_SB(0, 1), b2 + hstep, voffB); PG8_STAGE(PG8_SA(0, 0), a2, voffA);
            PG8_WAIT_V(8); PG8_WAIT_L(0); PG8_BAR; PG8_MMA(1, 0, At, B0); PG8_MMA(1, 1, At, B1); PG8_BAR; PG8_SCHED;
            PG8_LDB(B0, 1, 0); PG8_LDB(B1, 1, 1); PG8_SCHED; PG8_LDA(At, 1, 0); PG8_STAGE(PG8_SA(0, 1), a2 + hstep, voffA);
            PG8_WAIT_V(8); PG8_WAIT_L(0); PG8_BAR; PG8_MMA(0, 0, At, B0); PG8_MMA(0, 1, At, B1); PG8_BAR; PG8_SCHED;
            PG8_LDA(At, 1, 1); PG8_STAGE(PG8_SB(1, 0), b3, voffB); PG8_STAGE(PG8_SB(1, 1), b3 + hstep, voffB); PG8_STAGE(PG8_SA(1, 0), a3, voffA);
            PG8_WAIT_V(8); PG8_WAIT_L(0); PG8_BAR; PG8_MMA(1, 0, At, B0); PG8_MMA(1, 1, At, B1); PG8_BAR; PG8_SCHED;
            } else {
            PG8_LDB(B0, 0, 0); PG8_SCHED; PG8_LDA(At, 0, 0); PG8_STAGE(PG8_SA(1, 1), a1 + hstep, voffA);
            PG8_WAIT_L(8); PG8_BAR; PG8_WAIT_L(0); PG8_MMA(0, 0, At, B0); PG8_BAR; PG8_SCHED;
            PG8_LDB(B1, 0, 1); PG8_STAGE(PG8_SB(0, 0), b2, voffB);
            PG8_BAR; PG8_WAIT_L(0); PG8_MMA(0, 1, At, B1); PG8_BAR;
            PG8_LDA(At, 0, 1); PG8_STAGE(PG8_SA(0, 0), a2, voffA);
            PG8_BAR; PG8_WAIT_L(0); PG8_MMA(1, 0, At, B0); PG8_BAR; PG8_SCHED;
            PG8_STAGE(PG8_SB(0, 1), b2 + hstep, voffB);
            PG8_WAIT_V(6); PG8_BAR; PG8_MMA(1, 1, At, B1); PG8_BAR;
            PG8_LDB(B0, 1, 0); PG8_SCHED; PG8_LDA(At, 1, 0); PG8_STAGE(PG8_SA(0, 1), a2 + hstep, voffA);
            PG8_WAIT_L(8); PG8_BAR; PG8_WAIT_L(0); PG8_MMA(0, 0, At, B0); PG8_BAR; PG8_SCHED;
            PG8_LDB(B1, 1, 1); PG8_STAGE(PG8_SB(1, 0), b3, voffB);
            PG8_BAR; PG8_WAIT_L(0); PG8_MMA(0, 1, At, B1); PG8_BAR;
            PG8_LDA(At, 1, 1); PG8_STAGE(PG8_SA(1, 0), a3, voffA);
            PG8_BAR; PG8_WAIT_L(0); PG8_MMA(1, 0, At, B0); PG8_BAR; PG8_SCHED;
            PG8_STAGE(PG8_SB(1, 1), b3 + hstep, voffB);
            PG8_WAIT_V(6); PG8_BAR; PG8_MMA(1, 1, At, B1); PG8_BAR;
            }
        }
        if constexpr (ALIGN_EPI) { if (wr == 0) PG8_BAR; }
        if constexpr (!Epi::AFTER_DRAIN) { E(acc, cur, wr, wc, fr, fq); S.done(cur); }
        if (!has_next) break;
#pragma unroll
        for (int a = 0; a < 2; ++a)
#pragma unroll
            for (int b = 0; b < 2; ++b)
#pragma unroll
                for (int m = 0; m < 4; ++m)
#pragma unroll
                    for (int n = 0; n < 2; ++n) acc[a][b][m][n] = (f32x4){0.f, 0.f, 0.f, 0.f};
        cur = nxt; cA = nA; cB = nB; ++ui;
        if constexpr (ALIGN_EPI) { if (wr == 1) PG8_BAR; }
    }
    PG8_WAIT_V(0);
    if constexpr (!ALIGN_EPI) { if (wr == 0) PG8_BAR; }
    PG8_BAR;
    if constexpr (Epi::AFTER_DRAIN) { E.fused(acc, cur, wr, wc, fr, fq, lds, wid, lane); S.done(cur); }
#undef PG8_SA
#undef PG8_SB
#undef PG8_STAGE
#undef PG8_LDA
#undef PG8_LDB
#undef PG8_MMA
#undef PG8_WAIT_V
#undef PG8_WAIT_L
#undef PG8_BAR
#undef PG8_SCHED
}
}
#include <hip/hip_bf16.h>
#include <cmath>
namespace attn_body {
using bf16=__hip_bfloat16;
using bf16x8=__attribute__((ext_vector_type(8)))short;
using s16x4=__attribute__((ext_vector_type(4)))short;
using f32x16=__attribute__((ext_vector_type(16)))float;
using u32x4=__attribute__((ext_vector_type(4)))unsigned;
constexpr int BATCH=8,NHEAD=16,SEQ=2048,D=64,DM=NHEAD*D;
constexpr int NW=8,QBLK=32,QB=QBLK*NW,KVBLK=64,NQB=SEQ/QB;
constexpr int ATTN_PITCH=DM, ATTN_UNIT_ROWS=QB;
__device__ __forceinline__ int crow(int r,int hi){return (r&3)+8*(r>>2)+4*hi;}
#define SBAR() __builtin_amdgcn_sched_barrier(0)
__device__ __forceinline__ void cmask(f32x16&p0,f32x16&p1,int jb,int qrel,int hi){
  const float NEG=-INFINITY; int d=qrel-(64*jb+4*hi); asm volatile("":"+v"(d));
  #pragma unroll
  for(int r=0;r<16;++r){const int c=(r&3)+8*(r>>2); if(c>d)p0[r]=NEG; if(c+32>d)p1[r]=NEG;}
}

constexpr int NSLOT=3, SLOTB=8192;
constexpr int LDS_K=0, LDS_V=NSLOT*SLOTB, LDS_WS=2*NSLOT*SLOTB, LDS_OST=LDS_WS+NW*64*4, LDS_FS=LDS_OST+NW*4096, LDS_SCAN=LDS_FS+SEQ*4, LDS_BYTES=LDS_SCAN+256; typedef float f32x4v __attribute__((ext_vector_type(4)));
constexpr float C2=0.125f*1.4426950408889634f;
__device__ __forceinline__ void glds16(const void*gsrc,unsigned lds_dst){unsigned keep;
  asm volatile("s_mov_b32 %0, m0\n\ts_mov_b32 m0, %2\n\ts_nop 0\n\tglobal_load_lds_dwordx4 %1, off\n\ts_mov_b32 m0, %0":"=&s"(keep):"v"(gsrc),"s"(lds_dst):"memory");}
__device__ __forceinline__ float max3f(float a,float b,float c){float r;asm("v_max3_f32 %0, %1, %2, %3":"=v"(r):"v"(a),"v"(b),"v"(c));return r;}
__device__ __forceinline__ float max2f(float a,float b){float r;asm("v_max_f32_e32 %0, %1, %2":"=v"(r):"v"(a),"v"(b));return r;}
__device__ __forceinline__ float fadd_s(float a,float b){float r;asm("v_add_f32_e32 %0, %1, %2":"=v"(r):"v"(a),"v"(b));return r;}
__device__ __forceinline__ float fsub_s(float a,float b){float r;asm("v_sub_f32_e32 %0, %1, %2":"=v"(r):"v"(a),"v"(b));return r;}
typedef float f32x2_t __attribute__((ext_vector_type(2))); typedef __bf16 bf16x2_t __attribute__((ext_vector_type(2)));
__device__ __forceinline__ unsigned cvtpk_s(float lo,float hi){f32x2_t v={lo,hi};bf16x2_t b=__builtin_convertvector(v,bf16x2_t);return __builtin_bit_cast(unsigned,b);}
#define WAIT_BAR(N) asm volatile("s_waitcnt vmcnt(" #N ") lgkmcnt(0)\n\ts_barrier":::"memory")

__device__ __forceinline__ void qkt(f32x16&p0,f32x16&p1,const char*Kslot,const bf16x8*qr,int r32,int hi){
  const char*kb=Kslot+hi*1024+r32*16;
  #pragma unroll
  for(int d0=0;d0<4;++d0){
    const bf16x8 b0=*reinterpret_cast<const bf16x8*>(kb+d0*2048);
    const bf16x8 b1=*reinterpret_cast<const bf16x8*>(kb+d0*2048+512);
    p0=__builtin_amdgcn_mfma_f32_32x32x16_bf16(b0,qr[d0],p0,0,0,0);p1=__builtin_amdgcn_mfma_f32_32x32x16_bf16(b1,qr[d0],p1,0,0,0);}
}
typedef __attribute__((address_space(3))) const char* lds_cptr;
typedef short v4i16_t __attribute__((ext_vector_type(4)));
__device__ __forceinline__ void kload8(bf16x8*kf,lds_cptr kp){
  kf[0]=*(const __attribute__((address_space(3))) bf16x8*)(kp);      kf[1]=*(const __attribute__((address_space(3))) bf16x8*)(kp+512);
  kf[2]=*(const __attribute__((address_space(3))) bf16x8*)(kp+2048); kf[3]=*(const __attribute__((address_space(3))) bf16x8*)(kp+2560);
  kf[4]=*(const __attribute__((address_space(3))) bf16x8*)(kp+4096); kf[5]=*(const __attribute__((address_space(3))) bf16x8*)(kp+4608);
  kf[6]=*(const __attribute__((address_space(3))) bf16x8*)(kp+6144); kf[7]=*(const __attribute__((address_space(3))) bf16x8*)(kp+6656);
}
__device__ __forceinline__ void kload2(bf16x8*kf,lds_cptr kp,int j){ kf[2*j]=*(const __attribute__((address_space(3))) bf16x8*)(kp+j*2048); kf[2*j+1]=*(const __attribute__((address_space(3))) bf16x8*)(kp+j*2048+512); }
__device__ __forceinline__ s16x4 vtr(lds_cptr p){ return __builtin_bit_cast(s16x4,__builtin_amdgcn_ds_read_tr16_b64_v4i16((__attribute__((address_space(3))) v4i16_t*)p)); }
__device__ __forceinline__ float rowmax(const f32x16&p0,const f32x16&p1){
  float a=max3f(p0[0],p0[1],p1[0]),b=max3f(p0[2],p0[3],p1[1]);a=max3f(a,p1[2],p1[3]);
  #pragma unroll
  for(int r=4;r<16;r+=4){a=max3f(a,p0[r],p0[r+1]);b=max3f(b,p0[r+2],p0[r+3]);a=max3f(a,p1[r],p1[r+1]);b=max3f(b,p1[r+2],p1[r+3]);}
  const float m=max2f(a,b);
  auto rr=__builtin_amdgcn_permlane32_swap(__float_as_uint(m),__float_as_uint(m),false,false);
  return max2f(__uint_as_float(rr[0]),__uint_as_float(rr[1]));
}
__device__ __forceinline__ void pv(f32x16*o,int vb,bf16x8 pa0,bf16x8 pa1,bf16x8 pa2,bf16x8 pa3){
  #pragma unroll
  for(int d0=0;d0<2;++d0){s16x4 lo[4],hi[4];
    #pragma unroll
    for(int ks=0;ks<4;++ks){
      asm volatile("ds_read_b64_tr_b16 %0,%1 offset:%c2":"=&v"(lo[ks]):"v"(vb),"i"(d0*4096+ks*1024):"memory");
      asm volatile("ds_read_b64_tr_b16 %0,%1 offset:%c2":"=&v"(hi[ks]):"v"(vb),"i"(d0*4096+ks*1024+512):"memory");}
    asm volatile("s_waitcnt lgkmcnt(0)":::"memory");SBAR();
    #define PK(k) (bf16x8){lo[k][0],lo[k][1],lo[k][2],lo[k][3],hi[k][0],hi[k][1],hi[k][2],hi[k][3]}
    o[d0]=__builtin_amdgcn_mfma_f32_32x32x16_bf16(pa0,PK(0),o[d0],0,0,0);
    o[d0]=__builtin_amdgcn_mfma_f32_32x32x16_bf16(pa1,PK(1),o[d0],0,0,0);
    o[d0]=__builtin_amdgcn_mfma_f32_32x32x16_bf16(pa2,PK(2),o[d0],0,0,0);
    o[d0]=__builtin_amdgcn_mfma_f32_32x32x16_bf16(pa3,PK(3),o[d0],0,0,0);
    #undef PK
  }
}

#ifndef ATTN_STORE16
#define ATTN_STORE16(p,v) (*(u32x4*)(p)=(v))
#endif
template<int THRL> __device__ __forceinline__ void attn_unit(int b,int h,int qb,const bf16*Q,const bf16*__restrict__ K,const bf16*__restrict__ V,bf16*O,const bf16*__restrict__ SZ,char*shm){
  const int tid=threadIdx.x,lane=tid&63,r32=lane&31,hi=lane>>5; const int wid=__builtin_amdgcn_readfirstlane(tid>>6);
  const long rowbase=(long)b*SEQ; const int q0=qb*QB;
  const bf16*Qw=Q+(rowbase+q0+wid*QBLK)*DM+h*D;
  const bf16*Kh=K+rowbase*DM+h*D,*Vh=V+rowbase*DM+h*D;
  const unsigned lds0=(unsigned)(uintptr_t)shm;
  float*wsf=(float*)(shm+LDS_WS)+wid*64;
  const bf16*ksrc=Kh+(long)lane*DM+wid*8;
  const bf16*vsrc=Vh+(long)(16*(wid&3)+(lane>>2))*DM+(wid>>2)*32+(lane&3)*8;
  const unsigned kdst=lds0+LDS_K+wid*1024, vdst=lds0+LDS_V+wid*1024;
  #define DMA_K(t,slot) glds16(ksrc+(long)(t)*KVBLK*DM,(unsigned)__builtin_amdgcn_readfirstlane(kdst+(slot)))
  #define DMA_V(t,slot) glds16(vsrc+(long)(t)*KVBLK*DM,(unsigned)__builtin_amdgcn_readfirstlane(vdst+(slot)))
  const int vb0=(int)(lds0+LDS_V)+((lane>>4)&1)*32+(lane&3)*8+(4*hi+((lane&15)>>2))*64;
  const char*Kbase=shm+LDS_K; bf16x8 kf[8];
  const lds_cptr shm3=(lds_cptr)shm; const lds_cptr kp0=shm3+LDS_K+hi*1024+r32*16; const lds_cptr vp0=shm3+LDS_V+((lane>>4)&1)*32+(lane&3)*8+(4*hi+((lane&15)>>2))*64;
  const int NT=(q0+QB)/KVBLK;
  DMA_K(0,0);DMA_V(0,0);DMA_K(1,SLOTB);
  bf16x8 qr[4];
  #pragma unroll
  for(int d0=0;d0<4;++d0)qr[d0]=*reinterpret_cast<const bf16x8*>(&Qw[(long)r32*DM+d0*16+hi*8]);
  float l_reg=0.f;f32x16 o[2];o[0]=f32x16{};o[1]=f32x16{};
  const int qrel=wid*QBLK+r32;
  const __attribute__((address_space(3))) float* Fs3=(const __attribute__((address_space(3))) float*)((lds_cptr)shm+LDS_FS);
  float fqm=Fs3[q0+qrel];
  #define BIAS(C0,C1,t) do{ const __attribute__((address_space(3))) f32x4v* fk_=(const __attribute__((address_space(3))) f32x4v*)(Fs3+(t)*64+4*hi); \
    _Pragma("unroll") for(int i_=0;i_<4;++i_){ const f32x4v a_=fk_[2*i_], b_=fk_[2*i_+8]; \
      _Pragma("unroll") for(int k_=0;k_<4;++k_){ C0[4*i_+k_]=fqm-a_[k_]; C1[4*i_+k_]=fqm-b_[k_]; } } }while(0)
  #define CMASK(P0,P1,t) do{int jb_=(t)-(NT-4); if(jb_>=0)cmask(P0,P1,jb_,qrel,hi);}while(0)
  bool resc=false;
  #define START(P0,P1) do{ const float rm=rowmax(P0,P1); resc=false; \
    { const float dl=rm; fqm=fsub_s(fqm,dl); \
      _Pragma("unroll") for(int r=0;r<16;++r){P0[r]=fsub_s(P0[r],dl);P1[r]=fsub_s(P1[r],dl);} } \
    _Pragma("unroll") for(int r=0;r<16;++r)P0[r]=__builtin_amdgcn_exp2f(P0[r]); }while(0)
  #define RESC() do{ if(resc){ asm volatile("s_waitcnt lgkmcnt(0)":::"memory"); \
      _Pragma("unroll") for(int d_=0;d_<2;++d_) _Pragma("unroll") for(int r=0;r<16;++r)o[d_][r]*=wsf[crow(r,hi)]; } }while(0)
  f32x16 pA0,pA1,pB0,pB1;
  int sl_prev=0,sl_cur=0,sl_next=SLOTB;
  #define ROT() do{sl_prev=sl_cur;sl_cur=sl_next;sl_next=(sl_next==(NSLOT-1)*SLOTB)?0:sl_next+SLOTB;}while(0)
  DMA_K(2,2*SLOTB);
  WAIT_BAR(3);
  BIAS(pA0,pA1,0); qkt(pA0,pA1,Kbase,qr,r32,hi);asm volatile("s_nop 15\n\ts_nop 7":"+v"(pA0),"+v"(pA1));CMASK(pA0,pA1,0);
  START(pA0,pA1);
  _Pragma("unroll") for(int r=0;r<16;++r)pA1[r]=__builtin_amdgcn_exp2f(pA1[r]);
  WAIT_BAR(0);
  DMA_K(3,0);DMA_V(1,SLOTB);
  ROT();
  kload8(kf,kp0+sl_cur);
  WAIT_BAR(2);
  s16x4 vlo[8],vhi[8]; u32x4 pw0,pw1,pw2,pw3;
  #define PKW(P,B) cvtpk_s(P[B],P[B+1])
  #define PAF(k) __builtin_bit_cast(bf16x8,pw##k)
  #define VFR(i) (bf16x8){vlo[i][0],vlo[i][1],vlo[i][2],vlo[i][3],vhi[i][0],vhi[i][1],vhi[i][2],vhi[i][3]}
  #define PIN(x) asm volatile("":"+v"(x))
  #define MX3(a,b,c) __builtin_fmaxf(__builtin_fmaxf((a),(b)),(c))
  #define GAPA(MF,A0,A1,A2,A3,W0,W1,PW) do{ MF; sacc+=A0; sacc+=A1; sacc+=A2; sacc+=A3; PIN(sacc); W0; W1; PIN(PW); SBAR(); }while(0)
  #define EX(v) __builtin_amdgcn_exp2f(v)
  #define GAPB(MF,X,B) do{ MF; X[B]=EX(X[B]); X[B+1]=EX(X[B+1]); X[B+2]=EX(X[B+2]); X[B+3]=EX(X[B+3]); PIN(X); SBAR(); }while(0)
  #define VRD(i) do{ vlo[i]=vtr(vp_+(((i)>>2)*4096+((i)&3)*1024)); vhi[i]=vtr(vp_+(((i)>>2)*4096+((i)&3)*1024+512)); }while(0)
  #define KRD(G,j) do{ if(G){ kload2(kf,kp0+sl_next,j); SBAR(); } }while(0)
  #define STEP(C0,C1,P0,P1,t,GK,GV,GL) do{ SBAR(); BIAS(C0,C1,t); SBAR(); \
    const lds_cptr vp_=vp0+sl_prev; \
    VRD(0); SBAR(); float sacc=(P0[0]+P0[1]); \
    GAPA(C0=__builtin_amdgcn_mfma_f32_32x32x16_bf16(kf[0],qr[0],C0,0,0,0), P0[2],P0[3],P0[4],P0[5],     pw0[0]=PKW(P0,0), pw0[1]=PKW(P0,2), pw0); \
    VRD(4); SBAR(); GAPA(C1=__builtin_amdgcn_mfma_f32_32x32x16_bf16(kf[1],qr[0],C1,0,0,0), P0[6],P0[7],P0[8],P0[9],     pw0[2]=PKW(P0,4), pw0[3]=PKW(P0,6), pw0); \
    VRD(1); SBAR(); GAPA(C0=__builtin_amdgcn_mfma_f32_32x32x16_bf16(kf[2],qr[1],C0,0,0,0),   P0[10],P0[11],P0[12],P0[13], pw1[0]=PKW(P0,8), pw1[1]=PKW(P0,10), pw1); \
    VRD(5); SBAR(); GAPA(C1=__builtin_amdgcn_mfma_f32_32x32x16_bf16(kf[3],qr[1],C1,0,0,0),   P0[14],P0[15],P1[0],P1[1],   pw1[2]=PKW(P0,12),pw1[3]=PKW(P0,14), pw1); \
    VRD(2); SBAR(); GAPA(C0=__builtin_amdgcn_mfma_f32_32x32x16_bf16(kf[4],qr[2],C0,0,0,0),   P1[2],P1[3],P1[4],P1[5],     pw2[0]=PKW(P1,0), pw2[1]=PKW(P1,2), pw2); \
    VRD(6); SBAR(); GAPA(C1=__builtin_amdgcn_mfma_f32_32x32x16_bf16(kf[5],qr[2],C1,0,0,0),   P1[6],P1[7],P1[8],P1[9],     pw2[2]=PKW(P1,4), pw2[3]=PKW(P1,6), pw2); \
    VRD(3); SBAR(); GAPA(C0=__builtin_amdgcn_mfma_f32_32x32x16_bf16(kf[6],qr[3],C0,0,0,0),   P1[10],P1[11],P1[12],P1[13], pw3[0]=PKW(P1,8), pw3[1]=PKW(P1,10), pw3); \
    VRD(7); SBAR(); GAPA(C1=__builtin_amdgcn_mfma_f32_32x32x16_bf16(kf[7],qr[3],C1,0,0,0),   P1[14],P1[15],0.f,0.f,       pw3[2]=PKW(P1,12),pw3[3]=PKW(P1,14), pw3); \
    l_reg+=sacc; \
    if(GK){DMA_K((t)+3,sl_cur);} if(GV){DMA_V((t)+1,sl_next);} \
    CMASK(C0,C1,t); \
    { float a=MX3(C0[0],C0[1],C1[0]),b=MX3(C0[2],C0[3],C1[1]); a=MX3(a,C1[2],C1[3]); \
      _Pragma("unroll") for(int r=4;r<16;r+=4){a=MX3(a,C0[r],C0[r+1]);b=MX3(b,C0[r+2],C0[r+3]);a=MX3(a,C1[r],C1[r+1]);b=MX3(b,C1[r+2],C1[r+3]);} \
      float rm=__builtin_fmaxf(a,b); { auto rr=__builtin_amdgcn_permlane32_swap(__float_as_uint(rm),__float_as_uint(rm),false,false); rm=__builtin_fmaxf(__uint_as_float(rr[0]),__uint_as_float(rr[1])); } \
      resc=false; \
      if(__builtin_expect(__any(rm>(float)THRL),0)){ const float dl=__builtin_fmaxf(rm,0.f); fqm-=dl; \
        _Pragma("unroll") for(int r=0;r<16;++r){C0[r]-=dl;C1[r]-=dl;} \
        const float f=__builtin_amdgcn_exp2f(-dl); l_reg*=f; if(hi==0)wsf[r32]=f; resc=true; } } \
    SBAR(); \
    GAPB(o[0]=__builtin_amdgcn_mfma_f32_32x32x16_bf16(PAF(0),VFR(0),o[0],0,0,0), C0,0); \
    GAPB(o[1]=__builtin_amdgcn_mfma_f32_32x32x16_bf16(PAF(0),VFR(4),o[1],0,0,0), C0,4); \
    KRD(GL,0); GAPB(o[0]=__builtin_amdgcn_mfma_f32_32x32x16_bf16(PAF(1),VFR(1),o[0],0,0,0), C0,8); \
    KRD(GL,1); GAPB(o[1]=__builtin_amdgcn_mfma_f32_32x32x16_bf16(PAF(1),VFR(5),o[1],0,0,0), C0,12); \
    KRD(GL,2); GAPB(o[0]=__builtin_amdgcn_mfma_f32_32x32x16_bf16(PAF(2),VFR(2),o[0],0,0,0), C1,0); \
    KRD(GL,3); GAPB(o[1]=__builtin_amdgcn_mfma_f32_32x32x16_bf16(PAF(2),VFR(6),o[1],0,0,0), C1,4); \
    GAPB(o[0]=__builtin_amdgcn_mfma_f32_32x32x16_bf16(PAF(3),VFR(3),o[0],0,0,0), C1,8); \
    GAPB(o[1]=__builtin_amdgcn_mfma_f32_32x32x16_bf16(PAF(3),VFR(7),o[1],0,0,0), C1,12); \
    }while(0)
  int t=1;
  #undef CMASK
  #define CMASK(P0,P1,t) do{}while(0)
  for(;t+5<NT;t+=2){
    STEP(pB0,pB1,pA0,pA1,t,true,true,true);     WAIT_BAR(2); RESC(); ROT();
    STEP(pA0,pA1,pB0,pB1,t+1,true,true,true);   WAIT_BAR(2); RESC(); ROT();
  }
  #undef CMASK
  #define CMASK(P0,P1,t) do{int jb_=(t)-(NT-4); if(jb_>=0)cmask(P0,P1,jb_,qrel,hi);}while(0)
  #define ENDW(tt) do{ if((tt)+3<NT){WAIT_BAR(2);} else if((tt)+2<NT){WAIT_BAR(1);} else {WAIT_BAR(0);} }while(0)
  for(;t+1<NT;t+=2){
    STEP(pB0,pB1,pA0,pA1,t,(t+3<NT),(t+1<NT),(t+1<NT));       ENDW(t);   RESC(); ROT();
    STEP(pA0,pA1,pB0,pB1,t+1,(t+4<NT),(t+2<NT),(t+2<NT));     ENDW(t+1); RESC(); ROT();
  }
  STEP(pB0,pB1,pA0,pA1,NT-1,false,false,false); RESC();
  { float sacc=pB0[0]+pB0[1]; _Pragma("unroll") for(int r=2;r<16;++r)sacc+=pB0[r]; _Pragma("unroll") for(int r=0;r<16;++r)sacc+=pB1[r]; l_reg+=sacc;
    pw0=(u32x4){PKW(pB0,0),PKW(pB0,2),PKW(pB0,4),PKW(pB0,6)};pw1=(u32x4){PKW(pB0,8),PKW(pB0,10),PKW(pB0,12),PKW(pB0,14)};pw2=(u32x4){PKW(pB1,0),PKW(pB1,2),PKW(pB1,4),PKW(pB1,6)};pw3=(u32x4){PKW(pB1,8),PKW(pB1,10),PKW(pB1,12),PKW(pB1,14)};
    SBAR(); pv(o,vb0+sl_cur,PAF(0),PAF(1),PAF(2),PAF(3)); }
  #undef PKW
  #undef PAF
  #undef VFR
  #undef PIN
  #undef MX3
  #undef GAPA
  #undef GAPB
  #undef EX
  #undef VRD
  #undef KRD
  #undef STEP
  #undef ENDW
  {auto rr=__builtin_amdgcn_permlane32_swap(__float_as_uint(l_reg),__float_as_uint(l_reg),false,false);l_reg=__uint_as_float(rr[0])+__uint_as_float(rr[1]);}
  if(hi==0)wsf[32+r32]=l_reg;asm volatile("s_waitcnt lgkmcnt(0)":::"memory");
  float rli[16];
  #pragma unroll
  for(int r=0;r<16;++r)rli[r]=__builtin_amdgcn_rcpf(wsf[32+crow(r,hi)]);
  bf16*Ow=O+(rowbase+q0+wid*QBLK)*DM+h*D;
  { bf16*stg=(bf16*)(shm+LDS_OST)+wid*2048;
    #pragma unroll
    for(int r=0;r<16;++r){const int orow=crow(r,hi);
      #pragma unroll
      for(int d0=0;d0<2;++d0)stg[orow*64+d0*32+r32]=__float2bfloat16(o[d0][r]*rli[r]);}
    asm volatile("s_waitcnt lgkmcnt(0)":::"memory");
    const bf16*SZw=SZ+(rowbase+q0+wid*QBLK)*DM+h*D;
    #pragma unroll
    for(int i=0;i<4;++i){const int row=i*8+(lane>>3),ch=lane&7; const u32x4 v=*(const u32x4*)(stg+row*64+ch*8); const u32x4 g=*(const u32x4*)(SZw+(long)row*DM+ch*8); u32x4 w;
      #pragma unroll
      for(int k=0;k<4;++k){ const float a0=__uint_as_float(v[k]<<16)*__uint_as_float(g[k]<<16), a1=__uint_as_float(v[k]&0xffff0000u)*__uint_as_float(g[k]&0xffff0000u); w[k]=cvtpk_s(a0,a1); }
      ATTN_STORE16(Ow+(long)row*DM+ch*8,w);} }
  asm volatile("s_waitcnt lgkmcnt(0)\n\ts_barrier":::"memory");
  #undef DMA_K
  #undef DMA_V
  #undef CMASK
  #undef START
  #undef RESC
  #undef ROT
  #undef BIAS
}
constexpr int ATTN_LDS_BYTES=LDS_BYTES;
struct AttnTensors { const bf16* Q; const bf16* K; const bf16* V; bf16* O; const bf16* SZ; const float* LF; };
template<int THRL=8> __device__ __forceinline__ void attn_phase(char*lds,const AttnTensors&T,int vcu,int G){
  #pragma unroll 1
  for(int task=vcu;task<BATCH*NHEAD*2;task+=G){
    int tid=threadIdx.x; asm volatile("":"+v"(tid)); const int lane=tid&63,wid=tid>>6;
    const int bh=task>>1,s=task&1,b=bh/NHEAD,h=bh%NHEAD;
    { __attribute__((address_space(3))) float* Fs=(__attribute__((address_space(3))) float*)((lds_cptr)lds+LDS_FS);
      __attribute__((address_space(3))) float* WT=(__attribute__((address_space(3))) float*)((lds_cptr)lds+LDS_SCAN);
      const float* lf=T.LF+((long)b*SEQ+4*tid)*NHEAD+h;
      const float v0=lf[0],v1=lf[NHEAD],v2=lf[2*NHEAD],v3=lf[3*NHEAD];
      const float p1=v0+v1,p2=p1+v2,p3=p2+v3; float x=p3;
      #pragma unroll
      for(int off=1;off<64;off<<=1){const float y=__shfl_up(x,off); if(lane>=off)x+=y;}
      if(lane==63)WT[wid]=x;
      __syncthreads();
      float offs=0.f;
      #pragma unroll
      for(int w=0;w<NW;++w){const float tv=WT[w]; if(w<wid)offs+=tv;}
      const float ex=x-p3+offs; const float L2E=1.4426950408889634f;
      f32x4v o4; o4[0]=(ex+v0)*L2E; o4[1]=(ex+p1)*L2E; o4[2]=(ex+p2)*L2E; o4[3]=(ex+p3)*L2E;
      *(__attribute__((address_space(3))) f32x4v*)(Fs+4*tid)=o4;
      __syncthreads(); }
    #pragma unroll 1
    for(int i=0;i<4;++i){ const int qb=(i==0)?7-s:(i==1)?s:(i==2)?4+s:3-s;
      attn_unit<THRL>(b,h,qb,T.Q,T.K,T.V,T.O,T.SZ,lds); }
  }
}
#undef SBAR
#undef WAIT_BAR
}
#define GAS __attribute__((address_space(1)))
#define LAS __attribute__((address_space(3)))
typedef unsigned short bf16u;
typedef unsigned v4u __attribute__((ext_vector_type(4)));
typedef float f32x4 __attribute__((ext_vector_type(4)));
typedef float f32x16 __attribute__((ext_vector_type(16)));
typedef short bf16x8 __attribute__((ext_vector_type(8)));
#define LDS_WAIT() asm volatile("s_waitcnt lgkmcnt(0)" ::: "memory")

constexpr int NWAVES = 8;
constexpr int BATCH = 8, SEQ = 2048, D = 1024, M = BATCH * SEQ, NG = 64, NST = 64, NH = 16;
constexpr float EPS = 1e-6f;
constexpr float C2 = 0.125f * 1.4426950408889634f;

constexpr size_t MiB = 1u << 20;
constexpr size_t WS_W_IN_A = 0 * MiB, WS_W_GLU = 4 * MiB, WS_W_OUT_A = 6 * MiB, WS_W_KV = 8 * MiB, WS_W_IN_B = 12 * MiB, WS_W_OUT_B = 16 * MiB;
constexpr size_t WS_W_F = 18 * MiB;
constexpr size_t WS_MODP = 19 * MiB;
constexpr size_t WS_GATE = 21 * MiB;
constexpr size_t WS_ABAR = 21 * MiB + 128 * 1024, WS_AL = WS_ABAR + 32 * 1024, WS_BFRAG = WS_AL + 32 * 1024, WS_CFRAG = WS_BFRAG + 256 * 1024;
constexpr size_t WS_E = 22 * MiB;
constexpr size_t WS_UZ = 24 * MiB;
constexpr size_t WS_K = 24 * MiB, WS_V = 56 * MiB;
constexpr size_t WS_R2 = 88 * MiB;
constexpr size_t WS_R3 = 120 * MiB;
constexpr size_t WS_QO = 152 * MiB, WS_SZ = 184 * MiB;
constexpr size_t WS_LF = 216 * MiB;
constexpr size_t WS_END = 217 * MiB;
constexpr int LDS_BYTES = 147456;

__device__ __forceinline__ unsigned f2bf(float f) { unsigned u = __builtin_bit_cast(unsigned, f); return (u + 0x7fffu + ((u >> 16) & 1u)) >> 16; }
__device__ __forceinline__ unsigned pk2(float lo, float hi) { return f2bf(lo) | (f2bf(hi) << 16); }
__device__ __forceinline__ float wave_sum(float v) {
#pragma unroll
    for (int o = 1; o < 64; o <<= 1) v += __shfl_xor(v, o);
    return v;
}
__host__ __device__ __forceinline__ int phys_row(int n) { const int q = n & 255; return (n - q) + 128 * ((q >> 5) & 1) + 32 * (q >> 6) + (q & 31); }

struct Args { const float* in[29]; float* out; unsigned char* ws; };

__device__ __forceinline__ void p0_transpose_item(const float* W, int ldw, int K, int N, bf16u* WT, LAS float* scr, int item, int lane) {
    const int nblk = N / 32, kb = item / nblk, nb = item % nblk, k0 = 64 * kb, n0 = 32 * nb;
#pragma unroll 8
    for (int i = 0; i < 32; ++i) { const int kk = 2 * i + (lane >> 5); scr[kk * 33 + (lane & 31)] = W[(size_t)(k0 + kk) * ldw + n0 + (lane & 31)]; }
    LDS_WAIT(); asm volatile("" ::: "memory");
    const int c = lane & 7; const int pr0 = phys_row(n0);
#pragma unroll
    for (int j = 0; j < 4; ++j) { const int n = (lane >> 3) + 8 * j; const LAS float* s = scr + (8 * c) * 33 + n;
        v4u o; o.x = pk2(s[0 * 33], s[1 * 33]); o.y = pk2(s[2 * 33], s[3 * 33]); o.z = pk2(s[4 * 33], s[5 * 33]); o.w = pk2(s[6 * 33], s[7 * 33]);
        *(v4u*)(WT + (size_t)(pr0 + n) * K + k0 + 8 * c) = o; }
    LDS_WAIT(); asm volatile("" ::: "memory");
}

__device__ __forceinline__ void sincos_d(double x, double& s, double& c) {
    const double kq = rint(x * 0.63661977236758134308), r = fma(-kq, 1.57079632679489661923, x) - kq * 6.123233995736766e-17, r2 = r * r;
    double sp = -7.6471637318198165e-13; sp = fma(sp, r2, 1.6059043836821613e-10); sp = fma(sp, r2, -2.5052108385441720e-08); sp = fma(sp, r2, 2.7557319223985893e-06);
    sp = fma(sp, r2, -1.9841269841269841e-04); sp = fma(sp, r2, 8.3333333333333332e-03); sp = fma(sp, r2, -1.6666666666666666e-01); sp = fma(sp * r2, r, r);
    double cp = 4.7794773323873853e-14; cp = fma(cp, r2, -1.1470745597729725e-11); cp = fma(cp, r2, 2.0876756987868100e-09); cp = fma(cp, r2, -2.7557319223985888e-07);
    cp = fma(cp, r2, 2.4801587301587302e-05); cp = fma(cp, r2, -1.3888888888888889e-03); cp = fma(cp, r2, 4.1666666666666664e-02); cp = fma(cp, r2, -0.5); cp = fma(cp, r2, 1.0);
    const int q = ((int)kq) & 3;
    s = (q == 0) ? sp : (q == 1) ? cp : (q == 2) ? -sp : -cp;
    c = (q == 0) ? cp : (q == 1) ? -sp : (q == 2) ? -cp : sp;
}

#ifndef PH_MASK
#define PH_MASK 0x3ff
#endif
__device__ __forceinline__ float sigm_f(float x) { return __builtin_amdgcn_rcpf(1.0f + __builtin_amdgcn_exp2f(-1.4426950408889634f * x)); }
__device__ __forceinline__ float gelu_tanh(float y) { const float t = 1.5957691216057308f * (y + 0.044715f * y * y * y); return y * sigm_f(t); }
__device__ __forceinline__ int crow16(int r, int hi) { return (r & 3) + 8 * (r >> 2) + 4 * hi; }

template <int NOUT> __device__ __forceinline__ void norm_rows(const float* X, int v, int wave, int lane, const LAS float* GS0, const LAS float* SH0, bf16u* O0, const LAS float* GS1, const LAS float* SH1, bf16u* O1) {
    f32x4 gs0[4], sh0[4], gs1[4], sh1[4];
#pragma unroll
    for (int j = 0; j < 4; ++j) { gs0[j] = *(const LAS f32x4*)(GS0 + 256 * j + 4 * lane); sh0[j] = *(const LAS f32x4*)(SH0 + 256 * j + 4 * lane);
        if (NOUT == 2) { gs1[j] = *(const LAS f32x4*)(GS1 + 256 * j + 4 * lane); sh1[j] = *(const LAS f32x4*)(SH1 + 256 * j + 4 * lane); } }
#pragma unroll 2
    for (int i = 0; i < 8; ++i) { const size_t row = (size_t)(64 * v + 8 * wave + i);
        const f32x4* xr = (const f32x4*)(X + row * D) + lane;
        f32x4 x[4]; float s = 0.f;
#pragma unroll
        for (int j = 0; j < 4; ++j) { x[j] = xr[64 * j]; s += (x[j].x * x[j].x + x[j].y * x[j].y) + (x[j].z * x[j].z + x[j].w * x[j].w); }
        const float r = 1.0f / sqrtf(wave_sum(s) * (1.0f / D) + EPS);
        unsigned long long* o0 = (unsigned long long*)(O0 + row * D) + lane;
#pragma unroll
        for (int j = 0; j < 4; ++j) { const f32x4 h = x[j] * r * gs0[j] + sh0[j]; o0[64 * j] = (unsigned long long)pk2(h.x, h.y) | ((unsigned long long)pk2(h.z, h.w) << 32); }
        if (NOUT == 2) { unsigned long long* o1 = (unsigned long long*)(O1 + row * D) + lane;
#pragma unroll
            for (int j = 0; j < 4; ++j) { const f32x4 h = x[j] * r * gs1[j] + sh1[j]; o1[64 * j] = (unsigned long long)pk2(h.x, h.y) | ((unsigned long long)pk2(h.z, h.w) << 32); } }
    }
}
__device__ __forceinline__ void mod_vectors(const float* MODP, const float* bias, const float* g, int b, int cbase, LAS float* GS, LAS float* SH, int tid) {
    for (int k = tid; k < D; k += NWAVES * 64) { float sh = bias[k], sc = bias[D + k];
#pragma unroll
        for (int ks = 0; ks < 8; ++ks) { const float* p = MODP + (size_t)(ks * 8 + b) * 8192 + cbase + k; sh += p[0]; sc += p[D]; }
        GS[k] = g[k] * (1.0f + sc); SH[k] = sh; }
}

template <int PASS> __device__ __forceinline__ void s5_scan(LAS unsigned char* lds, const bf16u* UZ, bf16u* Y1, const float2* ABAR, const float2* AL, const bf16u* BFRAG, const bf16u* CFRAG, float4* E, const float* Dvec, int gw, int NGW, int wave, int lane) {
    LAS unsigned char* Sl = lds + wave * 8704;
    const int j = lane & 31, hi = lane >> 5;
    for (int task = gw; task < 2048; task += NGW) {
        const int seg = task & 7, g = (task >> 3) & 63, bp = task >> 9;
        const float2 a0 = ABAR[g * 64 + j], a1 = ABAR[g * 64 + 32 + j];
        bf16x8 bfr[4], cfr[4];
#pragma unroll
        for (int c = 0; c < 4; ++c) bfr[c] = *(const bf16x8*)(BFRAG + ((size_t)(g * 4 + c) * 64 + lane) * 8);
        if (PASS == 1) {
#pragma unroll
            for (int c = 0; c < 4; ++c) cfr[c] = *(const bf16x8*)(CFRAG + ((size_t)(g * 4 + c) * 64 + lane) * 8); }
        const int seqA = (j >> 2) & 1, timeA = (j & 3) + 4 * (j >> 3);
        const bf16u* ap = UZ + ((size_t)((bp + 4 * seqA) * SEQ + seg * 256 + timeA)) * 2048 + g * 16 + 8 * hi;
        float s0r = 0.f, s0i = 0.f, s1r = 0.f, s1i = 0.f;
        if (PASS == 1) { const float2 l0 = AL[g * 64 + j], l1 = AL[g * 64 + 32 + j];
            for (int k = 0; k < seg; ++k) { const float4 e = E[((size_t)((bp * 64 + g) * 8 + k)) * 64 + lane];
                const float n0r = l0.x * s0r - l0.y * s0i + e.x, n0i = l0.x * s0i + l0.y * s0r + e.y; s0r = n0r; s0i = n0i;
                const float n1r = l1.x * s1r - l1.y * s1i + e.z, n1i = l1.x * s1i + l1.y * s1r + e.w; s1r = n1r; s1i = n1i; } }
        const float dv = (PASS == 1) ? Dvec[g * 16 + (lane & 15)] : 0.f;
        bf16x8 a_next = *(const bf16x8*)ap;
#pragma unroll 1
        for (int tile = 0; tile < 16; ++tile) {
            const bf16x8 a = a_next; if (tile < 15) a_next = *(const bf16x8*)(ap + (size_t)(tile + 1) * 16 * 2048);
            f32x16 acc[4];
#pragma unroll
            for (int c = 0; c < 4; ++c) { f32x16 z = {}; acc[c] = __builtin_amdgcn_mfma_f32_32x32x16_bf16(a, bfr[c], z, 0, 0, 0); }
#pragma unroll
            for (int r = 0; r < 16; ++r) {
                const float n0r = a0.x * s0r - a0.y * s0i + acc[0][r], n0i = a0.x * s0i + a0.y * s0r + acc[1][r]; s0r = n0r; s0i = n0i; acc[0][r] = n0r; acc[1][r] = n0i;
                const float n1r = a1.x * s1r - a1.y * s1i + acc[2][r], n1i = a1.x * s1i + a1.y * s1r + acc[3][r]; s1r = n1r; s1i = n1i; acc[2][r] = n1r; acc[3][r] = n1i; }
            if (PASS == 1) {
#pragma unroll
                for (int r = 0; r < 16; ++r) { const int row = crow16(r, hi);
                    *(LAS unsigned*)(Sl + row * 272 + 4 * j) = pg8::cvt_pk_bf16(acc[0][r], acc[1][r]);
                    *(LAS unsigned*)(Sl + row * 272 + 128 + 4 * j) = pg8::cvt_pk_bf16(acc[2][r], acc[3][r]); }
                LDS_WAIT();
                f32x4 Y[2] = {{0.f, 0.f, 0.f, 0.f}, {0.f, 0.f, 0.f, 0.f}};
#pragma unroll
                for (int mt = 0; mt < 2; ++mt)
#pragma unroll
                    for (int ks = 0; ks < 4; ++ks) { const bf16x8 af = *(const LAS bf16x8*)(Sl + (16 * mt + (lane & 15)) * 272 + (32 * ks + 8 * (lane >> 4)) * 2);
                        Y[mt] = __builtin_amdgcn_mfma_f32_16x16x32_bf16(af, cfr[ks], Y[mt], 0, 0, 0); }
                LDS_WAIT();
                const int ch = lane & 15, lq = lane >> 4;
#pragma unroll
                for (int mt = 0; mt < 2; ++mt)
#pragma unroll
                    for (int q = 0; q < 4; ++q) { const int time = q + 8 * mt + 4 * (lq >> 1), bb = bp + 4 * (lq & 1);
                        const size_t tok = (size_t)bb * SEQ + seg * 256 + tile * 16 + time;
                        const float uval = __uint_as_float((unsigned)UZ[tok * 2048 + g * 16 + ch] << 16);
                        const float y = gelu_tanh(Y[mt][q] + dv * uval);
                        Y1[tok * D + g * 16 + ch] = (bf16u)f2bf(y); }
            }
        }
        if (PASS == 0) E[((size_t)((bp * 64 + g) * 8 + seg)) * 64 + lane] = make_float4(s0r, s0i, s1r, s1i);
    }
}

__global__ void __launch_bounds__(NWAVES * 64, 2) fwd_mega(Args args) {
    extern __shared__ __attribute__((aligned(16))) unsigned char lds_raw[];
    cg::grid_group grid = cg::this_grid();
    LAS unsigned char* lds = (LAS unsigned char*)lds_raw;
    const int tid = threadIdx.x, lane = tid & 63, wave = __builtin_amdgcn_readfirstlane(tid >> 6);
    const int G = gridDim.x, bx = blockIdx.x;
    const int vcu = (G % 8 == 0) ? (bx % 8) * (G / 8) + bx / 8 : bx;
    const int gw = vcu * NWAVES + wave, NGW = G * NWAVES;
    unsigned char* ws = args.ws;
    const float* x = args.in[0]; const float* cnd = args.in[1];
    bf16u* W_IN_A = (bf16u*)(ws + WS_W_IN_A); bf16u* W_GLU = (bf16u*)(ws + WS_W_GLU); bf16u* W_OUT_A = (bf16u*)(ws + WS_W_OUT_A);
    bf16u* W_KV = (bf16u*)(ws + WS_W_KV); bf16u* W_IN_B = (bf16u*)(ws + WS_W_IN_B); bf16u* W_OUT_B = (bf16u*)(ws + WS_W_OUT_B); bf16u* W_F = (bf16u*)(ws + WS_W_F);
    float* MODP = (float*)(ws + WS_MODP); float* GATE = (float*)(ws + WS_GATE);
    float2* ABAR = (float2*)(ws + WS_ABAR); float2* AL = (float2*)(ws + WS_AL); bf16u* BFRAG = (bf16u*)(ws + WS_BFRAG); bf16u* CFRAG = (bf16u*)(ws + WS_CFRAG);
    float4* E = (float4*)(ws + WS_E);
    bf16u* UZ = (bf16u*)(ws + WS_UZ); bf16u* KB = (bf16u*)(ws + WS_K); bf16u* VB = (bf16u*)(ws + WS_V);
    bf16u* R2 = (bf16u*)(ws + WS_R2); bf16u* R3 = (bf16u*)(ws + WS_R3); bf16u* QO = (bf16u*)(ws + WS_QO); bf16u* SZ = (bf16u*)(ws + WS_SZ);
    float* LF = (float*)(ws + WS_LF);
    float* out = args.out;

#if (PH_MASK >> 0) & 1
    {
        LAS float* SC = (LAS float*)(lds + 73728);
        for (int idx = tid; idx < 8 * D; idx += NWAVES * 64) { const int b = idx >> 10, k = idx & 1023; const float cv = cnd[idx]; SC[k * 8 + b] = cv * sigm_f(cv); }
        __syncthreads();
        LAS float* scr = (LAS float*)(lds + wave * 8704);
        constexpr int I_2048 = (D / 64) * (2048 / 32), I_1024 = (D / 64) * (1024 / 32);
        constexpr int NT_ITEMS = 3 * I_2048 + 3 * I_1024, NITEMS = NT_ITEMS + 1024;
        for (int it = gw; it < NITEMS; it += NGW) {
            int r = it;
            if (r < NT_ITEMS) {
                if (r < I_2048) { p0_transpose_item(args.in[5], 2048, D, 2048, W_IN_A, scr, r, lane); continue; } r -= I_2048;
                if (r < I_2048) { p0_transpose_item(args.in[20], 2064, D, 2048, W_KV, scr, r, lane); continue; } r -= I_2048;
                if (r < I_2048) { p0_transpose_item(args.in[26], 2048, D, 2048, W_IN_B, scr, r, lane); continue; } r -= I_2048;
                if (r < I_1024) { p0_transpose_item(args.in[14], 1024, D, 1024, W_GLU, scr, r, lane); continue; } r -= I_1024;
                if (r < I_1024) { p0_transpose_item(args.in[16], 1024, D, 1024, W_OUT_A, scr, r, lane); continue; } r -= I_1024;
                p0_transpose_item(args.in[28], 1024, D, 1024, W_OUT_B, scr, r, lane); continue;
            }
            r -= NT_ITEMS;
            const int col = (r >> 3) * 64 + lane, ks = r & 7;
            const float* W; int ldw, cc;
            if (col < 3072) { W = args.in[3]; ldw = 3072; cc = col; } else if (col < 5120) { W = args.in[18]; ldw = 2048; cc = col - 3072; } else { W = args.in[24]; ldw = 3072; cc = col - 5120; }
            float acc8[8] = {0.f, 0.f, 0.f, 0.f, 0.f, 0.f, 0.f, 0.f};
            const float* wp = W + (size_t)(ks * 128) * ldw + cc;
#pragma unroll 8
            for (int k = 0; k < 128; ++k) { const float w = wp[(size_t)k * ldw];
                const f32x4 s0 = *(const LAS f32x4*)(SC + (ks * 128 + k) * 8), s1 = *(const LAS f32x4*)(SC + (ks * 128 + k) * 8 + 4);
                acc8[0] += s0.x * w; acc8[1] += s0.y * w; acc8[2] += s0.z * w; acc8[3] += s0.w * w; acc8[4] += s1.x * w; acc8[5] += s1.y * w; acc8[6] += s1.z * w; acc8[7] += s1.w * w; }
#pragma unroll
            for (int b = 0; b < 8; ++b) MODP[(size_t)(ks * 8 + b) * 8192 + col] = acc8[b];
        }
        const int gtid = vcu * (NWAVES * 64) + tid, NGT = G * NWAVES * 64;
        for (int idx = gtid; idx < 16 * D; idx += NGT) { const int jf = idx >> 10, k = idx & 1023; W_F[idx] = (bf16u)f2bf(args.in[20][(size_t)k * 2064 + 2048 + jf]); }
        for (int idx = gtid; idx < NG * NST; idx += NGT) {
            const int g = idx >> 6, p = idx & 63;
            const double dt = exp((double)args.in[6][g]), ar = (double)args.in[7][idx], ai = (double)args.in[8][idx];
            const double mag = exp(ar * dt); double sn, cs; sincos_d(ai * dt, sn, cs);
            const double abr = mag * cs, abi = mag * sn, den = ar * ar + ai * ai, nr = abr - 1.0;
            const double cr = (nr * ar + abi * ai) / den, ci = (abi * ar - nr * ai) / den;
            ABAR[idx] = make_float2((float)abr, (float)abi);
            double pr = abr, pi = abi;
#pragma unroll 1
            for (int q = 0; q < 8; ++q) { const double t = pr * pr - pi * pi; pi = 2.0 * pr * pi; pr = t; }
            AL[idx] = make_float2((float)pr, (float)pi);
            const float* Bre = args.in[9] + (size_t)idx * 16; const float* Bim = args.in[10] + (size_t)idx * 16;
            const int c0 = (p >> 5) * 2;
#pragma unroll 1
            for (int ch = 0; ch < 16; ++ch) { const double br = Bre[ch], bi = Bim[ch]; const double bbr = cr * br - ci * bi, bbi = cr * bi + ci * br;
                const int l = (ch >> 3) * 32 + (p & 31), jj = ch & 7;
                BFRAG[((size_t)(g * 4 + c0) * 64 + l) * 8 + jj] = (bf16u)f2bf((float)bbr); BFRAG[((size_t)(g * 4 + c0 + 1) * 64 + l) * 8 + jj] = (bf16u)f2bf((float)bbi); }
#pragma unroll 1
            for (int ch = 0; ch < 16; ++ch) { const float cre = args.in[11][(size_t)(g * 16 + ch) * 64 + p], cim = args.in[12][(size_t)(g * 16 + ch) * 64 + p];
#pragma unroll
                for (int ri = 0; ri < 2; ++ri) { const int kap = 2 * p + ri, ks2 = kap >> 5, l = ((kap & 31) >> 3) * 16 + ch, jj = kap & 7;
                    CFRAG[((size_t)(g * 4 + ks2) * 64 + l) * 8 + jj] = (bf16u)f2bf(ri == 0 ? cre : -cim); } }
        }
    }
#endif
    grid.sync();

#if (PH_MASK >> 1) & 1
    {
        if (tid < 64) { const int idx = vcu * 64 + tid; if (idx < 2 * 8 * D) { const int which = idx >> 13, b = (idx >> 10) & 7, n = idx & 1023;
                const int col = which == 0 ? 2048 + n : 5120 + 2048 + n; float s = which == 0 ? args.in[4][2048 + n] : args.in[25][2048 + n];
#pragma unroll
                for (int ks = 0; ks < 8; ++ks) s += MODP[(size_t)(ks * 8 + b) * 8192 + col];
                GATE[idx] = s; } }
        LAS float* GS = (LAS float*)lds; LAS float* SH = GS + D;
        for (int v = vcu; v < M / 64; v += G) {
            __syncthreads();
            mod_vectors(MODP, args.in[4], args.in[2], v >> 5, 0, GS, SH, tid);
            __syncthreads();
            norm_rows<1>(x, v, wave, lane, GS, SH, R2, GS, SH, R2);
        }
    }
#endif
    grid.sync();

#if (PH_MASK >> 2) & 1
    { pg8::Gemm g{R2, W_IN_A, M, 2048, D}; pg8::StaticOrder S; S.init(M, 2048, G, bx); pg8::EpiStore Ep{UZ, 2048};
      pg8::gemm_phase<pg8::EpiStore, pg8::StaticOrder, true, true>(lds, g, S, Ep); }
#endif
    grid.sync();

#if (PH_MASK >> 3) & 1
    s5_scan<0>(lds, UZ, R2, ABAR, AL, BFRAG, CFRAG, E, args.in[13], gw, NGW, wave, lane);
#endif
    grid.sync();
    s5_scan<1>(lds, UZ, R2, ABAR, AL, BFRAG, CFRAG, E, args.in[13], gw, NGW, wave, lane);
    grid.sync();

#if (PH_MASK >> 4) & 1
    { pg8::Gemm g{R2, W_GLU, M, 1024, D}; pg8::StaticOrder S; S.init(M, 1024, G, bx); pg8::EpiGlu Ep{R2, UZ + 1024, args.in[15], R3};
      pg8::gemm_phase<pg8::EpiGlu, pg8::StaticOrder, true, true>(lds, g, S, Ep); }
#endif
    grid.sync();

#if (PH_MASK >> 5) & 1
    { pg8::Gemm g{R3, W_OUT_A, M, 1024, D}; pg8::StaticOrder S; S.init(M, 1024, G, bx); pg8::EpiRes Ep{x, GATE, out};
      pg8::gemm_phase<pg8::EpiRes, pg8::StaticOrder, true, true>(lds, g, S, Ep); }
#endif
    grid.sync();

#if (PH_MASK >> 6) & 1
    {
        LAS float* GS0 = (LAS float*)lds; LAS float* SH0 = GS0 + D; LAS float* GS1 = SH0 + D; LAS float* SH1 = GS1 + D;
        for (int v = vcu; v < M / 64; v += G) {
            __syncthreads();
            mod_vectors(MODP, args.in[19], args.in[17], v >> 5, 3072, GS0, SH0, tid);
            mod_vectors(MODP, args.in[25], args.in[23], v >> 5, 5120, GS1, SH1, tid);
            __syncthreads();
            norm_rows<2>(out, v, wave, lane, GS0, SH0, R2, GS1, SH1, R3);
        }
    }
#endif
    grid.sync();

#if (PH_MASK >> 7) & 1
    {
        for (int t = gw; t < M / 16; t += NGW) {
            f32x4 acc = {0.f, 0.f, 0.f, 0.f};
            const bf16u* ap = R2 + (size_t)(16 * t + (lane & 15)) * D + 8 * (lane >> 4); const bf16u* bp = W_F + (size_t)(lane & 15) * D + 8 * (lane >> 4);
#pragma unroll 8
            for (int ks = 0; ks < 32; ++ks) acc = __builtin_amdgcn_mfma_f32_16x16x32_bf16(*(const bf16x8*)(ap + ks * 32), *(const bf16x8*)(bp + ks * 32), acc, 0, 0, 0);
            const float fb = args.in[21][lane & 15];
#pragma unroll
            for (int r = 0; r < 4; ++r) { const float xl = acc[r] + fb; const float ls = fminf(xl, 0.f) - log1pf(__expf(-fabsf(xl)));
                LF[(size_t)(16 * t + 4 * (lane >> 4) + r) * NH + (lane & 15)] = ls; }
        }
        { pg8::Gemm g{R2, W_KV, M, 2048, D}; pg8::StaticOrder S; S.init(M, 2048, G, bx); pg8::EpiHeadNorm<false> Ep{KB, VB, args.in[22], 1.0f};
          pg8::gemm_phase<pg8::EpiHeadNorm<false>, pg8::StaticOrder, true, true>(lds, g, S, Ep); }
        { pg8::Gemm g{R3, W_IN_B, M, 2048, D}; pg8::StaticOrder S; S.init(M, 2048, G, bx); pg8::EpiHeadNorm<true> Ep{QO, SZ, args.in[27], C2};
          pg8::gemm_phase<pg8::EpiHeadNorm<true>, pg8::StaticOrder, true, true>(lds, g, S, Ep); }
    }
#endif
    grid.sync();

#if (PH_MASK >> 8) & 1
    { const attn_body::AttnTensors AT{(const attn_body::bf16*)QO, (const attn_body::bf16*)KB, (const attn_body::bf16*)VB, (attn_body::bf16*)QO, (const attn_body::bf16*)SZ, LF};
      attn_body::attn_phase<8>((char*)lds_raw, AT, vcu, G); }
#endif
    grid.sync();

#if (PH_MASK >> 9) & 1
    { pg8::Gemm g{QO, W_OUT_B, M, 1024, D}; pg8::StaticOrder S; S.init(M, 1024, G, bx); pg8::EpiRes Ep{out, GATE + 8 * D, out};
      pg8::gemm_phase<pg8::EpiRes, pg8::StaticOrder, true, true>(lds, g, S, Ep); }
#endif
}

extern "C" void kernel_launch(void* const* d_in, const int* in_sizes, int n_in, void* d_out, int out_size, void* d_ws, size_t ws_size, hipStream_t stream) {
    static int grid = 0;
    if (grid == 0) {
        if (n_in != 29 || out_size != M * D || ws_size < WS_END) { fprintf(stderr, "kernel_launch: unexpected problem (n_in %d out %d ws %zu)\n", n_in, out_size, ws_size); grid = -1; return; }
        int dev = 0, cus = 0, per_cu = 0;
        (void)hipGetDevice(&dev); (void)hipDeviceGetAttribute(&cus, hipDeviceAttributeMultiprocessorCount, dev);
        if (hipFuncSetAttribute((const void*)fwd_mega, hipFuncAttributeMaxDynamicSharedMemorySize, LDS_BYTES) != hipSuccess) { fprintf(stderr, "kernel_launch: hipFuncSetAttribute failed\n"); grid = -1; return; }
        if (hipOccupancyMaxActiveBlocksPerMultiprocessor(&per_cu, (const void*)fwd_mega, NWAVES * 64, LDS_BYTES) != hipSuccess || per_cu < 1) { fprintf(stderr, "kernel_launch: occupancy query says %d\n", per_cu); per_cu = 1; }
        (void)hipGetLastError();
        grid = cus > 0 ? cus : 256;
    }
    if (grid < 0) return;
    Args a{};
    for (int i = 0; i < 29; ++i) a.in[i] = (const float*)d_in[i];
    a.out = (float*)d_out; a.ws = (unsigned char*)d_ws;
    void* kargs[] = {&a};
    const hipError_t e = hipLaunchCooperativeKernel((const void*)fwd_mega, dim3(grid), dim3(NWAVES * 64), kargs, LDS_BYTES, stream);
    if (e != hipSuccess) fprintf(stderr, "cooperative launch failed: %s (grid %d)\n", hipGetErrorString(e), grid);
}
```

```cpp
#include <hip/hip_runtime.h>
#include <hip/hip_cooperative_groups.h>
#include <cstdio>
#include <cstdint>
namespace cg = cooperative_groups;
namespace pg8 {
#define PG8_LAS __attribute__((address_space(3)))
typedef unsigned short bf16_t;
typedef short bf16x8 __attribute__((ext_vector_type(8)));
typedef float f32x4 __attribute__((ext_vector_type(4)));
typedef unsigned u32x4 __attribute__((ext_vector_type(4)));
constexpr int BM = 256, BK = 64, HALF = 128, HTB = HALF * BK * 2  , STAGE_BYTES = 8 * HTB, NXCD = 8, WGM = 8;

__host__ __device__ __forceinline__ int lds_byte(int r, int c) { const int st = (r >> 4) * 2 + (c >> 5), rr = r & 15, cc = c & 31, ob = rr * 64 + cc * 2; return st * 1024 + (ob ^ (((ob >> 9) & 1) << 5)); }
__host__ __device__ __forceinline__ void stage_rc(int b, int& R, int& C) { const int st = b / 1024, sb = b % 1024, swz = sb ^ (((sb >> 9) & 1) << 5); R = (st >> 1) * 16 + swz / 64; C = (st & 1) * 32 + (swz % 64) / 2; }
__host__ __device__ __forceinline__ int perm32(int rho) { const int n = rho >> 4, i = rho & 15; return 8 * (i >> 2) + 4 * n + (i & 3); }

struct Unit { int pm, pn; };
struct Gemm { const bf16_t* A; const bf16_t* Bt; int M, N, K; };

struct StaticOrder {
    int nM, nN, nwg, G, c;
    __host__ __device__ void init(int M, int N, int G_, int c_) { nM = M / BM; nN = N / BM; nwg = nM * nN; G = G_; c = c_; }
    __host__ __device__ bool next(int i, Unit& u) const {
        const long L = (long)i * G + c; if (L >= nwg) return false;
        int wgid = (int)L; { const int q = nwg / NXCD, r = nwg % NXCD, xcd = wgid % NXCD, off = wgid / NXCD; wgid = (xcd < r ? xcd * (q + 1) : r * (q + 1) + (xcd - r) * q) + off; }
        const int nig = WGM * nN, gid = wgid / nig, fm = gid * WGM, gsz = (nM - fm) < WGM ? (nM - fm) : WGM;
        u.pm = fm + ((wgid % nig) % gsz); u.pn = (wgid % nig) / gsz; return true;
    }
    __device__ __forceinline__ void a_ready(const Unit&) const {}
    __device__ __forceinline__ void done(const Unit&) const {}
};

__device__ __forceinline__ unsigned cvt_pk_bf16(float lo, float hi) { unsigned r; asm volatile("v_cvt_pk_bf16_f32 %0, %1, %2" : "=v"(r) : "v"(lo), "v"(hi)); return r; }
typedef float f32x2 __attribute__((ext_vector_type(2)));
typedef unsigned u32x4e __attribute__((ext_vector_type(4)));
__device__ __forceinline__ float bf_lo(unsigned u) { return __uint_as_float(u << 16); }
__device__ __forceinline__ float bf_hi(unsigned u) { return __uint_as_float(u & 0xffff0000u); }
__device__ __forceinline__ float sigm(float x) { return __builtin_amdgcn_rcpf(1.0f + __builtin_amdgcn_exp2f(-1.4426950408889634f * x)); }
__device__ __forceinline__ u32x4e pack8(const f32x4& a, const f32x4& b) { u32x4e w; w.x = cvt_pk_bf16(a[0], a[1]); w.y = cvt_pk_bf16(a[2], a[3]); w.z = cvt_pk_bf16(b[0], b[1]); w.w = cvt_pk_bf16(b[2], b[3]); return w; }

struct EpiStore {
    static constexpr bool PERM = true, AFTER_DRAIN = false;
    bf16_t* O; int ldc;
    __device__ __forceinline__ void operator()(const f32x4 (&acc)[2][2][4][2], const Unit& u, int wr, int wc, int fr, int fq) const {
        const int row0 = u.pm * BM + wr * 64 + fr, colb = u.pn * BM + wc * 64 + 8 * fq;
#pragma unroll
        for (int ai = 0; ai < 2; ++ai)
#pragma unroll
            for (int m = 0; m < 4; ++m) { bf16_t* rowp = O + (size_t)(row0 + ai * HALF + m * 16) * ldc + colb;
#pragma unroll
                for (int bj = 0; bj < 2; ++bj) *(u32x4e*)(rowp + bj * 32) = pack8(acc[ai][bj][m][0], acc[ai][bj][m][1]); }
    }
};
struct EpiGlu {
    static constexpr bool PERM = true, AFTER_DRAIN = false;
    const bf16_t* Y1; const bf16_t* Z; const float* bias; bf16_t* O;
    __device__ __forceinline__ void operator()(const f32x4 (&acc)[2][2][4][2], const Unit& u, int wr, int wc, int fr, int fq) const {
        const int row0 = u.pm * BM + wr * 64 + fr, colb = u.pn * BM + wc * 64 + 8 * fq;
        f32x4 bv[2][2];
#pragma unroll
        for (int bj = 0; bj < 2; ++bj)
#pragma unroll
            for (int n = 0; n < 2; ++n) bv[bj][n] = *(const f32x4*)(bias + colb + bj * 32 + 4 * n);
#pragma unroll
        for (int ai = 0; ai < 2; ++ai)
#pragma unroll
            for (int m = 0; m < 4; ++m) { const size_t row = (size_t)(row0 + ai * HALF + m * 16);
#pragma unroll
                for (int bj = 0; bj < 2; ++bj) { const int col = colb + bj * 32;
                    const u32x4e yv = *(const u32x4e*)(Y1 + row * 1024 + col), zv = *(const u32x4e*)(Z + row * 2048 + col);
                    f32x4 o0, o1;
#pragma unroll
                    for (int k = 0; k < 2; ++k) { const float g0 = acc[ai][bj][m][0][2 * k] + bv[bj][0][2 * k], g1 = acc[ai][bj][m][0][2 * k + 1] + bv[bj][0][2 * k + 1];
                        const float z0 = bf_lo(zv[k]), z1 = bf_hi(zv[k]);
                        o0[2 * k] = bf_lo(yv[k]) * sigm(g0) * z0 * sigm(z0); o0[2 * k + 1] = bf_hi(yv[k]) * sigm(g1) * z1 * sigm(z1); }
#pragma unroll
                    for (int k = 0; k < 2; ++k) { const float g0 = acc[ai][bj][m][1][2 * k] + bv[bj][1][2 * k], g1 = acc[ai][bj][m][1][2 * k + 1] + bv[bj][1][2 * k + 1];
                        const float z0 = bf_lo(zv[2 + k]), z1 = bf_hi(zv[2 + k]);
                        o1[2 * k] = bf_lo(yv[2 + k]) * sigm(g0) * z0 * sigm(z0); o1[2 * k + 1] = bf_hi(yv[2 + k]) * sigm(g1) * z1 * sigm(z1); }
                    *(u32x4e*)(O + row * 1024 + col) = pack8(o0, o1); } }
    }
};
struct EpiRes {
    static constexpr bool PERM = true, AFTER_DRAIN = false;
    const float* X; const float* gate; float* OUT;
    __device__ __forceinline__ void operator()(const f32x4 (&acc)[2][2][4][2], const Unit& u, int wr, int wc, int fr, int fq) const {
        const int row0 = u.pm * BM + wr * 64 + fr, colb = u.pn * BM + wc * 64 + 8 * fq;
        const float* gp = gate + (size_t)(u.pm >> 3) * 1024 + colb;
        f32x4 gv[2][2];
#pragma unroll
        for (int bj = 0; bj < 2; ++bj)
#pragma unroll
            for (int n = 0; n < 2; ++n) gv[bj][n] = *(const f32x4*)(gp + bj * 32 + 4 * n);
#pragma unroll
        for (int ai = 0; ai < 2; ++ai)
#pragma unroll
            for (int m = 0; m < 4; ++m) { const size_t off = (size_t)(row0 + ai * HALF + m * 16) * 1024 + colb;
#pragma unroll
                for (int bj = 0; bj < 2; ++bj)
#pragma unroll
                    for (int n = 0; n < 2; ++n) { const f32x4 xv = *(const f32x4*)(X + off + bj * 32 + 4 * n);
                        *(f32x4*)(OUT + off + bj * 32 + 4 * n) = xv + gv[bj][n] * acc[ai][bj][m][n]; } }
    }
};
template <bool SILU> struct EpiHeadNorm {
    static constexpr bool PERM = true, AFTER_DRAIN = false;
    bf16_t* O0; bf16_t* O1; const float* g; float scale;
    __device__ __forceinline__ void operator()(const f32x4 (&acc)[2][2][4][2], const Unit& u, int wr, int wc, int fr, int fq) const {
        const int row0 = u.pm * BM + wr * 64 + fr;
        if (u.pn < 4) {
            const int colb = u.pn * BM + wc * 64 + 8 * fq;
            f32x4 gv[2][2];
#pragma unroll
            for (int bj = 0; bj < 2; ++bj)
#pragma unroll
                for (int n = 0; n < 2; ++n) gv[bj][n] = *(const f32x4*)(g + bj * 32 + 8 * fq + 4 * n) * scale;
#pragma unroll
            for (int ai = 0; ai < 2; ++ai)
#pragma unroll
                for (int m = 0; m < 4; ++m) { float s = 0.f;
#pragma unroll
                    for (int bj = 0; bj < 2; ++bj)
#pragma unroll
                        for (int n = 0; n < 2; ++n) { const f32x4 x = acc[ai][bj][m][n]; s += (x[0] * x[0] + x[1] * x[1]) + (x[2] * x[2] + x[3] * x[3]); }
                    s += __shfl_xor(s, 16); s += __shfl_xor(s, 32);
                    const float r = 1.0f / sqrtf(s * (1.0f / 64.0f) + 1e-6f);
                    bf16_t* rowp = O0 + (size_t)(row0 + ai * HALF + m * 16) * 1024 + colb;
#pragma unroll
                    for (int bj = 0; bj < 2; ++bj) *(u32x4e*)(rowp + bj * 32) = pack8(acc[ai][bj][m][0] * r * gv[bj][0], acc[ai][bj][m][1] * r * gv[bj][1]); }
        } else {
            const int colb = (u.pn - 4) * BM + wc * 64 + 8 * fq;
#pragma unroll
            for (int ai = 0; ai < 2; ++ai)
#pragma unroll
                for (int m = 0; m < 4; ++m) { bf16_t* rowp = O1 + (size_t)(row0 + ai * HALF + m * 16) * 1024 + colb;
#pragma unroll
                    for (int bj = 0; bj < 2; ++bj) { f32x4 a = acc[ai][bj][m][0], b = acc[ai][bj][m][1];
                        if (SILU) {
#pragma unroll
                            for (int k = 0; k < 4; ++k) { a[k] = a[k] * sigm(a[k]); b[k] = b[k] * sigm(b[k]); } }
                        *(u32x4e*)(rowp + bj * 32) = pack8(a, b); } }
        }
    }
};
template <class Epi, class Sched, bool ALIGN_EPI = false, bool SP2 = false>
__device__ __forceinline__ void gemm_phase(PG8_LAS unsigned char* lds, const Gemm g, const Sched& S, const Epi& E) {
    const int tid = threadIdx.x, wid = __builtin_amdgcn_readfirstlane(tid >> 6), lane = tid & 63, wr = wid >> 2, wc = wid & 3, fr = lane & 15, fq = lane >> 4;
    const int K = g.K, nt = K / BK;
    unsigned voffA[2], voffB[2];
#pragma unroll
    for (int i = 0; i < 2; ++i) { int R, C; stage_rc(tid * 16 + i * 8192, R, C); const int Rb = Epi::PERM ? ((R & ~31) + perm32(R & 31)) : R;
        voffA[i] = (unsigned)(R * K + C) * 2u; voffB[i] = (unsigned)(Rb * K + C) * 2u; }
    const size_t kstep = (size_t)(BK * 2);
    const size_t hstep = (size_t)HALF * K * 2;
    const size_t tstep = 2 * hstep;
    const unsigned ldsw = (unsigned)wid * 1024u;
    const int aoff = lds_byte(wr * 64 + fr, fq * 8), boff = lds_byte(wc * 32 + fr, fq * 8);
#define PG8_SA(b, h) (((b) * 2 + (h)) * HTB)
#define PG8_SB(b, h) ((4 + (b) * 2 + (h)) * HTB)
#define PG8_STAGE(bufoff, gbase, voff) do { _Pragma("unroll") for (int _i = 0; _i < 2; ++_i) \
        __builtin_amdgcn_global_load_lds((const unsigned*)((const char*)(gbase) + (voff)[_i]), (PG8_LAS unsigned*)(lds + (bufoff) + ldsw + _i * 8192), 16, 0, 0); } while (0)
#define PG8_LDA(dst, b, h) do { _Pragma("unroll") for (int m = 0; m < 4; ++m) _Pragma("unroll") for (int k = 0; k < 2; ++k) dst[m][k] = *(const PG8_LAS bf16x8*)(lds + PG8_SA(b, h) + aoff + m * 2048 + k * 1024); } while (0)
#define PG8_LDB(dst, b, h) do { _Pragma("unroll") for (int n = 0; n < 2; ++n) _Pragma("unroll") for (int k = 0; k < 2; ++k) dst[n][k] = *(const PG8_LAS bf16x8*)(lds + PG8_SB(b, h) + boff + n * 2048 + k * 1024); } while (0)
#define PG8_MMA(ai, bj, At, Bt) do { __builtin_amdgcn_s_setprio(1); _Pragma("unroll") for (int m = 0; m < 4; ++m) _Pragma("unroll") for (int n = 0; n < 2; ++n) _Pragma("unroll") for (int k = 0; k < 2; ++k) \
        acc[ai][bj][m][n] = __builtin_amdgcn_mfma_f32_16x16x32_bf16(Bt[n][k], At[m][k], acc[ai][bj][m][n], 0, 0, 0); __builtin_amdgcn_s_setprio(0); } while (0)
#define PG8_WAIT_V(n) asm volatile("s_waitcnt vmcnt(" #n ")" ::: "memory")
#define PG8_WAIT_L(n) asm volatile("s_waitcnt lgkmcnt(" #n ")" ::: "memory")
#define PG8_BAR __builtin_amdgcn_s_barrier()
#define PG8_SCHED __builtin_amdgcn_sched_barrier(0)
    Unit cur, nxt; int ui = 0;
    if (!S.next(0, cur)) return;
    f32x4 acc[2][2][4][2];
#pragma unroll
    for (int a = 0; a < 2; ++a)
#pragma unroll
        for (int b = 0; b < 2; ++b)
#pragma unroll
            for (int m = 0; m < 4; ++m)
#pragma unroll
                for (int n = 0; n < 2; ++n) acc[a][b][m][n] = (f32x4){0.f, 0.f, 0.f, 0.f};
    bf16x8 At[4][2], B0[2][2], B1[2][2];
    const char* cA = (const char*)g.A + (size_t)cur.pm * tstep; const char* cB = (const char*)g.Bt + (size_t)cur.pn * tstep;
    S.a_ready(cur);
    if constexpr (SP2) {
        PG8_STAGE(PG8_SB(0, 0), cB, voffB); PG8_STAGE(PG8_SB(0, 1), cB + hstep, voffB); PG8_STAGE(PG8_SA(0, 0), cA, voffA); PG8_STAGE(PG8_SA(0, 1), cA + hstep, voffA);
        if (wr == 1) PG8_BAR;
        PG8_WAIT_V(2); PG8_BAR;
        PG8_STAGE(PG8_SB(1, 0), cB + kstep, voffB); PG8_STAGE(PG8_SA(1, 0), cA + kstep, voffA); PG8_STAGE(PG8_SB(1, 1), cB + hstep + kstep, voffB);
        PG8_WAIT_V(6); PG8_BAR;
    } else {
        PG8_STAGE(PG8_SB(0, 0), cB, voffB); PG8_STAGE(PG8_SA(0, 0), cA, voffA); PG8_STAGE(PG8_SB(0, 1), cB + hstep, voffB); PG8_STAGE(PG8_SA(0, 1), cA + hstep, voffA);
        if (wr == 1) PG8_BAR;
        PG8_WAIT_V(4); PG8_BAR;
        PG8_STAGE(PG8_SB(1, 0), cB + kstep, voffB); PG8_STAGE(PG8_SA(1, 0), cA + kstep, voffA); PG8_STAGE(PG8_SB(1, 1), cB + hstep + kstep, voffB);
        PG8_WAIT_V(6); PG8_BAR;
    }
    for (;;) {
        const bool has_next = S.next(ui + 1, nxt);
        const char* nA = has_next ? (const char*)g.A + (size_t)nxt.pm * tstep : cA; const char* nB = has_next ? (const char*)g.Bt + (size_t)nxt.pn * tstep : cB;
        for (int t = 0; t < nt; t += 2) {
            const bool last = (t == nt - 2);
            const char* a1 = cA + (size_t)(t + 1) * kstep;
            const char* a2 = last ? nA : cA + (size_t)(t + 2) * kstep; const char* b2 = last ? nB : cB + (size_t)(t + 2) * kstep;
            const char* a3 = a2 + kstep; const char* b3 = b2 + kstep;
            if (last && has_next) S.a_ready(nxt);
            if constexpr (SP2) {
            PG8_LDB(B0, 0, 0); PG8_LDB(B1, 0, 1); PG8_SCHED; PG8_LDA(At, 0, 0); PG8_STAGE(PG8_SA(1, 1), a1 + hstep, voffA);
            PG8_WAIT_V(8); PG8_WAIT_L(0); PG8_BAR; PG8_MMA(0, 0, At, B0); PG8_MMA(0, 1, At, B1); PG8_BAR; PG8_SCHED;
            PG8_LDA(At, 0, 1); PG8_STAGE(PG8_SB(0, 0), b2, voffB); PG8_STAGE(PG8_SB(0, 1), b2 + hstep, voffB); PG8_STAGE(PG8_SA(0, 0), a2, voffA);
            PG8_WAIT_V(8); PG8_WAIT_L(0); PG8_BAR; PG8_MMA(1, 0, At, B0); PG8_MMA(1, 1, At, B1); PG8_BAR; PG8_SCHED;
            PG8_LDB(B0, 1, 0); PG8_LDB(B1, 1, 1); PG8_SCHED; PG8_LDA(At, 1, 0); PG8_STAGE(PG8_SA(0, 1), a2 + hstep, voffA);
            PG8_WAIT_V(8); PG8_WAIT_L(0); PG8_BAR; PG8_MMA(0, 0, At, B0); PG8_MMA(0, 1, At, B1); PG8_BAR; PG8_SCHED;
            PG8_LDA(At, 1, 1); PG8_STAGE(PG8_SB(1, 0), b3, voffB); PG8_STAGE(PG8_SB(1, 1), b3 + hstep, voffB); PG8_STAGE(PG8_SA(1, 0), a3, voffA);
            PG8_WAIT_V(8); PG8_WAIT_L(0); PG8_BAR; PG8_MMA(1, 0, At, B0); PG8_MMA(1, 1, At, B1); PG8_BAR; PG8_SCHED;
            } else {
            PG8_LDB(B0, 0, 0); PG8_SCHED; PG8_LDA(At, 0, 0); PG8_STAGE(PG8_SA(1, 1), a1 + hstep, voffA);
            PG8_WAIT_L(8); PG8_BAR; PG8_WAIT_L(0); PG8_MMA(0, 0, At, B0); PG8_BAR; PG8_SCHED;
            PG8_LDB(B1, 0, 1); PG8_STAGE(PG8_SB(0, 0), b2, voffB);
            PG8_BAR; PG8_WAIT_L(0); PG8_MMA(0, 1, At, B1); PG8_BAR;
            PG8_LDA(At, 0, 1); PG8_STAGE(PG8_SA(0, 0), a2, voffA);
            PG8_BAR; PG8_WAIT_L(0); PG8_MMA(1, 0, At, B0); PG8_BAR; PG8_SCHED;
            PG8_STAGE(PG8_SB(0, 1), b2 + hstep, voffB);
            PG8_WAIT_V(6); PG8_BAR; PG8_MMA(1, 1, At, B1); PG8_BAR;
            PG8_LDB(B0, 1, 0); PG8_SCHED; PG8_LDA(At, 1, 0); PG8_STAGE(PG8_SA(0, 1), a2 + hstep, voffA);
            PG8_WAIT_L(8); PG8_BAR; PG8_WAIT_L(0); PG8_MMA(0, 0, At, B0); PG8_BAR; PG8_SCHED;
            PG8_LDB(B1, 1, 1); PG8_STAGE(PG8_SB(1, 0), b3, voffB);
            PG8_BAR; PG8_WAIT_L(0); PG8_MMA(0, 1, At, B1); PG8_BAR;
            PG8_LDA(At, 1, 1); PG8_STAGE(PG8_SA(1, 0), a3, voffA);
            PG8_BAR; PG8_WAIT_L(0); PG8_MMA(1, 0, At, B0); PG8_BAR; PG8_SCHED;
            PG8_STAGE(PG8_SB(1, 1), b3 + hstep, voffB);
            PG8_WAIT_V(6); PG8_BAR; PG8_MMA(1, 1, At, B1); PG8_BAR;
            }
        }
        if constexpr (ALIGN_EPI) { if (wr == 0) PG8_BAR; }
        if constexpr (!Epi::AFTER_DRAIN) { E(acc, cur, wr, wc, fr, fq); S.done(cur); }
        if (!has_next) break;
#pragma unroll
        for (int a = 0; a < 2; ++a)
#pragma unroll
            for (int b = 0; b < 2; ++b)
#pragma unroll
                for (int m = 0; m < 4; ++m)
#pragma unroll
                    for (int n = 0; n < 2; ++n) acc[a][b][m][n] = (f32x4){0.f, 0.f, 0.f, 0.f};
        cur = nxt; cA = nA; cB = nB; ++ui;
        if constexpr (ALIGN_EPI) { if (wr == 1) PG8_BAR; }
    }
    PG8_WAIT_V(0);
    if constexpr (!ALIGN_EPI) { if (wr == 0) PG8_BAR; }
    PG8_BAR;
    if constexpr (Epi::AFTER_DRAIN) { E.fused(acc, cur, wr, wc, fr, fq, lds, wid, lane); S.done(cur); }
#undef PG8_SA
#undef PG8_SB
#undef PG8_STAGE
#undef PG8_LDA
#undef PG8_LDB
#undef PG8_MMA
#undef PG8_WAIT_V
#undef PG8_WAIT_L
#undef PG8_BAR
#undef PG8_SCHED
}
}
#include <hip/hip_bf16.h>
#include <cmath>
namespace attn_body {
using bf16=__hip_bfloat16;
using bf16x8=__attribute__((ext_vector_type(8)))short;
using s16x4=__attribute__((ext_vector_type(4)))short;
using f32x16=__attribute__((ext_vector_type(16)))float;
using u32x4=__attribute__((ext_vector_type(4)))unsigned;
constexpr int BATCH=8,NHEAD=16,SEQ=2048,D=64,DM=NHEAD*D;
constexpr int NW=8,QBLK=32,QB=QBLK*NW,KVBLK=64,NQB=SEQ/QB;
constexpr int ATTN_PITCH=DM, ATTN_UNIT_ROWS=QB;
__device__ __forceinline__ int crow(int r,int hi){return (r&3)+8*(r>>2)+4*hi;}
#define SBAR() __builtin_amdgcn_sched_barrier(0)
__device__ __forceinline__ void cmask(f32x16&p0,f32x16&p1,int jb,int qrel,int hi){
  const float NEG=-INFINITY; int d=qrel-(64*jb+4*hi); asm volatile("":"+v"(d));
  #pragma unroll
  for(int r=0;r<16;++r){const int c=(r&3)+8*(r>>2); if(c>d)p0[r]=NEG; if(c+32>d)p1[r]=NEG;}
}

constexpr int NSLOT=3, SLOTB=8192;
constexpr int LDS_K=0, LDS_V=NSLOT*SLOTB, LDS_WS=2*NSLOT*SLOTB, LDS_OST=LDS_WS+NW*64*4, LDS_FS=LDS_OST+NW*4096, LDS_SCAN=LDS_FS+SEQ*4, LDS_BYTES=LDS_SCAN+256; typedef float f32x4v __attribute__((ext_vector_type(4)));
constexpr float C2=0.125f*1.4426950408889634f;
__device__ __forceinline__ void glds16(const void*gsrc,unsigned lds_dst){unsigned keep;
  asm volatile("s_mov_b32 %0, m0\n\ts_mov_b32 m0, %2\n\ts_nop 0\n\tglobal_load_lds_dwordx4 %1, off\n\ts_mov_b32 m0, %0":"=&s"(keep):"v"(gsrc),"s"(lds_dst):"memory");}
__device__ __forceinline__ float max3f(float a,float b,float c){float r;asm("v_max3_f32 %0, %1, %2, %3":"=v"(r):"v"(a),"v"(b),"v"(c));return r;}
__device__ __forceinline__ float max2f(float a,float b){float r;asm("v_max_f32_e32 %0, %1, %2":"=v"(r):"v"(a),"v"(b));return r;}
__device__ __forceinline__ float fadd_s(float a,float b){float r;asm("v_add_f32_e32 %0, %1, %2":"=v"(r):"v"(a),"v"(b));return r;}
__device__ __forceinline__ float fsub_s(float a,float b){float r;asm("v_sub_f32_e32 %0, %1, %2":"=v"(r):"v"(a),"v"(b));return r;}
typedef float f32x2_t __attribute__((ext_vector_type(2))); typedef __bf16 bf16x2_t __attribute__((ext_vector_type(2)));
__device__ __forceinline__ unsigned cvtpk_s(float lo,float hi){f32x2_t v={lo,hi};bf16x2_t b=__builtin_convertvector(v,bf16x2_t);return __builtin_bit_cast(unsigned,b);}
#define WAIT_BAR(N) asm volatile("s_waitcnt vmcnt(" #N ") lgkmcnt(0)\n\ts_barrier":::"memory")

__device__ __forceinline__ void qkt(f32x16&p0,f32x16&p1,const char*Kslot,const bf16x8*qr,int r32,int hi){
  const char*kb=Kslot+hi*1024+r32*16;
  #pragma unroll
  for(int d0=0;d0<4;++d0){
    const bf16x8 b0=*reinterpret_cast<const bf16x8*>(kb+d0*2048);
    const bf16x8 b1=*reinterpret_cast<const bf16x8*>(kb+d0*2048+512);
    p0=__builtin_amdgcn_mfma_f32_32x32x16_bf16(b0,qr[d0],p0,0,0,0);p1=__builtin_amdgcn_mfma_f32_32x32x16_bf16(b1,qr[d0],p1,0,0,0);}
}
typedef __attribute__((address_space(3))) const char* lds_cptr;
typedef short v4i16_t __attribute__((ext_vector_type(4)));
__device__ __forceinline__ void kload8(bf16x8*kf,lds_cptr kp){
  kf[0]=*(const __attribute__((address_space(3))) bf16x8*)(kp);      kf[1]=*(const __attribute__((address_space(3))) bf16x8*)(kp+512);
  kf[2]=*(const __attribute__((address_space(3))) bf16x8*)(kp+2048); kf[3]=*(const __attribute__((address_space(3))) bf16x8*)(kp+2560);
  kf[4]=*(const __attribute__((address_space(3))) bf16x8*)(kp+4096); kf[5]=*(const __attribute__((address_space(3))) bf16x8*)(kp+4608);
  kf[6]=*(const __attribute__((address_space(3))) bf16x8*)(kp+6144); kf[7]=*(const __attribute__((address_space(3))) bf16x8*)(kp+6656);
}
__device__ __forceinline__ void kload2(bf16x8*kf,lds_cptr kp,int j){ kf[2*j]=*(const __attribute__((address_space(3))) bf16x8*)(kp+j*2048); kf[2*j+1]=*(const __attribute__((address_space(3))) bf16x8*)(kp+j*2048+512); }
__device__ __forceinline__ s16x4 vtr(lds_cptr p){ return __builtin_bit_cast(s16x4,__builtin_amdgcn_ds_read_tr16_b64_v4i16((__attribute__((address_space(3))) v4i16_t*)p)); }
__device__ __forceinline__ float rowmax(const f32x16&p0,const f32x16&p1){
  float a=max3f(p0[0],p0[1],p1[0]),b=max3f(p0[2],p0[3],p1[1]);a=max3f(a,p1[2],p1[3]);
  #pragma unroll
  for(int r=4;r<16;r+=4){a=max3f(a,p0[r],p0[r+1]);b=max3f(b,p0[r+2],p0[r+3]);a=max3f(a,p1[r],p1[r+1]);b=max3f(b,p1[r+2],p1[r+3]);}
  const float m=max2f(a,b);
  auto rr=__builtin_amdgcn_permlane32_swap(__float_as_uint(m),__float_as_uint(m),false,false);
  return max2f(__uint_as_float(rr[0]),__uint_as_float(rr[1]));
}
__device__ __forceinline__ void pv(f32x16*o,int vb,bf16x8 pa0,bf16x8 pa1,bf16x8 pa2,bf16x8 pa3){
  #pragma unroll
  for(int d0=0;d0<2;++d0){s16x4 lo[4],hi[4];
    #pragma unroll
    for(int ks=0;ks<4;++ks){
      asm volatile("ds_read_b64_tr_b16 %0,%1 offset:%c2":"=&v"(lo[ks]):"v"(vb),"i"(d0*4096+ks*1024):"memory");
      asm volatile("ds_read_b64_tr_b16 %0,%1 offset:%c2":"=&v"(hi[ks]):"v"(vb),"i"(d0*4096+ks*1024+512):"memory");}
    asm volatile("s_waitcnt lgkmcnt(0)":::"memory");SBAR();
    #define PK(k) (bf16x8){lo[k][0],lo[k][1],lo[k][2],lo[k][3],hi[k][0],hi[k][1],hi[k][2],hi[k][3]}
    o[d0]=__builtin_amdgcn_mfma_f32_32x32x16_bf16(pa0,PK(0),o[d0],0,0,0);
    o[d0]=__builtin_amdgcn_mfma_f32_32x32x16_bf16(pa1,PK(1),o[d0],0,0,0);
    o[d0]=__builtin_amdgcn_mfma_f32_32x32x16_bf16(pa2,PK(2),o[d0],0,0,0);
    o[d0]=__builtin_amdgcn_mfma_f32_32x32x16_bf16(pa3,PK(3),o[d0],0,0,0);
    #undef PK
  }
}

#ifndef ATTN_STORE16
#define ATTN_STORE16(p,v) (*(u32x4*)(p)=(v))
#endif
template<int THRL> __device__ __forceinline__ void attn_unit(int b,int h,int qb,const bf16*Q,const bf16*__restrict__ K,const bf16*__restrict__ V,bf16*O,const bf16*__restrict__ SZ,char*shm){
  const int tid=threadIdx.x,lane=tid&63,r32=lane&31,hi=lane>>5; const int wid=__builtin_amdgcn_readfirstlane(tid>>6);
  const long rowbase=(long)b*SEQ; const int q0=qb*QB;
  const bf16*Qw=Q+(rowbase+q0+wid*QBLK)*DM+h*D;
  const bf16*Kh=K+rowbase*DM+h*D,*Vh=V+rowbase*DM+h*D;
  const unsigned lds0=(unsigned)(uintptr_t)shm;
  float*wsf=(float*)(shm+LDS_WS)+wid*64;
  const bf16*ksrc=Kh+(long)lane*DM+wid*8;
  const bf16*vsrc=Vh+(long)(16*(wid&3)+(lane>>2))*DM+(wid>>2)*32+(lane&3)*8;
  const unsigned kdst=lds0+LDS_K+wid*1024, vdst=lds0+LDS_V+wid*1024;
  #define DMA_K(t,slot) glds16(ksrc+(long)(t)*KVBLK*DM,(unsigned)__builtin_amdgcn_readfirstlane(kdst+(slot)))
  #define DMA_V(t,slot) glds16(vsrc+(long)(t)*KVBLK*DM,(unsigned)__builtin_amdgcn_readfirstlane(vdst+(slot)))
  const int vb0=(int)(lds0+LDS_V)+((lane>>4)&1)*32+(lane&3)*8+(4*hi+((lane&15)>>2))*64;
  const char*Kbase=shm+LDS_K; bf16x8 kf[8];
  const lds_cptr shm3=(lds_cptr)shm; const lds_cptr kp0=shm3+LDS_K+hi*1024+r32*16; const lds_cptr vp0=shm3+LDS_V+((lane>>4)&1)*32+(lane&3)*8+(4*hi+((lane&15)>>2))*64;
  const int NT=(q0+QB)/KVBLK;
  DMA_K(0,0);DMA_V(0,0);DMA_K(1,SLOTB);
  bf16x8 qr[4];
  #pragma unroll
  for(int d0=0;d0<4;++d0)qr[d0]=*reinterpret_cast<const bf16x8*>(&Qw[(long)r32*DM+d0*16+hi*8]);
  float l_reg=0.f;f32x16 o[2];o[0]=f32x16{};o[1]=f32x16{};
  const int qrel=wid*QBLK+r32;
  const __attribute__((address_space(3))) float* Fs3=(const __attribute__((address_space(3))) float*)((lds_cptr)shm+LDS_FS);
  float fqm=Fs3[q0+qrel];
  #define BIAS(C0,C1,t) do{ const __attribute__((address_space(3))) f32x4v* fk_=(const __attribute__((address_space(3))) f32x4v*)(Fs3+(t)*64+4*hi); \
    _Pragma("unroll") for(int i_=0;i_<4;++i_){ const f32x4v a_=fk_[2*i_], b_=fk_[2*i_+8]; \
      _Pragma("unroll") for(int k_=0;k_<4;++k_){ C0[4*i_+k_]=fqm-a_[k_]; C1[4*i_+k_]=fqm-b_[k_]; } } }while(0)
  #define CMASK(P0,P1,t) do{int jb_=(t)-(NT-4); if(jb_>=0)cmask(P0,P1,jb_,qrel,hi);}while(0)
  bool resc=false;
  #define START(P0,P1) do{ const float rm=rowmax(P0,P1); resc=false; \
    { const float dl=rm; fqm=fsub_s(fqm,dl); \
      _Pragma("unroll") for(int r=0;r<16;++r){P0[r]=fsub_s(P0[r],dl);P1[r]=fsub_s(P1[r],dl);} } \
    _Pragma("unroll") for(int r=0;r<16;++r)P0[r]=__builtin_amdgcn_exp2f(P0[r]); }while(0)
  #define RESC() do{ if(resc){ asm volatile("s_waitcnt lgkmcnt(0)":::"memory"); \
      _Pragma("unroll") for(int d_=0;d_<2;++d_) _Pragma("unroll") for(int r=0;r<16;++r)o[d_][r]*=wsf[crow(r,hi)]; } }while(0)
  f32x16 pA0,pA1,pB0,pB1;
  int sl_prev=0,sl_cur=0,sl_next=SLOTB;
  #define ROT() do{sl_prev=sl_cur;sl_cur=sl_next;sl_next=(sl_next==(NSLOT-1)*SLOTB)?0:sl_next+SLOTB;}while(0)
  DMA_K(2,2*SLOTB);
  WAIT_BAR(3);
  BIAS(pA0,pA1,0); qkt(pA0,pA1,Kbase,qr,r32,hi);asm volatile("s_nop 15\n\ts_nop 7":"+v"(pA0),"+v"(pA1));CMASK(pA0,pA1,0);
  START(pA0,pA1);
  _Pragma("unroll") for(int r=0;r<16;++r)pA1[r]=__builtin_amdgcn_exp2f(pA1[r]);
  WAIT_BAR(0);
  DMA_K(3,0);DMA_V(1,SLOTB);
  ROT();
  kload8(kf,kp0+sl_cur);
  WAIT_BAR(2);
  s16x4 vlo[8],vhi[8]; u32x4 pw0,pw1,pw2,pw3;
  #define PKW(P,B) cvtpk_s(P[B],P[B+1])
  #define PAF(k) __builtin_bit_cast(bf16x8,pw##k)
  #define VFR(i) (bf16x8){vlo[i][0],vlo[i][1],vlo[i][2],vlo[i][3],vhi[i][0],vhi[i][1],vhi[i][2],vhi[i][3]}
  #define PIN(x) asm volatile("":"+v"(x))
  #define MX3(a,b,c) __builtin_fmaxf(__builtin_fmaxf((a),(b)),(c))
  #define GAPA(MF,A0,A1,A2,A3,W0,W1,PW) do{ MF; sacc+=A0; sacc+=A1; sacc+=A2; sacc+=A3; PIN(sacc); W0; W1; PIN(PW); SBAR(); }while(0)
  #define EX(v) __builtin_amdgcn_exp2f(v)
  #define GAPB(MF,X,B) do{ MF; X[B]=EX(X[B]); X[B+1]=EX(X[B+1]); X[B+2]=EX(X[B+2]); X[B+3]=EX(X[B+3]); PIN(X); SBAR(); }while(0)
  #define VRD(i) do{ vlo[i]=vtr(vp_+(((i)>>2)*4096+((i)&3)*1024)); vhi[i]=vtr(vp_+(((i)>>2)*4096+((i)&3)*1024+512)); }while(0)
  #define KRD(G,j) do{ if(G){ kload2(kf,kp0+sl_next,j); SBAR(); } }while(0)
  #define STEP(C0,C1,P0,P1,t,GK,GV,GL) do{ SBAR(); BIAS(C0,C1,t); SBAR(); \
    const lds_cptr vp_=vp0+sl_prev; \
    VRD(0); SBAR(); float sacc=(P0[0]+P0[1]); \
    GAPA(C0=__builtin_amdgcn_mfma_f32_32x32x16_bf16(kf[0],qr[0],C0,0,0,0), P0[2],P0[3],P0[4],P0[5],     pw0[0]=PKW(P0,0), pw0[1]=PKW(P0,2), pw0); \
    VRD(4); SBAR(); GAPA(C1=__builtin_amdgcn_mfma_f32_32x32x16_bf16(kf[1],qr[0],C1,0,0,0), P0[6],P0[7],P0[8],P0[9],     pw0[2]=PKW(P0,4), pw0[3]=PKW(P0,6), pw0); \
    VRD(1); SBAR(); GAPA(C0=__builtin_amdgcn_mfma_f32_32x32x16_bf16(kf[2],qr[1],C0,0,0,0),   P0[10],P0[11],P0[12],P0[13], pw1[0]=PKW(P0,8), pw1[1]=PKW(P0,10), pw1); \
    VRD(5); SBAR(); GAPA(C1=__builtin_amdgcn_mfma_f32_32x32x16_bf16(kf[3],qr[1],C1,0,0,0),   P0[14],P0[15],P1[0],P1[1],   pw1[2]=PKW(P0,12),pw1[3]=PKW(P0,14), pw1); \
    VRD(2); SBAR(); GAPA(C0=__builtin_amdgcn_mfma_f32_32x32x16_bf16(kf[4],qr[2],C0,0,0,0),   P1[2],P1[3],P1[4],P1[5],     pw2[0]=PKW(P1,0), pw2[1]=PKW(P1,2), pw2); \
    VRD(6); SBAR(); GAPA(C1=__builtin_amdgcn_mfma_f32_32x32x16_bf16(kf[5],qr[2],C1,0,0,0),   P1[6],P1[7],P1[8],P1[9],     pw2[2]=PKW(P1,4), pw2[3]=PKW(P1,6), pw2); \
    VRD(3); SBAR(); GAPA(C0=__builtin_amdgcn_mfma_f32_32x32x16_bf16(kf[6],qr[3],C0,0,0,0),   P1[10],P1[11],P1[12],P1[13], pw3[0]=PKW(P1,8), pw3[1]=PKW(P1,10), pw3); \
    VRD(7); SBAR(); GAPA(C1=__builtin_amdgcn_mfma_f32_32x32x16_bf16(kf[7],qr[3],C1,0,0,0),   P1[14],P1[15],0.f,0.f,       pw3[2]=PKW(P1,12),pw3[3]=PKW(P1,14), pw3); \
    l_reg+=sacc; \
    if(GK){DMA_K((t)+3,sl_cur);} if(GV){DMA_V((t)+1,sl_next);} \
    CMASK(C0,C1,t); \
    { float a=MX3(C0[0],C0[1],C1[0]),b=MX3(C0[2],C0[3],C1[1]); a=MX3(a,C1[2],C1[3]); \
      _Pragma("unroll") for(int r=4;r<16;r+=4){a=MX3(a,C0[r],C0[r+1]);b=MX3(b,C0[r+2],C0[r+3]);a=MX3(a,C1[r],C1[r+1]);b=MX3(b,C1[r+2],C1[r+3]);} \
      float rm=__builtin_fmaxf(a,b); { auto rr=__builtin_amdgcn_permlane32_swap(__float_as_uint(rm),__float_as_uint(rm),false,false); rm=__builtin_fmaxf(__uint_as_float(rr[0]),__uint_as_float(rr[1])); } \
      resc=false; \
      if(__builtin_expect(__any(rm>(float)THRL),0)){ const float dl=__builtin_fmaxf(rm,0.f); fqm-=dl; \
        _Pragma("unroll") for(int r=0;r<16;++r){C0[r]-=dl;C1[r]-=dl;} \
        const float f=__builtin_amdgcn_exp2f(-dl); l_reg*=f; if(hi==0)wsf[r32]=f; resc=true; } } \
    SBAR(); \
    GAPB(o[0]=__builtin_amdgcn_mfma_f32_32x32x16_bf16(PAF(0),VFR(0),o[0],0,0,0), C0,0); \
    GAPB(o[1]=__builtin_amdgcn_mfma_f32_32x32x16_bf16(PAF(0),VFR(4),o[1],0,0,0), C0,4); \
    KRD(GL,0); GAPB(o[0]=__builtin_amdgcn_mfma_f32_32x32x16_bf16(PAF(1),VFR(1),o[0],0,0,0), C0,8); \
    KRD(GL,1); GAPB(o[1]=__builtin_amdgcn_mfma_f32_32x32x16_bf16(PAF(1),VFR(5),o[1],0,0,0), C0,12); \
    KRD(GL,2); GAPB(o[0]=__builtin_amdgcn_mfma_f32_32x32x16_bf16(PAF(2),VFR(2),o[0],0,0,0), C1,0); \
    KRD(GL,3); GAPB(o[1]=__builtin_amdgcn_mfma_f32_32x32x16_bf16(PAF(2),VFR(6),o[1],0,0,0), C1,4); \
    GAPB(o[0]=__builtin_amdgcn_mfma_f32_32x32x16_bf16(PAF(3),VFR(3),o[0],0,0,0), C1,8); \
    GAPB(o[1]=__builtin_amdgcn_mfma_f32_32x32x16_bf16(PAF(3),VFR(7),o[1],0,0,0), C1,12); \
    }while(0)
  int t=1;
  #undef CMASK
  #define CMASK(P0,P1,t) do{}while(0)
  for(;t+5<NT;t+=2){
    STEP(pB0,pB1,pA0,pA1,t,true,true,true);     WAIT_BAR(2); RESC(); ROT();
    STEP(pA0,pA1,pB0,pB1,t+1,true,true,true);   WAIT_BAR(2); RESC(); ROT();
  }
  #undef CMASK
  #define CMASK(P0,P1,t) do{int jb_=(t)-(NT-4); if(jb_>=0)cmask(P0,P1,jb_,qrel,hi);}while(0)
  #define ENDW(tt) do{ if((tt)+3<NT){WAIT_BAR(2);} else if((tt)+2<NT){WAIT_BAR(1);} else {WAIT_BAR(0);} }while(0)
  for(;t+1<NT;t+=2){
    STEP(pB0,pB1,pA0,pA1,t,(t+3<NT),(t+1<NT),(t+1<NT));       ENDW(t);   RESC(); ROT();
    STEP(pA0,pA1,pB0,pB1,t+1,(t+4<NT),(t+2<NT),(t+2<NT));     ENDW(t+1); RESC(); ROT();
  }
  STEP(pB0,pB1,pA0,pA1,NT-1,false,false,false); RESC();
  { float sacc=pB0[0]+pB0[1]; _Pragma("unroll") for(int r=2;r<16;++r)sacc+=pB0[r]; _Pragma("unroll") for(int r=0;r<16;++r)sacc+=pB1[r]; l_reg+=sacc;
    pw0=(u32x4){PKW(pB0,0),PKW(pB0,2),PKW(pB0,4),PKW(pB0,6)};pw1=(u32x4){PKW(pB0,8),PKW(pB0,10),PKW(pB0,12),PKW(pB0,14)};pw2=(u32x4){PKW(pB1,0),PKW(pB1,2),PKW(pB1,4),PKW(pB1,6)};pw3=(u32x4){PKW(pB1,8),PKW(pB1,10),PKW(pB1,12),PKW(pB1,14)};
    SBAR(); pv(o,vb0+sl_cur,PAF(0),PAF(1),PAF(2),PAF(3)); }
  #undef PKW
  #undef PAF
  #undef VFR
  #undef PIN
  #undef MX3
  #undef GAPA
  #undef GAPB
  #undef EX
  #undef VRD
  #undef KRD
  #undef STEP
  #undef ENDW
  {auto rr=__builtin_amdgcn_permlane32_swap(__float_as_uint(l_reg),__float_as_uint(l_reg),false,false);l_reg=__uint_as_float(rr[0])+__uint_as_float(rr[1]);}
  if(hi==0)wsf[32+r32]=l_reg;asm volatile("s_waitcnt lgkmcnt(0)":::"memory");
  float rli[16];
  #pragma unroll
  for(int r=0;r<16;++r)rli[r]=__builtin_amdgcn_rcpf(wsf[32+crow(r,hi)]);
  bf16*Ow=O+(rowbase+q0+wid*QBLK)*DM+h*D;
  { bf16*stg=(bf16*)(shm+LDS_OST)+wid*2048;
    #pragma unroll
    for(int r=0;r<16;++r){const int orow=crow(r,hi);
      #pragma unroll
      for(int d0=0;d0<2;++d0)stg[orow*64+d0*32+r32]=__float2bfloat16(o[d0][r]*rli[r]);}
    asm volatile("s_waitcnt lgkmcnt(0)":::"memory");
    const bf16*SZw=SZ+(rowbase+q0+wid*QBLK)*DM+h*D;
    #pragma unroll
    for(int i=0;i<4;++i){const int row=i*8+(lane>>3),ch=lane&7; const u32x4 v=*(const u32x4*)(stg+row*64+ch*8); const u32x4 g=*(const u32x4*)(SZw+(long)row*DM+ch*8); u32x4 w;
      #pragma unroll
      for(int k=0;k<4;++k){ const float a0=__uint_as_float(v[k]<<16)*__uint_as_float(g[k]<<16), a1=__uint_as_float(v[k]&0xffff0000u)*__uint_as_float(g[k]&0xffff0000u); w[k]=cvtpk_s(a0,a1); }
      ATTN_STORE16(Ow+(long)row*DM+ch*8,w);} }
  asm volatile("s_waitcnt lgkmcnt(0)\n\ts_barrier":::"memory");
  #undef DMA_K
  #undef DMA_V
  #undef CMASK
  #undef START
  #undef RESC
  #undef ROT
  #undef BIAS
}
constexpr int ATTN_LDS_BYTES=LDS_BYTES;
struct AttnTensors { const bf16* Q; const bf16* K; const bf16* V; bf16* O; const bf16* SZ; const float* LF; };
template<int THRL=8> __device__ __forceinline__ void attn_phase(char*lds,const AttnTensors&T,int vcu,int G){
  #pragma unroll 1
  for(int task=vcu;task<BATCH*NHEAD*2;task+=G){
    int tid=threadIdx.x; asm volatile("":"+v"(tid)); const int lane=tid&63,wid=tid>>6;
    const int bh=task>>1,s=task&1,b=bh/NHEAD,h=bh%NHEAD;
    { __attribute__((address_space(3))) float* Fs=(__attribute__((address_space(3))) float*)((lds_cptr)lds+LDS_FS);
      __attribute__((address_space(3))) float* WT=(__attribute__((address_space(3))) float*)((lds_cptr)lds+LDS_SCAN);
      const float* lf=T.LF+((long)b*SEQ+4*tid)*NHEAD+h;
      const float v0=lf[0],v1=lf[NHEAD],v2=lf[2*NHEAD],v3=lf[3*NHEAD];
      const float p1=v0+v1,p2=p1+v2,p3=p2+v3; float x=p3;
      #pragma unroll
      for(int off=1;off<64;off<<=1){const float y=__shfl_up(x,off); if(lane>=off)x+=y;}
      if(lane==63)WT[wid]=x;
      __syncthreads();
      float offs=0.f;
      #pragma unroll
      for(int w=0;w<NW;++w){const float tv=WT[w]; if(w<wid)offs+=tv;}
      const float ex=x-p3+offs; const float L2E=1.4426950408889634f;
      f32x4v o4; o4[0]=(ex+v0)*L2E; o4[1]=(ex+p1)*L2E; o4[2]=(ex+p2)*L2E; o4[3]=(ex+p3)*L2E;
      *(__attribute__((address_space(3))) f32x4v*)(Fs+4*tid)=o4;
      __syncthreads(); }
    #pragma unroll 1
    for(int i=0;i<4;++i){ const int qb=(i==0)?7-s:(i==1)?s:(i==2)?4+s:3-s;
      attn_unit<THRL>(b,h,qb,T.Q,T.K,T.V,T.O,T.SZ,lds); }
  }
}
#undef SBAR
#undef WAIT_BAR
}
#define GAS __attribute__((address_space(1)))
#define LAS __attribute__((address_space(3)))
typedef unsigned short bf16u;
typedef unsigned v4u __attribute__((ext_vector_type(4)));
typedef float f32x4 __attribute__((ext_vector_type(4)));
typedef float f32x16 __attribute__((ext_vector_type(16)));
typedef short bf16x8 __attribute__((ext_vector_type(8)));
#define LDS_WAIT() asm volatile("s_waitcnt lgkmcnt(0)" ::: "memory")

constexpr int NWAVES = 8;
constexpr int BATCH = 8, SEQ = 2048, D = 1024, M = BATCH * SEQ, NG = 64, NST = 64, NH = 16;
constexpr float EPS = 1e-6f;
constexpr float C2 = 0.125f * 1.4426950408889634f;

constexpr size_t MiB = 1u << 20;
constexpr size_t WS_W_IN_A = 0 * MiB, WS_W_GLU = 4 * MiB, WS_W_OUT_A = 6 * MiB, WS_W_KV = 8 * MiB, WS_W_IN_B = 12 * MiB, WS_W_OUT_B = 16 * MiB;
constexpr size_t WS_W_F = 18 * MiB;
constexpr size_t WS_MODP = 19 * MiB;
constexpr size_t WS_GATE = 21 * MiB;
constexpr size_t WS_ABAR = 21 * MiB + 128 * 1024, WS_AL = WS_ABAR + 32 * 1024, WS_BFRAG = WS_AL + 32 * 1024, WS_CFRAG = WS_BFRAG + 256 * 1024;
constexpr size_t WS_CTL = 21 * MiB + 768 * 1024, CTL_ZERO_BYTES = 16384;
constexpr size_t WS_E = 22 * MiB;
constexpr size_t WS_UZ = 24 * MiB;
constexpr size_t WS_K = 24 * MiB, WS_V = 56 * MiB;
constexpr size_t WS_R2 = 88 * MiB;
constexpr size_t WS_R3 = 120 * MiB;
constexpr size_t WS_QO = 152 * MiB, WS_SZ = 184 * MiB;
constexpr size_t WS_LF = 216 * MiB;
constexpr size_t WS_END = 217 * MiB;
constexpr int LDS_BYTES = 147456;

__device__ __forceinline__ unsigned f2bf(float f) { unsigned u = __builtin_bit_cast(unsigned, f); return (u + 0x7fffu + ((u >> 16) & 1u)) >> 16; }
__device__ __forceinline__ unsigned pk2(float lo, float hi) { return f2bf(lo) | (f2bf(hi) << 16); }
__device__ __forceinline__ float wave_sum(float v) {
#pragma unroll
    for (int o = 1; o < 64; o <<= 1) v += __shfl_xor(v, o);
    return v;
}
__host__ __device__ __forceinline__ int phys_row(int n) { const int q = n & 255; return (n - q) + 128 * ((q >> 5) & 1) + 32 * (q >> 6) + (q & 31); }

struct Args { const float* in[29]; float* out; unsigned char* ws; };

__device__ __forceinline__ void p0_transpose_item(const float* W, int ldw, int K, int N, bf16u* WT, LAS float* scr, int item, int lane) {
    const int nblk = N / 32, kb = item / nblk, nb = item % nblk, k0 = 64 * kb, n0 = 32 * nb;
#pragma unroll 8
    for (int i = 0; i < 32; ++i) { const int kk = 2 * i + (lane >> 5); scr[kk * 33 + (lane & 31)] = W[(size_t)(k0 + kk) * ldw + n0 + (lane & 31)]; }
    LDS_WAIT(); asm volatile("" ::: "memory");
    const int c = lane & 7; const int pr0 = phys_row(n0);
#pragma unroll
    for (int j = 0; j < 4; ++j) { const int n = (lane >> 3) + 8 * j; const LAS float* s = scr + (8 * c) * 33 + n;
        v4u o; o.x = pk2(s[0 * 33], s[1 * 33]); o.y = pk2(s[2 * 33], s[3 * 33]); o.z = pk2(s[4 * 33], s[5 * 33]); o.w = pk2(s[6 * 33], s[7 * 33]);
        *(v4u*)(WT + (size_t)(pr0 + n) * K + k0 + 8 * c) = o; }
    LDS_WAIT(); asm volatile("" ::: "memory");
}

__device__ __forceinline__ void sincos_d(double x, double& s, double& c) {
    const double kq = rint(x * 0.63661977236758134308), r = fma(-kq, 1.57079632679489661923, x) - kq * 6.123233995736766e-17, r2 = r * r;
    double sp = -7.6471637318198165e-13; sp = fma(sp, r2, 1.6059043836821613e-10); sp = fma(sp, r2, -2.5052108385441720e-08); sp = fma(sp, r2, 2.7557319223985893e-06);
    sp = fma(sp, r2, -1.9841269841269841e-04); sp = fma(sp, r2, 8.3333333333333332e-03); sp = fma(sp, r2, -1.6666666666666666e-01); sp = fma(sp * r2, r, r);
    double cp = 4.7794773323873853e-14; cp = fma(cp, r2, -1.1470745597729725e-11); cp = fma(cp, r2, 2.0876756987868100e-09); cp = fma(cp, r2, -2.7557319223985888e-07);
    cp = fma(cp, r2, 2.4801587301587302e-05); cp = fma(cp, r2, -1.3888888888888889e-03); cp = fma(cp, r2, 4.1666666666666664e-02); cp = fma(cp, r2, -0.5); cp = fma(cp, r2, 1.0);
    const int q = ((int)kq) & 3;
    s = (q == 0) ? sp : (q == 1) ? cp : (q == 2) ? -sp : -cp;
    c = (q == 0) ? cp : (q == 1) ? -sp : (q == 2) ? -cp : sp;
}

#define XB_TMO      128
#define XB_XCNT(j)  (256  + 64 * (j))
#define XB_XSUB(j)  (1280 + 64 * (j))
#define XB_XGEN(j)  (2304 + 64 * (j))
#define XB_TOP      3328
#define XB_TOPGEN   3392
#define XCD_BAR_WORDS 3456
#define XB_SPIN_CAP (1u << 18)

__device__ __forceinline__ unsigned xb_ld(unsigned* p)              { return __hip_atomic_load(p, __ATOMIC_RELAXED, __HIP_MEMORY_SCOPE_AGENT); }
__device__ __forceinline__ unsigned xb_add(unsigned* p, unsigned v) { return __hip_atomic_fetch_add(p, v, __ATOMIC_RELAXED, __HIP_MEMORY_SCOPE_AGENT); }
__device__ __forceinline__ unsigned xb_xcc_id() { return (unsigned)__builtin_amdgcn_s_getreg((3 << 11) | 20) & 0xFu; }
#define XB_SPIN(cond, bar) do { unsigned _sp = 0; while (cond) { __builtin_amdgcn_s_sleep(1); \
    if ((++_sp & 255u) == 0u) { if (xb_ld(&(bar)[XB_TMO])) break; if (_sp > XB_SPIN_CAP) { atomicAdd(&(bar)[XB_TMO], 1u); break; } } } } while (0)

struct XcdBarrier {
    unsigned* bar; unsigned x;
    volatile LAS unsigned* st;
};

__device__ __forceinline__ XcdBarrier xcd_barrier_post(unsigned* bar, volatile LAS unsigned* st) {
    XcdBarrier b; b.bar = bar; b.x = xb_xcc_id(); b.st = st;
    if (threadIdx.x == 0) (void)xb_add(&bar[XB_XCNT(b.x)], 1u);
    return b;
}
__device__ __forceinline__ void xcd_barrier_complete(unsigned* bar, unsigned x, unsigned& nloc, unsigned& nx) {
    const unsigned G = gridDim.x * gridDim.y * gridDim.z;
    unsigned sum, cnt, mine, sp = 0u;
    for (;;) {
        sum = 0u; cnt = 0u; mine = 0u;
#pragma unroll
        for (unsigned j = 0; j < 16; ++j) { const unsigned c = xb_ld(&bar[XB_XCNT(j)]); sum += c; cnt += (c > 0u) ? 1u : 0u; mine = (j == x) ? c : mine; }
        if (sum == G) break;
        __builtin_amdgcn_s_sleep(1);
        if ((++sp & 255u) == 0u) { if (xb_ld(&bar[XB_TMO])) break; if (sp > XB_SPIN_CAP) { atomicAdd(&bar[XB_TMO], 1u); break; } }
    }
    nloc = mine > 0u ? mine : 1u; nx = cnt > 0u ? cnt : 1u;
}

__device__ __forceinline__ void xcd_barrier(const XcdBarrier& b) {
    asm volatile("s_waitcnt vmcnt(0)" ::: "memory");
    __syncthreads();
    if (threadIdx.x == 0) {
        unsigned* bar = b.bar;
        __builtin_amdgcn_s_waitcnt(0);
        unsigned nloc = b.st[0], nx = b.st[1];
        if (nloc == 0u) { xcd_barrier_complete(bar, b.x, nloc, nx); b.st[0] = nloc; b.st[1] = nx; }
        const unsigned old = xb_add(&bar[XB_XSUB(b.x)], 1u);
        const unsigned gen = old / nloc;
        if (old + 1u == (gen + 1u) * nloc) {
            __builtin_amdgcn_fence(__ATOMIC_RELEASE, "agent");
            asm volatile("s_waitcnt vmcnt(0)" ::: "memory");
            const unsigned og = xb_add(&bar[XB_TOP], 1u);
            const unsigned tg = og / nx;
            if (og + 1u == (tg + 1u) * nx) xb_add(&bar[XB_TOPGEN], 1u);
            else XB_SPIN(xb_ld(&bar[XB_TOPGEN]) == tg, bar);
            __builtin_amdgcn_fence(__ATOMIC_ACQUIRE, "agent");
            xb_add(&bar[XB_XGEN(b.x)], 1u);
            asm volatile("s_waitcnt vmcnt(0)" ::: "memory");
        } else {
            XB_SPIN(xb_ld(&bar[XB_XGEN(b.x)]) == gen, bar);
            __builtin_amdgcn_fence(__ATOMIC_ACQUIRE, "agent");
            asm volatile("s_waitcnt vmcnt(0)" ::: "memory");
        }
    }
    __syncthreads();
}
#ifndef PH_MASK
#define PH_MASK 0x3ff
#endif
__device__ __forceinline__ float sigm_f(float x) { return __builtin_amdgcn_rcpf(1.0f + __builtin_amdgcn_exp2f(-1.4426950408889634f * x)); }
__device__ __forceinline__ float gelu_tanh(float y) { const float t = 1.5957691216057308f * (y + 0.044715f * y * y * y); return y * sigm_f(t); }
__device__ __forceinline__ int crow16(int r, int hi) { return (r & 3) + 8 * (r >> 2) + 4 * hi; }

template <int NOUT> __device__ __forceinline__ void norm_rows(const float* X, int v, int wave, int lane, const LAS float* GS0, const LAS float* SH0, bf16u* O0, const LAS float* GS1, const LAS float* SH1, bf16u* O1) {
    f32x4 gs0[4], sh0[4], gs1[4], sh1[4];
#pragma unroll
    for (int j = 0; j < 4; ++j) { gs0[j] = *(const LAS f32x4*)(GS0 + 256 * j + 4 * lane); sh0[j] = *(const LAS f32x4*)(SH0 + 256 * j + 4 * lane);
        if (NOUT == 2) { gs1[j] = *(const LAS f32x4*)(GS1 + 256 * j + 4 * lane); sh1[j] = *(const LAS f32x4*)(SH1 + 256 * j + 4 * lane); } }
#pragma unroll 2
    for (int i = 0; i < 8; ++i) { const size_t row = (size_t)(64 * v + 8 * wave + i);
        const f32x4* xr = (const f32x4*)(X + row * D) + lane;
        f32x4 x[4]; float s = 0.f;
#pragma unroll
        for (int j = 0; j < 4; ++j) { x[j] = xr[64 * j]; s += (x[j].x * x[j].x + x[j].y * x[j].y) + (x[j].z * x[j].z + x[j].w * x[j].w); }
        const float r = 1.0f / sqrtf(wave_sum(s) * (1.0f / D) + EPS);
        unsigned long long* o0 = (unsigned long long*)(O0 + row * D) + lane;
#pragma unroll
        for (int j = 0; j < 4; ++j) { const f32x4 h = x[j] * r * gs0[j] + sh0[j]; o0[64 * j] = (unsigned long long)pk2(h.x, h.y) | ((unsigned long long)pk2(h.z, h.w) << 32); }
        if (NOUT == 2) { unsigned long long* o1 = (unsigned long long*)(O1 + row * D) + lane;
#pragma unroll
            for (int j = 0; j < 4; ++j) { const f32x4 h = x[j] * r * gs1[j] + sh1[j]; o1[64 * j] = (unsigned long long)pk2(h.x, h.y) | ((unsigned long long)pk2(h.z, h.w) << 32); } }
    }
}
__device__ __forceinline__ void mod_vectors(const float* MODP, const float* bias, const float* g, int b, int cbase, LAS float* GS, LAS float* SH, int tid) {
    for (int k = tid; k < D; k += NWAVES * 64) { float sh = bias[k], sc = bias[D + k];
#pragma unroll
        for (int ks = 0; ks < 8; ++ks) { const float* p = MODP + (size_t)(ks * 8 + b) * 8192 + cbase + k; sh += p[0]; sc += p[D]; }
        GS[k] = g[k] * (1.0f + sc); SH[k] = sh; }
}

template <int PASS> __device__ __forceinline__ void s5_scan(LAS unsigned char* lds, const bf16u* UZ, bf16u* Y1, const float2* ABAR, const float2* AL, const bf16u* BFRAG, const bf16u* CFRAG, float4* E, const float* Dvec, int gw, int NGW, int wave, int lane) {
    LAS unsigned char* Sl = lds + wave * 8704;
    const int j = lane & 31, hi = lane >> 5;
    for (int task = gw; task < 2048; task += NGW) {
        const int seg = task & 7, g = (task >> 3) & 63, bp = task >> 9;
        const float2 a0 = ABAR[g * 64 + j], a1 = ABAR[g * 64 + 32 + j];
        bf16x8 bfr[4], cfr[4];
#pragma unroll
        for (int c = 0; c < 4; ++c) bfr[c] = *(const bf16x8*)(BFRAG + ((size_t)(g * 4 + c) * 64 + lane) * 8);
        if (PASS == 1) {
#pragma unroll
            for (int c = 0; c < 4; ++c) cfr[c] = *(const bf16x8*)(CFRAG + ((size_t)(g * 4 + c) * 64 + lane) * 8); }
        const int seqA = (j >> 2) & 1, timeA = (j & 3) + 4 * (j >> 3);
        const bf16u* ap = UZ + ((size_t)((bp + 4 * seqA) * SEQ + seg * 256 + timeA)) * 2048 + g * 16 + 8 * hi;
        float s0r = 0.f, s0i = 0.f, s1r = 0.f, s1i = 0.f;
        if (PASS == 1) { const float2 l0 = AL[g * 64 + j], l1 = AL[g * 64 + 32 + j];
            for (int k = 0; k < seg; ++k) { const float4 e = E[((size_t)((bp * 64 + g) * 8 + k)) * 64 + lane];
                const float n0r = l0.x * s0r - l0.y * s0i + e.x, n0i = l0.x * s0i + l0.y * s0r + e.y; s0r = n0r; s0i = n0i;
                const float n1r = l1.x * s1r - l1.y * s1i + e.z, n1i = l1.x * s1i + l1.y * s1r + e.w; s1r = n1r; s1i = n1i; } }
        const float dv = (PASS == 1) ? Dvec[g * 16 + (lane & 15)] : 0.f;
        bf16x8 a_next = *(const bf16x8*)ap;
#pragma unroll 1
        for (int tile = 0; tile < 16; ++tile) {
            const bf16x8 a = a_next; if (tile < 15) a_next = *(const bf16x8*)(ap + (size_t)(tile + 1) * 16 * 2048);
            f32x16 acc[4];
#pragma unroll
            for (int c = 0; c < 4; ++c) { f32x16 z = {}; acc[c] = __builtin_amdgcn_mfma_f32_32x32x16_bf16(a, bfr[c], z, 0, 0, 0); }
#pragma unroll
            for (int r = 0; r < 16; ++r) {
                const float n0r = a0.x * s0r - a0.y * s0i + acc[0][r], n0i = a0.x * s0i + a0.y * s0r + acc[1][r]; s0r = n0r; s0i = n0i; acc[0][r] = n0r; acc[1][r] = n0i;
                const float n1r = a1.x * s1r - a1.y * s1i + acc[2][r], n1i = a1.x * s1i + a1.y * s1r + acc[3][r]; s1r = n1r; s1i = n1i; acc[2][r] = n1r; acc[3][r] = n1i; }
            if (PASS == 1) {
#pragma unroll
                for (int r = 0; r < 16; ++r) { const int row = crow16(r, hi);
                    *(LAS unsigned*)(Sl + row * 272 + 4 * j) = pg8::cvt_pk_bf16(acc[0][r], acc[1][r]);
                    *(LAS unsigned*)(Sl + row * 272 + 128 + 4 * j) = pg8::cvt_pk_bf16(acc[2][r], acc[3][r]); }
                LDS_WAIT();
                f32x4 Y[2] = {{0.f, 0.f, 0.f, 0.f}, {0.f, 0.f, 0.f, 0.f}};
#pragma unroll
                for (int mt = 0; mt < 2; ++mt)
#pragma unroll
                    for (int ks = 0; ks < 4; ++ks) { const bf16x8 af = *(const LAS bf16x8*)(Sl + (16 * mt + (lane & 15)) * 272 + (32 * ks + 8 * (lane >> 4)) * 2);
                        Y[mt] = __builtin_amdgcn_mfma_f32_16x16x32_bf16(af, cfr[ks], Y[mt], 0, 0, 0); }
                LDS_WAIT();
                const int ch = lane & 15, lq = lane >> 4;
#pragma unroll
                for (int mt = 0; mt < 2; ++mt)
#pragma unroll
                    for (int q = 0; q < 4; ++q) { const int time = q + 8 * mt + 4 * (lq >> 1), bb = bp + 4 * (lq & 1);
                        const size_t tok = (size_t)bb * SEQ + seg * 256 + tile * 16 + time;
                        const float uval = __uint_as_float((unsigned)UZ[tok * 2048 + g * 16 + ch] << 16);
                        const float y = gelu_tanh(Y[mt][q] + dv * uval);
                        Y1[tok * D + g * 16 + ch] = (bf16u)f2bf(y); }
            }
        }
        if (PASS == 0) E[((size_t)((bp * 64 + g) * 8 + seg)) * 64 + lane] = make_float4(s0r, s0i, s1r, s1i);
    }
}

__global__ void __launch_bounds__(NWAVES * 64, 2) fwd_mega(Args args) {
    extern __shared__ __attribute__((aligned(16))) unsigned char lds_raw[];
    cg::grid_group grid = cg::this_grid();
    LAS unsigned char* lds = (LAS unsigned char*)lds_raw;
    const int tid = threadIdx.x, lane = tid & 63, wave = __builtin_amdgcn_readfirstlane(tid >> 6);
    const int G = gridDim.x, bx = blockIdx.x;
    const int vcu = (G % 8 == 0) ? (bx % 8) * (G / 8) + bx / 8 : bx;
    const int gw = vcu * NWAVES + wave, NGW = G * NWAVES;
    unsigned char* ws = args.ws;
    const float* x = args.in[0]; const float* cnd = args.in[1];
    bf16u* W_IN_A = (bf16u*)(ws + WS_W_IN_A); bf16u* W_GLU = (bf16u*)(ws + WS_W_GLU); bf16u* W_OUT_A = (bf16u*)(ws + WS_W_OUT_A);
    bf16u* W_KV = (bf16u*)(ws + WS_W_KV); bf16u* W_IN_B = (bf16u*)(ws + WS_W_IN_B); bf16u* W_OUT_B = (bf16u*)(ws + WS_W_OUT_B); bf16u* W_F = (bf16u*)(ws + WS_W_F);
    float* MODP = (float*)(ws + WS_MODP); float* GATE = (float*)(ws + WS_GATE);
    float2* ABAR = (float2*)(ws + WS_ABAR); float2* AL = (float2*)(ws + WS_AL); bf16u* BFRAG = (bf16u*)(ws + WS_BFRAG); bf16u* CFRAG = (bf16u*)(ws + WS_CFRAG);
    float4* E = (float4*)(ws + WS_E);
    bf16u* UZ = (bf16u*)(ws + WS_UZ); bf16u* KB = (bf16u*)(ws + WS_K); bf16u* VB = (bf16u*)(ws + WS_V);
    bf16u* R2 = (bf16u*)(ws + WS_R2); bf16u* R3 = (bf16u*)(ws + WS_R3); bf16u* QO = (bf16u*)(ws + WS_QO); bf16u* SZ = (bf16u*)(ws + WS_SZ);
    float* LF = (float*)(ws + WS_LF);
    float* out = args.out;
    volatile LAS unsigned* MISC = (volatile LAS unsigned*)(lds + 131072 + 320);
    if (tid < 32) MISC[tid] = 0u;
    __syncthreads();
    XcdBarrier bar = xcd_barrier_post((unsigned*)(ws + WS_CTL), MISC + 8);
    if (args.ws == nullptr) grid.sync();
#define GRID_BAR() xcd_barrier(bar)

#if (PH_MASK >> 0) & 1
    {
        LAS float* SC = (LAS float*)(lds + 73728);
        for (int idx = tid; idx < 8 * D; idx += NWAVES * 64) { const int b = idx >> 10, k = idx & 1023; const float cv = cnd[idx]; SC[k * 8 + b] = cv * sigm_f(cv); }
        __syncthreads();
        LAS float* scr = (LAS float*)(lds + wave * 8704);
        constexpr int I_2048 = (D / 64) * (2048 / 32), I_1024 = (D / 64) * (1024 / 32);
        constexpr int NT_ITEMS = 3 * I_2048 + 3 * I_1024, NITEMS = NT_ITEMS + 1024;
        for (int it = gw; it < NITEMS; it += NGW) {
            int r = it;
            if (r < NT_ITEMS) {
                if (r < I_2048) { p0_transpose_item(args.in[5], 2048, D, 2048, W_IN_A, scr, r, lane); continue; } r -= I_2048;
                if (r < I_2048) { p0_transpose_item(args.in[20], 2064, D, 2048, W_KV, scr, r, lane); continue; } r -= I_2048;
                if (r < I_2048) { p0_transpose_item(args.in[26], 2048, D, 2048, W_IN_B, scr, r, lane); continue; } r -= I_2048;
                if (r < I_1024) { p0_transpose_item(args.in[14], 1024, D, 1024, W_GLU, scr, r, lane); continue; } r -= I_1024;
                if (r < I_1024) { p0_transpose_item(args.in[16], 1024, D, 1024, W_OUT_A, scr, r, lane); continue; } r -= I_1024;
                p0_transpose_item(args.in[28], 1024, D, 1024, W_OUT_B, scr, r, lane); continue;
            }
            r -= NT_ITEMS;
            const int col = (r >> 3) * 64 + lane, ks = r & 7;
            const float* W; int ldw, cc;
            if (col < 3072) { W = args.in[3]; ldw = 3072; cc = col; } else if (col < 5120) { W = args.in[18]; ldw = 2048; cc = col - 3072; } else { W = args.in[24]; ldw = 3072; cc = col - 5120; }
            float acc8[8] = {0.f, 0.f, 0.f, 0.f, 0.f, 0.f, 0.f, 0.f};
            const float* wp = W + (size_t)(ks * 128) * ldw + cc;
#pragma unroll 8
            for (int k = 0; k < 128; ++k) { const float w = wp[(size_t)k * ldw];
                const f32x4 s0 = *(const LAS f32x4*)(SC + (ks * 128 + k) * 8), s1 = *(const LAS f32x4*)(SC + (ks * 128 + k) * 8 + 4);
                acc8[0] += s0.x * w; acc8[1] += s0.y * w; acc8[2] += s0.z * w; acc8[3] += s0.w * w; acc8[4] += s1.x * w; acc8[5] += s1.y * w; acc8[6] += s1.z * w; acc8[7] += s1.w * w; }
#pragma unroll
            for (int b = 0; b < 8; ++b) MODP[(size_t)(ks * 8 + b) * 8192 + col] = acc8[b];
        }
        const int gtid = vcu * (NWAVES * 64) + tid, NGT = G * NWAVES * 64;
        for (int idx = gtid; idx < 16 * D; idx += NGT) { const int jf = idx >> 10, k = idx & 1023; W_F[idx] = (bf16u)f2bf(args.in[20][(size_t)k * 2064 + 2048 + jf]); }
        for (int idx = gtid; idx < NG * NST; idx += NGT) {
            const int g = idx >> 6, p = idx & 63;
            const double dt = exp((double)args.in[6][g]), ar = (double)args.in[7][idx], ai = (double)args.in[8][idx];
            const double mag = exp(ar * dt); double sn, cs; sincos_d(ai * dt, sn, cs);
            const double abr = mag * cs, abi = mag * sn, den = ar * ar + ai * ai, nr = abr - 1.0;
            const double cr = (nr * ar + abi * ai) / den, ci = (abi * ar - nr * ai) / den;
            ABAR[idx] = make_float2((float)abr, (float)abi);
            double pr = abr, pi = abi;
#pragma unroll 1
            for (int q = 0; q < 8; ++q) { const double t = pr * pr - pi * pi; pi = 2.0 * pr * pi; pr = t; }
            AL[idx] = make_float2((float)pr, (float)pi);
            const float* Bre = args.in[9] + (size_t)idx * 16; const float* Bim = args.in[10] + (size_t)idx * 16;
            const int c0 = (p >> 5) * 2;
#pragma unroll 1
            for (int ch = 0; ch < 16; ++ch) { const double br = Bre[ch], bi = Bim[ch]; const double bbr = cr * br - ci * bi, bbi = cr * bi + ci * br;
                const int l = (ch >> 3) * 32 + (p & 31), jj = ch & 7;
                BFRAG[((size_t)(g * 4 + c0) * 64 + l) * 8 + jj] = (bf16u)f2bf((float)bbr); BFRAG[((size_t)(g * 4 + c0 + 1) * 64 + l) * 8 + jj] = (bf16u)f2bf((float)bbi); }
#pragma unroll 1
            for (int ch = 0; ch < 16; ++ch) { const float cre = args.in[11][(size_t)(g * 16 + ch) * 64 + p], cim = args.in[12][(size_t)(g * 16 + ch) * 64 + p];
#pragma unroll
                for (int ri = 0; ri < 2; ++ri) { const int kap = 2 * p + ri, ks2 = kap >> 5, l = ((kap & 31) >> 3) * 16 + ch, jj = kap & 7;
                    CFRAG[((size_t)(g * 4 + ks2) * 64 + l) * 8 + jj] = (bf16u)f2bf(ri == 0 ? cre : -cim); } }
        }
    }
#endif
    GRID_BAR();

#if (PH_MASK >> 1) & 1
    {
        if (tid < 64) { const int idx = vcu * 64 + tid; if (idx < 2 * 8 * D) { const int which = idx >> 13, b = (idx >> 10) & 7, n = idx & 1023;
                const int col = which == 0 ? 2048 + n : 5120 + 2048 + n; float s = which == 0 ? args.in[4][2048 + n] : args.in[25][2048 + n];
#pragma unroll
                for (int ks = 0; ks < 8; ++ks) s += MODP[(size_t)(ks * 8 + b) * 8192 + col];
                GATE[idx] = s; } }
        LAS float* GS = (LAS float*)lds; LAS float* SH = GS + D;
        for (int v = vcu; v < M / 64; v += G) {
            __syncthreads();
            mod_vectors(MODP, args.in[4], args.in[2], v >> 5, 0, GS, SH, tid);
            __syncthreads();
            norm_rows<1>(x, v, wave, lane, GS, SH, R2, GS, SH, R2);
        }
    }
#endif
    GRID_BAR();

#if (PH_MASK >> 2) & 1
    { pg8::Gemm g{R2, W_IN_A, M, 2048, D}; pg8::StaticOrder S; S.init(M, 2048, G, bx); pg8::EpiStore Ep{UZ, 2048};
      pg8::gemm_phase<pg8::EpiStore, pg8::StaticOrder, true, true>(lds, g, S, Ep); }
#endif
    GRID_BAR();

#if (PH_MASK >> 3) & 1
    s5_scan<0>(lds, UZ, R2, ABAR, AL, BFRAG, CFRAG, E, args.in[13], gw, NGW, wave, lane);
#endif
    GRID_BAR();
    s5_scan<1>(lds, UZ, R2, ABAR, AL, BFRAG, CFRAG, E, args.in[13], gw, NGW, wave, lane);
    GRID_BAR();

#if (PH_MASK >> 4) & 1
    { pg8::Gemm g{R2, W_GLU, M, 1024, D}; pg8::StaticOrder S; S.init(M, 1024, G, bx); pg8::EpiGlu Ep{R2, UZ + 1024, args.in[15], R3};
      pg8::gemm_phase<pg8::EpiGlu, pg8::StaticOrder, true, true>(lds, g, S, Ep); }
#endif
    GRID_BAR();

#if (PH_MASK >> 5) & 1
    { pg8::Gemm g{R3, W_OUT_A, M, 1024, D}; pg8::StaticOrder S; S.init(M, 1024, G, bx); pg8::EpiRes Ep{x, GATE, out};
      pg8::gemm_phase<pg8::EpiRes, pg8::StaticOrder, true, true>(lds, g, S, Ep); }
#endif
    GRID_BAR();

#if (PH_MASK >> 6) & 1
    {
        LAS float* GS0 = (LAS float*)lds; LAS float* SH0 = GS0 + D; LAS float* GS1 = SH0 + D; LAS float* SH1 = GS1 + D;
        for (int v = vcu; v < M / 64; v += G) {
            __syncthreads();
            mod_vectors(MODP, args.in[19], args.in[17], v >> 5, 3072, GS0, SH0, tid);
            mod_vectors(MODP, args.in[25], args.in[23], v >> 5, 5120, GS1, SH1, tid);
            __syncthreads();
            norm_rows<2>(out, v, wave, lane, GS0, SH0, R2, GS1, SH1, R3);
        }
    }
#endif
    GRID_BAR();

#if (PH_MASK >> 7) & 1
    {
        for (int t = gw; t < M / 16; t += NGW) {
            f32x4 acc = {0.f, 0.f, 0.f, 0.f};
            const bf16u* ap = R2 + (size_t)(16 * t + (lane & 15)) * D + 8 * (lane >> 4); const bf16u* bp = W_F + (size_t)(lane & 15) * D + 8 * (lane >> 4);
#pragma unroll 8
            for (int ks = 0; ks < 32; ++ks) acc = __builtin_amdgcn_mfma_f32_16x16x32_bf16(*(const bf16x8*)(ap + ks * 32), *(const bf16x8*)(bp + ks * 32), acc, 0, 0, 0);
            const float fb = args.in[21][lane & 15];
#pragma unroll
            for (int r = 0; r < 4; ++r) { const float xl = acc[r] + fb; const float ls = fminf(xl, 0.f) - log1pf(__expf(-fabsf(xl)));
                LF[(size_t)(16 * t + 4 * (lane >> 4) + r) * NH + (lane & 15)] = ls; }
        }
        { pg8::Gemm g{R2, W_KV, M, 2048, D}; pg8::StaticOrder S; S.init(M, 2048, G, bx); pg8::EpiHeadNorm<false> Ep{KB, VB, args.in[22], 1.0f};
          pg8::gemm_phase<pg8::EpiHeadNorm<false>, pg8::StaticOrder, true, true>(lds, g, S, Ep); }
        { pg8::Gemm g{R3, W_IN_B, M, 2048, D}; pg8::StaticOrder S; S.init(M, 2048, G, bx); pg8::EpiHeadNorm<true> Ep{QO, SZ, args.in[27], C2};
          pg8::gemm_phase<pg8::EpiHeadNorm<true>, pg8::StaticOrder, true, true>(lds, g, S, Ep); }
    }
#endif
    GRID_BAR();

#if (PH_MASK >> 8) & 1
    { const attn_body::AttnTensors AT{(const attn_body::bf16*)QO, (const attn_body::bf16*)KB, (const attn_body::bf16*)VB, (attn_body::bf16*)QO, (const attn_body::bf16*)SZ, LF};
      attn_body::attn_phase<8>((char*)lds_raw, AT, vcu, G); }
#endif
    GRID_BAR();

#if (PH_MASK >> 9) & 1
    { pg8::Gemm g{QO, W_OUT_B, M, 1024, D}; pg8::StaticOrder S; S.init(M, 1024, G, bx); pg8::EpiRes Ep{out, GATE + 8 * D, out};
      pg8::gemm_phase<pg8::EpiRes, pg8::StaticOrder, true, true>(lds, g, S, Ep); }
#endif
}

extern "C" void kernel_launch(void* const* d_in, const int* in_sizes, int n_in, void* d_out, int out_size, void* d_ws, size_t ws_size, hipStream_t stream) {
    static int grid = 0;
    if (grid == 0) {
        if (n_in != 29 || out_size != M * D || ws_size < WS_END) { fprintf(stderr, "kernel_launch: unexpected problem (n_in %d out %d ws %zu)\n", n_in, out_size, ws_size); grid = -1; return; }
        int dev = 0, cus = 0, per_cu = 0;
        (void)hipGetDevice(&dev); (void)hipDeviceGetAttribute(&cus, hipDeviceAttributeMultiprocessorCount, dev);
        if (hipFuncSetAttribute((const void*)fwd_mega, hipFuncAttributeMaxDynamicSharedMemorySize, LDS_BYTES) != hipSuccess) { fprintf(stderr, "kernel_launch: hipFuncSetAttribute failed\n"); grid = -1; return; }
        if (hipOccupancyMaxActiveBlocksPerMultiprocessor(&per_cu, (const void*)fwd_mega, NWAVES * 64, LDS_BYTES) != hipSuccess || per_cu < 1) { fprintf(stderr, "kernel_launch: occupancy query says %d\n", per_cu); per_cu = 1; }
        (void)hipGetLastError();
        grid = cus > 0 ? cus : 256;
    }
    if (grid < 0) return;
    if (hipMemsetAsync((char*)d_ws + WS_CTL, 0, CTL_ZERO_BYTES, stream) != hipSuccess) { fprintf(stderr, "kernel_launch: memset failed\n"); return; }
    Args a{};
    for (int i = 0; i < 29; ++i) a.in[i] = (const float*)d_in[i];
    a.out = (float*)d_out; a.ws = (unsigned char*)d_ws;
    void* kargs[] = {&a};
    const hipError_t e = hipLaunchCooperativeKernel((const void*)fwd_mega, dim3(grid), dim3(NWAVES * 64), kargs, LDS_BYTES, stream);
    if (e != hipSuccess) fprintf(stderr, "cooperative launch failed: %s (grid %d)\n", hipGetErrorString(e), grid);
}
```

```cpp
#include <hip/hip_runtime.h>
#include <hip/hip_cooperative_groups.h>
#include <cstdio>
#include <cstdint>
namespace cg = cooperative_groups;
namespace pg8 {
#define PG8_LAS __attribute__((address_space(3)))
typedef unsigned short bf16_t;
typedef short bf16x8 __attribute__((ext_vector_type(8)));
typedef float f32x4 __attribute__((ext_vector_type(4)));
typedef unsigned u32x4 __attribute__((ext_vector_type(4)));
constexpr int BM = 256, BK = 64, HALF = 128, HTB = HALF * BK * 2  , STAGE_BYTES = 8 * HTB, NXCD = 8, WGM = 8;

__host__ __device__ __forceinline__ int lds_byte(int r, int c) { const int st = (r >> 4) * 2 + (c >> 5), rr = r & 15, cc = c & 31, ob = rr * 64 + cc * 2; return st * 1024 + (ob ^ (((ob >> 9) & 1) << 5)); }
__host__ __device__ __forceinline__ void stage_rc(int b, int& R, int& C) { const int st = b / 1024, sb = b % 1024, swz = sb ^ (((sb >> 9) & 1) << 5); R = (st >> 1) * 16 + swz / 64; C = (st & 1) * 32 + (swz % 64) / 2; }
__host__ __device__ __forceinline__ int perm32(int rho) { const int n = rho >> 4, i = rho & 15; return 8 * (i >> 2) + 4 * n + (i & 3); }

struct Unit { int pm, pn; };
struct Gemm { const bf16_t* A; const bf16_t* Bt; int M, N, K; };

struct StaticOrder {
    int nM, nN, nwg, G, c;
    __host__ __device__ void init(int M, int N, int G_, int c_) { nM = M / BM; nN = N / BM; nwg = nM * nN; G = G_; c = c_; }
    __host__ __device__ bool next(int i, Unit& u) const {
        const long L = (long)i * G + c; if (L >= nwg) return false;
        int wgid = (int)L; { const int q = nwg / NXCD, r = nwg % NXCD, xcd = wgid % NXCD, off = wgid / NXCD; wgid = (xcd < r ? xcd * (q + 1) : r * (q + 1) + (xcd - r) * q) + off; }
        const int nig = WGM * nN, gid = wgid / nig, fm = gid * WGM, gsz = (nM - fm) < WGM ? (nM - fm) : WGM;
        u.pm = fm + ((wgid % nig) % gsz); u.pn = (wgid % nig) / gsz; return true;
    }
    __device__ __forceinline__ void a_ready(const Unit&) const {}
    __device__ __forceinline__ void done(const Unit&) const {}
};

__device__ __forceinline__ unsigned cvt_pk_bf16(float lo, float hi) { unsigned r; asm volatile("v_cvt_pk_bf16_f32 %0, %1, %2" : "=v"(r) : "v"(lo), "v"(hi)); return r; }
typedef float f32x2 __attribute__((ext_vector_type(2)));
typedef unsigned u32x4e __attribute__((ext_vector_type(4)));
__device__ __forceinline__ float bf_lo(unsigned u) { return __uint_as_float(u << 16); }
__device__ __forceinline__ float bf_hi(unsigned u) { return __uint_as_float(u & 0xffff0000u); }
__device__ __forceinline__ float sigm(float x) { return __builtin_amdgcn_rcpf(1.0f + __builtin_amdgcn_exp2f(-1.4426950408889634f * x)); }
__device__ __forceinline__ u32x4e pack8(const f32x4& a, const f32x4& b) { u32x4e w; w.x = cvt_pk_bf16(a[0], a[1]); w.y = cvt_pk_bf16(a[2], a[3]); w.z = cvt_pk_bf16(b[0], b[1]); w.w = cvt_pk_bf16(b[2], b[3]); return w; }

struct EpiStore {
    static constexpr bool PERM = true, AFTER_DRAIN = false;
    bf16_t* O; int ldc;
    __device__ __forceinline__ void operator()(const f32x4 (&acc)[2][2][4][2], const Unit& u, int wr, int wc, int fr, int fq) const {
        const int row0 = u.pm * BM + wr * 64 + fr, colb = u.pn * BM + wc * 64 + 8 * fq;
#pragma unroll
        for (int ai = 0; ai < 2; ++ai)
#pragma unroll
            for (int m = 0; m < 4; ++m) { bf16_t* rowp = O + (size_t)(row0 + ai * HALF + m * 16) * ldc + colb;
#pragma unroll
                for (int bj = 0; bj < 2; ++bj) *(u32x4e*)(rowp + bj * 32) = pack8(acc[ai][bj][m][0], acc[ai][bj][m][1]); }
    }
};
struct EpiGlu {
    static constexpr bool PERM = true, AFTER_DRAIN = false;
    const bf16_t* Y1; const bf16_t* Z; const float* bias; bf16_t* O;
    __device__ __forceinline__ void operator()(const f32x4 (&acc)[2][2][4][2], const Unit& u, int wr, int wc, int fr, int fq) const {
        constexpr int PD = 6;
        const int row0 = u.pm * BM + wr * 64 + fr, colb = u.pn * BM + wc * 64 + 8 * fq;
        f32x4 bv[2][2];
#pragma unroll
        for (int bj = 0; bj < 2; ++bj)
#pragma unroll
            for (int n = 0; n < 2; ++n) bv[bj][n] = *(const f32x4*)(bias + colb + bj * 32 + 4 * n);
        u32x4e yb[PD], zb[PD];
#define EG_ROW(it) ((size_t)(row0 + ((it) >> 3) * HALF + (((it) >> 1) & 3) * 16))
#define EG_COL(it) (colb + ((it) & 1) * 32)
#pragma unroll
        for (int it = 0; it < PD; ++it) { yb[it] = *(const u32x4e*)(Y1 + EG_ROW(it) * 1024 + EG_COL(it)); zb[it] = *(const u32x4e*)(Z + EG_ROW(it) * 2048 + EG_COL(it)); }
#pragma unroll
        for (int it = 0; it < 16; ++it) { const int ai = it >> 3, m = (it >> 1) & 3, bj = it & 1;
            const u32x4e yv = yb[it % PD], zv = zb[it % PD];
            if (it + PD < 16) { yb[it % PD] = *(const u32x4e*)(Y1 + EG_ROW(it + PD) * 1024 + EG_COL(it + PD)); zb[it % PD] = *(const u32x4e*)(Z + EG_ROW(it + PD) * 2048 + EG_COL(it + PD)); }
            asm volatile("" ::: "memory");
            f32x4 o0, o1;
#pragma unroll
            for (int k = 0; k < 2; ++k) { const float g0 = acc[ai][bj][m][0][2 * k] + bv[bj][0][2 * k], g1 = acc[ai][bj][m][0][2 * k + 1] + bv[bj][0][2 * k + 1];
                const float z0 = bf_lo(zv[k]), z1 = bf_hi(zv[k]);
                o0[2 * k] = bf_lo(yv[k]) * sigm(g0) * z0 * sigm(z0); o0[2 * k + 1] = bf_hi(yv[k]) * sigm(g1) * z1 * sigm(z1); }
#pragma unroll
            for (int k = 0; k < 2; ++k) { const float g0 = acc[ai][bj][m][1][2 * k] + bv[bj][1][2 * k], g1 = acc[ai][bj][m][1][2 * k + 1] + bv[bj][1][2 * k + 1];
                const float z0 = bf_lo(zv[2 + k]), z1 = bf_hi(zv[2 + k]);
                o1[2 * k] = bf_lo(yv[2 + k]) * sigm(g0) * z0 * sigm(z0); o1[2 * k + 1] = bf_hi(yv[2 + k]) * sigm(g1) * z1 * sigm(z1); }
            *(u32x4e*)(O + EG_ROW(it) * 1024 + EG_COL(it)) = pack8(o0, o1);
            asm volatile("" ::: "memory"); }
    }
};
struct EpiRes {
    static constexpr bool PERM = true, AFTER_DRAIN = false;
    const float* X; const float* gate; float* OUT;
    __device__ __forceinline__ void operator()(const f32x4 (&acc)[2][2][4][2], const Unit& u, int wr, int wc, int fr, int fq) const {
        constexpr int PD = 6;
        const int row0 = u.pm * BM + wr * 64 + fr, colb = u.pn * BM + wc * 64 + 8 * fq;
        const float* gp = gate + (size_t)(u.pm >> 3) * 1024 + colb;
        f32x4 gv[2][2];
#pragma unroll
        for (int bj = 0; bj < 2; ++bj)
#pragma unroll
            for (int n = 0; n < 2; ++n) gv[bj][n] = *(const f32x4*)(gp + bj * 32 + 4 * n);
        f32x4 xb[PD][2];
#pragma unroll
        for (int it = 0; it < PD; ++it) { const float* p = X + EG_ROW(it) * 1024 + EG_COL(it); xb[it][0] = *(const f32x4*)p; xb[it][1] = *(const f32x4*)(p + 4); }
#pragma unroll
        for (int it = 0; it < 16; ++it) { const int ai = it >> 3, m = (it >> 1) & 3, bj = it & 1;
            const f32x4 x0 = xb[it % PD][0], x1 = xb[it % PD][1];
            if (it + PD < 16) { const float* p = X + EG_ROW(it + PD) * 1024 + EG_COL(it + PD); xb[it % PD][0] = *(const f32x4*)p; xb[it % PD][1] = *(const f32x4*)(p + 4); }
            asm volatile("" ::: "memory");
            float* q = OUT + EG_ROW(it) * 1024 + EG_COL(it);
            *(f32x4*)q = x0 + gv[bj][0] * acc[ai][bj][m][0]; *(f32x4*)(q + 4) = x1 + gv[bj][1] * acc[ai][bj][m][1];
            asm volatile("" ::: "memory"); }
#undef EG_ROW
#undef EG_COL
    }
};
template <bool SILU> struct EpiHeadNorm {
    static constexpr bool PERM = true, AFTER_DRAIN = false;
    bf16_t* O0; bf16_t* O1; const float* g; float scale;
    __device__ __forceinline__ void operator()(const f32x4 (&acc)[2][2][4][2], const Unit& u, int wr, int wc, int fr, int fq) const {
        const int row0 = u.pm * BM + wr * 64 + fr;
        if (u.pn < 4) {
            const int colb = u.pn * BM + wc * 64 + 8 * fq;
            f32x4 gv[2][2];
#pragma unroll
            for (int bj = 0; bj < 2; ++bj)
#pragma unroll
                for (int n = 0; n < 2; ++n) gv[bj][n] = *(const f32x4*)(g + bj * 32 + 8 * fq + 4 * n) * scale;
#pragma unroll
            for (int ai = 0; ai < 2; ++ai)
#pragma unroll
                for (int m = 0; m < 4; ++m) { float s = 0.f;
#pragma unroll
                    for (int bj = 0; bj < 2; ++bj)
#pragma unroll
                        for (int n = 0; n < 2; ++n) { const f32x4 x = acc[ai][bj][m][n]; s += (x[0] * x[0] + x[1] * x[1]) + (x[2] * x[2] + x[3] * x[3]); }
                    s += __shfl_xor(s, 16); s += __shfl_xor(s, 32);
                    const float r = 1.0f / sqrtf(s * (1.0f / 64.0f) + 1e-6f);
                    bf16_t* rowp = O0 + (size_t)(row0 + ai * HALF + m * 16) * 1024 + colb;
#pragma unroll
                    for (int bj = 0; bj < 2; ++bj) *(u32x4e*)(rowp + bj * 32) = pack8(acc[ai][bj][m][0] * r * gv[bj][0], acc[ai][bj][m][1] * r * gv[bj][1]); }
        } else {
            const int colb = (u.pn - 4) * BM + wc * 64 + 8 * fq;
#pragma unroll
            for (int ai = 0; ai < 2; ++ai)
#pragma unroll
                for (int m = 0; m < 4; ++m) { bf16_t* rowp = O1 + (size_t)(row0 + ai * HALF + m * 16) * 1024 + colb;
#pragma unroll
                    for (int bj = 0; bj < 2; ++bj) { f32x4 a = acc[ai][bj][m][0], b = acc[ai][bj][m][1];
                        if (SILU) {
#pragma unroll
                            for (int k = 0; k < 4; ++k) { a[k] = a[k] * sigm(a[k]); b[k] = b[k] * sigm(b[k]); } }
                        *(u32x4e*)(rowp + bj * 32) = pack8(a, b); } }
        }
    }
};
template <class Epi, class Sched, bool ALIGN_EPI = false, bool SP2 = false>
__device__ __forceinline__ void gemm_phase(PG8_LAS unsigned char* lds, const Gemm g, const Sched& S, const Epi& E) {
    int tid_ = threadIdx.x; asm volatile("" : "+v"(tid_));
    const int tid = tid_, wid = __builtin_amdgcn_readfirstlane(tid >> 6), lane = tid & 63, wr = wid >> 2, wc = wid & 3, fr = lane & 15, fq = lane >> 4;
    const int K = g.K, nt = K / BK;
    unsigned voffA[2], voffB[2];
#pragma unroll
    for (int i = 0; i < 2; ++i) { int R, C; stage_rc(tid * 16 + i * 8192, R, C); const int Rb = Epi::PERM ? ((R & ~31) + perm32(R & 31)) : R;
        voffA[i] = (unsigned)(R * K + C) * 2u; voffB[i] = (unsigned)(Rb * K + C) * 2u; }
    const size_t kstep = (size_t)(BK * 2);
    const size_t hstep = (size_t)HALF * K * 2;
    const size_t tstep = 2 * hstep;
    const unsigned ldsw = (unsigned)wid * 1024u;
    const int aoff = lds_byte(wr * 64 + fr, fq * 8), boff = lds_byte(wc * 32 + fr, fq * 8);
#define PG8_SA(b, h) (((b) * 2 + (h)) * HTB)
#define PG8_SB(b, h) ((4 + (b) * 2 + (h)) * HTB)
#define PG8_STAGE(bufoff, gbase, voff) do { _Pragma("unroll") for (int _i = 0; _i < 2; ++_i) \
        __builtin_amdgcn_global_load_lds((const unsigned*)((const char*)(gbase) + (voff)[_i]), (PG8_LAS unsigned*)(lds + (bufoff) + ldsw + _i * 8192), 16, 0, 0); } while (0)
#define PG8_LDA(dst, b, h) do { _Pragma("unroll") for (int m = 0; m < 4; ++m) _Pragma("unroll") for (int k = 0; k < 2; ++k) dst[m][k] = *(const PG8_LAS bf16x8*)(lds + PG8_SA(b, h) + aoff + m * 2048 + k * 1024); } while (0)
#define PG8_LDB(dst, b, h) do { _Pragma("unroll") for (int n = 0; n < 2; ++n) _Pragma("unroll") for (int k = 0; k < 2; ++k) dst[n][k] = *(const PG8_LAS bf16x8*)(lds + PG8_SB(b, h) + boff + n * 2048 + k * 1024); } while (0)
#define PG8_MMA(ai, bj, At, Bt) do { __builtin_amdgcn_s_setprio(1); _Pragma("unroll") for (int m = 0; m < 4; ++m) _Pragma("unroll") for (int n = 0; n < 2; ++n) _Pragma("unroll") for (int k = 0; k < 2; ++k) \
        acc[ai][bj][m][n] = __builtin_amdgcn_mfma_f32_16x16x32_bf16(Bt[n][k], At[m][k], acc[ai][bj][m][n], 0, 0, 0); __builtin_amdgcn_s_setprio(0); } while (0)
#define PG8_WAIT_V(n) asm volatile("s_waitcnt vmcnt(" #n ")" ::: "memory")
#define PG8_WAIT_L(n) asm volatile("s_waitcnt lgkmcnt(" #n ")" ::: "memory")
#define PG8_BAR __builtin_amdgcn_s_barrier()
#define PG8_SCHED __builtin_amdgcn_sched_barrier(0)
    Unit cur, nxt; int ui = 0;
    if (!S.next(0, cur)) return;
    f32x4 acc[2][2][4][2];
#pragma unroll
    for (int a = 0; a < 2; ++a)
#pragma unroll
        for (int b = 0; b < 2; ++b)
#pragma unroll
            for (int m = 0; m < 4; ++m)
#pragma unroll
                for (int n = 0; n < 2; ++n) acc[a][b][m][n] = (f32x4){0.f, 0.f, 0.f, 0.f};
    bf16x8 At[4][2], B0[2][2], B1[2][2];
    const char* cA = (const char*)g.A + (size_t)cur.pm * tstep; const char* cB = (const char*)g.Bt + (size_t)cur.pn * tstep;
    S.a_ready(cur);
    if constexpr (SP2) {
        PG8_STAGE(PG8_SB(0, 0), cB, voffB); PG8_STAGE(PG8_SB(0, 1), cB + hstep, voffB); PG8_STAGE(PG8_SA(0, 0), cA, voffA); PG8_STAGE(PG8_SA(0, 1), cA + hstep, voffA);
        if (wr == 1) PG8_BAR;
        PG8_WAIT_V(2); PG8_BAR;
        PG8_STAGE(PG8_SB(1, 0), cB + kstep, voffB); PG8_STAGE(PG8_SA(1, 0), cA + kstep, voffA); PG8_STAGE(PG8_SB(1, 1), cB + hstep + kstep, voffB);
        PG8_WAIT_V(6); PG8_BAR;
    } else {
        PG8_STAGE(PG8_SB(0, 0), cB, voffB); PG8_STAGE(PG8_SA(0, 0), cA, voffA); PG8_STAGE(PG8_SB(0, 1), cB + hstep, voffB); PG8_STAGE(PG8_SA(0, 1), cA + hstep, voffA);
        if (wr == 1) PG8_BAR;
        PG8_WAIT_V(4); PG8_BAR;
        PG8_STAGE(PG8_SB(1, 0), cB + kstep, voffB); PG8_STAGE(PG8_SA(1, 0), cA + kstep, voffA); PG8_STAGE(PG8_SB(1, 1), cB + hstep + kstep, voffB);
        PG8_WAIT_V(6); PG8_BAR;
    }
    for (;;) {
        const bool has_next = S.next(ui + 1, nxt);
        const char* nA = has_next ? (const char*)g.A + (size_t)nxt.pm * tstep : cA; const char* nB = has_next ? (const char*)g.Bt + (size_t)nxt.pn * tstep : cB;
        for (int t = 0; t < nt; t += 2) {
            const bool last = (t == nt - 2);
            const char* a1 = cA + (size_t)(t + 1) * kstep;
            const char* a2 = last ? nA : cA + (size_t)(t + 2) * kstep; const char* b2 = last ? nB : cB + (size_t)(t + 2) * kstep;
            const char* a3 = a2 + kstep; const char* b3 = b2 + kstep;
            if (last && has_next) S.a_ready(nxt);
            if constexpr (SP2) {
            PG8_LDB(B0, 0, 0); PG8_LDB(B1, 0, 1); PG8_SCHED; PG8_LDA(At, 0, 0); PG8_STAGE(PG8_SA(1, 1), a1 + hstep, voffA);
            PG8_WAIT_V(8); PG8_WAIT_L(0); PG8_BAR; PG8_MMA(0, 0, At, B0); PG8_MMA(0, 1, At, B1); PG8_BAR; PG8_SCHED;
            PG8_LDA(At, 0, 1); PG8_STAGE(PG8_SB(0, 0), b2, voffB); PG8_STAGE(PG8_SB(0, 1), b2 + hstep, voffB); PG8_STAGE(PG8_SA(0, 0), a2, voffA);
            PG8_WAIT_V(8); PG8_WAIT_L(0); PG8_BAR; PG8_MMA(1, 0, At, B0); PG8_MMA(1, 1, At, B1); PG8_BAR; PG8_SCHED;
            PG8_LDB(B0, 1, 0); PG8_LDB(B1, 1, 1); PG8_SCHED; PG8_LDA(At, 1, 0); PG8_STAGE(PG8_SA(0, 1), a2 + hstep, voffA);
            PG8_WAIT_V(8); PG8_WAIT_L(0); PG8_BAR; PG8_MMA(0, 0, At, B0); PG8_MMA(0, 1, At, B1); PG8_BAR; PG8_SCHED;
            PG8_LDA(At, 1, 1); PG8_STAGE(PG8_SB(1, 0), b3, voffB); PG8_STAGE(PG8_SB(1, 1), b3 + hstep, voffB); PG8_STAGE(PG8_SA(1, 0), a3, voffA);
            PG8_WAIT_V(8); PG8_WAIT_L(0); PG8_BAR; PG8_MMA(1, 0, At, B0); PG8_MMA(1, 1, At, B1); PG8_BAR; PG8_SCHED;
            } else {
            PG8_LDB(B0, 0, 0); PG8_SCHED; PG8_LDA(At, 0, 0); PG8_STAGE(PG8_SA(1, 1), a1 + hstep, voffA);
            PG8_WAIT_L(8); PG8_BAR; PG8_WAIT_L(0); PG8_MMA(0, 0, At, B0); PG8_BAR; PG8_SCHED;
            PG8_LDB(B1, 0, 1); PG8_STAGE(PG8_SB(0, 0), b2, voffB);
            PG8_BAR; PG8_WAIT_L(0); PG8_MMA(0, 1, At, B1); PG8_BAR;
            PG8_LDA(At, 0, 1); PG8_STAGE(PG8_SA(0, 0), a2, voffA);
            PG8_BAR; PG8_WAIT_L(0); PG8_MMA(1, 0, At, B0); PG8_BAR; PG8_SCHED;
            PG8_STAGE(PG8_SB(0, 1), b2 + hstep, voffB);
            PG8_WAIT_V(6); PG8_BAR; PG8_MMA(1, 1, At, B1); PG8_BAR;
            PG8_LDB(B0, 1, 0); PG8_SCHED; PG8_LDA(At, 1, 0); PG8_STAGE(PG8_SA(0, 1), a2 + hstep, voffA);
            PG8_WAIT_L(8); PG8_BAR; PG8_WAIT_L(0); PG8_MMA(0, 0, At, B0); PG8_BAR; PG8_SCHED;
            PG8_LDB(B1, 1, 1); PG8_STAGE(PG8_SB(1, 0), b3, voffB);
            PG8_BAR; PG8_WAIT_L(0); PG8_MMA(0, 1, At, B1); PG8_BAR;
            PG8_LDA(At, 1, 1); PG8_STAGE(PG8_SA(1, 0), a3, voffA);
            PG8_BAR; PG8_WAIT_L(0); PG8_MMA(1, 0, At, B0); PG8_BAR; PG8_SCHED;
            PG8_STAGE(PG8_SB(1, 1), b3 + hstep, voffB);
            PG8_WAIT_V(6); PG8_BAR; PG8_MMA(1, 1, At, B1); PG8_BAR;
            }
        }
        if constexpr (ALIGN_EPI) { if (wr == 0) PG8_BAR; }
        if constexpr (!Epi::AFTER_DRAIN) { E(acc, cur, wr, wc, fr, fq); S.done(cur); }
        if (!has_next) break;
#pragma unroll
        for (int a = 0; a < 2; ++a)
#pragma unroll
            for (int b = 0; b < 2; ++b)
#pragma unroll
                for (int m = 0; m < 4; ++m)
#pragma unroll
                    for (int n = 0; n < 2; ++n) acc[a][b][m][n] = (f32x4){0.f, 0.f, 0.f, 0.f};
        cur = nxt; cA = nA; cB = nB; ++ui;
        if constexpr (ALIGN_EPI) { if (wr == 1) PG8_BAR; }
    }
    PG8_WAIT_V(0);
    if constexpr (!ALIGN_EPI) { if (wr == 0) PG8_BAR; }
    PG8_BAR;
    if constexpr (Epi::AFTER_DRAIN) { E.fused(acc, cur, wr, wc, fr, fq, lds, wid, lane); S.done(cur); }
#undef PG8_SA
#undef PG8_SB
#undef PG8_STAGE
#undef PG8_LDA
#undef PG8_LDB
#undef PG8_MMA
#undef PG8_WAIT_V
#undef PG8_WAIT_L
#undef PG8_BAR
#undef PG8_SCHED
}
}
#include <hip/hip_bf16.h>
#include <cmath>
namespace attn_body {
using bf16=__hip_bfloat16;
using bf16x8=__attribute__((ext_vector_type(8)))short;
using s16x4=__attribute__((ext_vector_type(4)))short;
using f32x16=__attribute__((ext_vector_type(16)))float;
using u32x4=__attribute__((ext_vector_type(4)))unsigned;
constexpr int BATCH=8,NHEAD=16,SEQ=2048,D=64,DM=NHEAD*D;
constexpr int NW=8,QBLK=32,QB=QBLK*NW,KVBLK=64,NQB=SEQ/QB;
constexpr int ATTN_PITCH=DM, ATTN_UNIT_ROWS=QB;
__device__ __forceinline__ int crow(int r,int hi){return (r&3)+8*(r>>2)+4*hi;}
#define SBAR() __builtin_amdgcn_sched_barrier(0)
__device__ __forceinline__ void cmask(f32x16&p0,f32x16&p1,int jb,int qrel,int hi){
  const float NEG=-INFINITY; int d=qrel-(64*jb+4*hi); asm volatile("":"+v"(d));
  #pragma unroll
  for(int r=0;r<16;++r){const int c=(r&3)+8*(r>>2); if(c>d)p0[r]=NEG; if(c+32>d)p1[r]=NEG;}
}

constexpr int NSLOT=3, SLOTB=8192;
constexpr int LDS_K=0, LDS_V=NSLOT*SLOTB, LDS_WS=2*NSLOT*SLOTB, LDS_OST=LDS_WS+NW*64*4, LDS_FS=LDS_OST+NW*4096, LDS_SCAN=LDS_FS+SEQ*4, LDS_BYTES=LDS_SCAN+256; typedef float f32x4v __attribute__((ext_vector_type(4)));
constexpr float C2=0.125f*1.4426950408889634f;
__device__ __forceinline__ void glds16(const void*gsrc,unsigned lds_dst){unsigned keep;
  asm volatile("s_mov_b32 %0, m0\n\ts_mov_b32 m0, %2\n\ts_nop 0\n\tglobal_load_lds_dwordx4 %1, off\n\ts_mov_b32 m0, %0":"=&s"(keep):"v"(gsrc),"s"(lds_dst):"memory");}
__device__ __forceinline__ float max3f(float a,float b,float c){float r;asm("v_max3_f32 %0, %1, %2, %3":"=v"(r):"v"(a),"v"(b),"v"(c));return r;}
__device__ __forceinline__ float max2f(float a,float b){float r;asm("v_max_f32_e32 %0, %1, %2":"=v"(r):"v"(a),"v"(b));return r;}
__device__ __forceinline__ float fadd_s(float a,float b){float r;asm("v_add_f32_e32 %0, %1, %2":"=v"(r):"v"(a),"v"(b));return r;}
__device__ __forceinline__ float fsub_s(float a,float b){float r;asm("v_sub_f32_e32 %0, %1, %2":"=v"(r):"v"(a),"v"(b));return r;}
typedef float f32x2_t __attribute__((ext_vector_type(2))); typedef __bf16 bf16x2_t __attribute__((ext_vector_type(2)));
__device__ __forceinline__ unsigned cvtpk_s(float lo,float hi){f32x2_t v={lo,hi};bf16x2_t b=__builtin_convertvector(v,bf16x2_t);return __builtin_bit_cast(unsigned,b);}
#define WAIT_BAR(N) asm volatile("s_waitcnt vmcnt(" #N ") lgkmcnt(0)\n\ts_barrier":::"memory")

__device__ __forceinline__ void qkt(f32x16&p0,f32x16&p1,const char*Kslot,const bf16x8*qr,int r32,int hi){
  const char*kb=Kslot+hi*1024+r32*16;
  #pragma unroll
  for(int d0=0;d0<4;++d0){
    const bf16x8 b0=*reinterpret_cast<const bf16x8*>(kb+d0*2048);
    const bf16x8 b1=*reinterpret_cast<const bf16x8*>(kb+d0*2048+512);
    p0=__builtin_amdgcn_mfma_f32_32x32x16_bf16(b0,qr[d0],p0,0,0,0);p1=__builtin_amdgcn_mfma_f32_32x32x16_bf16(b1,qr[d0],p1,0,0,0);}
}
typedef __attribute__((address_space(3))) const char* lds_cptr;
typedef short v4i16_t __attribute__((ext_vector_type(4)));
__device__ __forceinline__ void kload8(bf16x8*kf,lds_cptr kp){
  kf[0]=*(const __attribute__((address_space(3))) bf16x8*)(kp);      kf[1]=*(const __attribute__((address_space(3))) bf16x8*)(kp+512);
  kf[2]=*(const __attribute__((address_space(3))) bf16x8*)(kp+2048); kf[3]=*(const __attribute__((address_space(3))) bf16x8*)(kp+2560);
  kf[4]=*(const __attribute__((address_space(3))) bf16x8*)(kp+4096); kf[5]=*(const __attribute__((address_space(3))) bf16x8*)(kp+4608);
  kf[6]=*(const __attribute__((address_space(3))) bf16x8*)(kp+6144); kf[7]=*(const __attribute__((address_space(3))) bf16x8*)(kp+6656);
}
__device__ __forceinline__ void kload2(bf16x8*kf,lds_cptr kp,int j){ kf[2*j]=*(const __attribute__((address_space(3))) bf16x8*)(kp+j*2048); kf[2*j+1]=*(const __attribute__((address_space(3))) bf16x8*)(kp+j*2048+512); }
__device__ __forceinline__ s16x4 vtr(lds_cptr p){ return __builtin_bit_cast(s16x4,__builtin_amdgcn_ds_read_tr16_b64_v4i16((__attribute__((address_space(3))) v4i16_t*)p)); }
__device__ __forceinline__ float rowmax(const f32x16&p0,const f32x16&p1){
  float a=max3f(p0[0],p0[1],p1[0]),b=max3f(p0[2],p0[3],p1[1]);a=max3f(a,p1[2],p1[3]);
  #pragma unroll
  for(int r=4;r<16;r+=4){a=max3f(a,p0[r],p0[r+1]);b=max3f(b,p0[r+2],p0[r+3]);a=max3f(a,p1[r],p1[r+1]);b=max3f(b,p1[r+2],p1[r+3]);}
  const float m=max2f(a,b);
  auto rr=__builtin_amdgcn_permlane32_swap(__float_as_uint(m),__float_as_uint(m),false,false);
  return max2f(__uint_as_float(rr[0]),__uint_as_float(rr[1]));
}
__device__ __forceinline__ void pv(f32x16*o,int vb,bf16x8 pa0,bf16x8 pa1,bf16x8 pa2,bf16x8 pa3){
  #pragma unroll
  for(int d0=0;d0<2;++d0){s16x4 lo[4],hi[4];
    #pragma unroll
    for(int ks=0;ks<4;++ks){
      asm volatile("ds_read_b64_tr_b16 %0,%1 offset:%c2":"=&v"(lo[ks]):"v"(vb),"i"(d0*4096+ks*1024):"memory");
      asm volatile("ds_read_b64_tr_b16 %0,%1 offset:%c2":"=&v"(hi[ks]):"v"(vb),"i"(d0*4096+ks*1024+512):"memory");}
    asm volatile("s_waitcnt lgkmcnt(0)":::"memory");SBAR();
    #define PK(k) (bf16x8){lo[k][0],lo[k][1],lo[k][2],lo[k][3],hi[k][0],hi[k][1],hi[k][2],hi[k][3]}
    o[d0]=__builtin_amdgcn_mfma_f32_32x32x16_bf16(pa0,PK(0),o[d0],0,0,0);
    o[d0]=__builtin_amdgcn_mfma_f32_32x32x16_bf16(pa1,PK(1),o[d0],0,0,0);
    o[d0]=__builtin_amdgcn_mfma_f32_32x32x16_bf16(pa2,PK(2),o[d0],0,0,0);
    o[d0]=__builtin_amdgcn_mfma_f32_32x32x16_bf16(pa3,PK(3),o[d0],0,0,0);
    #undef PK
  }
}

#ifndef ATTN_STORE16
#define ATTN_STORE16(p,v) (*(u32x4*)(p)=(v))
#endif
template<int THRL> __device__ __forceinline__ void attn_unit(int b,int h,int qb,const bf16*Q,const bf16*__restrict__ K,const bf16*__restrict__ V,bf16*O,const bf16*__restrict__ SZ,char*shm){
  int tid_=threadIdx.x; asm volatile("":"+v"(tid_)); const int tid=tid_,lane=tid&63,r32=lane&31,hi=lane>>5; const int wid=__builtin_amdgcn_readfirstlane(tid>>6);
  const long rowbase=(long)b*SEQ; const int q0=qb*QB;
  const bf16*Qw=Q+(rowbase+q0+wid*QBLK)*DM+h*D;
  const bf16*Kh=K+rowbase*DM+h*D,*Vh=V+rowbase*DM+h*D;
  const unsigned lds0=(unsigned)(uintptr_t)shm;
  float*wsf=(float*)(shm+LDS_WS)+wid*64;
  const bf16*ksrc=Kh+(long)lane*DM+wid*8;
  const bf16*vsrc=Vh+(long)(16*(wid&3)+(lane>>2))*DM+(wid>>2)*32+(lane&3)*8;
  const unsigned kdst=lds0+LDS_K+wid*1024, vdst=lds0+LDS_V+wid*1024;
  #define DMA_K(t,slot) glds16(ksrc+(long)(t)*KVBLK*DM,(unsigned)__builtin_amdgcn_readfirstlane(kdst+(slot)))
  #define DMA_V(t,slot) glds16(vsrc+(long)(t)*KVBLK*DM,(unsigned)__builtin_amdgcn_readfirstlane(vdst+(slot)))
  const int vb0=(int)(lds0+LDS_V)+((lane>>4)&1)*32+(lane&3)*8+(4*hi+((lane&15)>>2))*64;
  const char*Kbase=shm+LDS_K; bf16x8 kf[8];
  const lds_cptr shm3=(lds_cptr)shm; const lds_cptr kp0=shm3+LDS_K+hi*1024+r32*16; const lds_cptr vp0=shm3+LDS_V+((lane>>4)&1)*32+(lane&3)*8+(4*hi+((lane&15)>>2))*64;
  const int NT=(q0+QB)/KVBLK;
  DMA_K(0,0);DMA_V(0,0);DMA_K(1,SLOTB);
  bf16x8 qr[4];
  #pragma unroll
  for(int d0=0;d0<4;++d0)qr[d0]=*reinterpret_cast<const bf16x8*>(&Qw[(long)r32*DM+d0*16+hi*8]);
  float l_reg=0.f;f32x16 o[2];o[0]=f32x16{};o[1]=f32x16{};
  const int qrel=wid*QBLK+r32;
  const __attribute__((address_space(3))) float* Fs3=(const __attribute__((address_space(3))) float*)((lds_cptr)shm+LDS_FS);
  float fqm=Fs3[q0+qrel];
  #define BIAS(C0,C1,t) do{ const __attribute__((address_space(3))) f32x4v* fk_=(const __attribute__((address_space(3))) f32x4v*)(Fs3+(t)*64+4*hi); \
    _Pragma("unroll") for(int i_=0;i_<4;++i_){ const f32x4v a_=fk_[2*i_], b_=fk_[2*i_+8]; \
      _Pragma("unroll") for(int k_=0;k_<4;++k_){ C0[4*i_+k_]=fqm-a_[k_]; C1[4*i_+k_]=fqm-b_[k_]; } } }while(0)
  #define CMASK(P0,P1,t) do{int jb_=(t)-(NT-4); if(jb_>=0)cmask(P0,P1,jb_,qrel,hi);}while(0)
  bool resc=false;
  #define START(P0,P1) do{ const float rm=rowmax(P0,P1); resc=false; \
    { const float dl=rm; fqm=fsub_s(fqm,dl); \
      _Pragma("unroll") for(int r=0;r<16;++r){P0[r]=fsub_s(P0[r],dl);P1[r]=fsub_s(P1[r],dl);} } \
    _Pragma("unroll") for(int r=0;r<16;++r)P0[r]=__builtin_amdgcn_exp2f(P0[r]); }while(0)
  #define RESC() do{ if(resc){ asm volatile("s_waitcnt lgkmcnt(0)":::"memory"); \
      _Pragma("unroll") for(int d_=0;d_<2;++d_) _Pragma("unroll") for(int r=0;r<16;++r)o[d_][r]*=wsf[crow(r,hi)]; } }while(0)
  f32x16 pA0,pA1,pB0,pB1;
  int sl_prev=0,sl_cur=0,sl_next=SLOTB;
  #define ROT() do{sl_prev=sl_cur;sl_cur=sl_next;sl_next=(sl_next==(NSLOT-1)*SLOTB)?0:sl_next+SLOTB;}while(0)
  DMA_K(2,2*SLOTB);
  WAIT_BAR(3);
  BIAS(pA0,pA1,0); qkt(pA0,pA1,Kbase,qr,r32,hi);asm volatile("s_nop 15\n\ts_nop 7":"+v"(pA0),"+v"(pA1));CMASK(pA0,pA1,0);
  START(pA0,pA1);
  _Pragma("unroll") for(int r=0;r<16;++r)pA1[r]=__builtin_amdgcn_exp2f(pA1[r]);
  WAIT_BAR(0);
  DMA_K(3,0);DMA_V(1,SLOTB);
  ROT();
  kload8(kf,kp0+sl_cur);
  WAIT_BAR(2);
  s16x4 vlo[8],vhi[8]; u32x4 pw0,pw1,pw2,pw3;
  #define PKW(P,B) cvtpk_s(P[B],P[B+1])
  #define PAF(k) __builtin_bit_cast(bf16x8,pw##k)
  #define VFR(i) (bf16x8){vlo[i][0],vlo[i][1],vlo[i][2],vlo[i][3],vhi[i][0],vhi[i][1],vhi[i][2],vhi[i][3]}
  #define PIN(x) asm volatile("":"+v"(x))
  #define MX3(a,b,c) __builtin_fmaxf(__builtin_fmaxf((a),(b)),(c))
  #define GAPA(MF,A0,A1,A2,A3,W0,W1,PW) do{ MF; sacc+=A0; sacc+=A1; sacc+=A2; sacc+=A3; PIN(sacc); W0; W1; PIN(PW); SBAR(); }while(0)
  #define EX(v) __builtin_amdgcn_exp2f(v)
  #define GAPB(MF,X,B) do{ MF; X[B]=EX(X[B]); X[B+1]=EX(X[B+1]); X[B+2]=EX(X[B+2]); X[B+3]=EX(X[B+3]); PIN(X); SBAR(); }while(0)
  #define VRD(i) do{ vlo[i]=vtr(vp_+(((i)>>2)*4096+((i)&3)*1024)); vhi[i]=vtr(vp_+(((i)>>2)*4096+((i)&3)*1024+512)); }while(0)
  #define KRD(G,j) do{ if(G){ kload2(kf,kp0+sl_next,j); SBAR(); } }while(0)
  #define STEP(C0,C1,P0,P1,t,GK,GV,GL) do{ SBAR(); BIAS(C0,C1,t); SBAR(); \
    const lds_cptr vp_=vp0+sl_prev; \
    VRD(0); SBAR(); float sacc=(P0[0]+P0[1]); \
    GAPA(C0=__builtin_amdgcn_mfma_f32_32x32x16_bf16(kf[0],qr[0],C0,0,0,0), P0[2],P0[3],P0[4],P0[5],     pw0[0]=PKW(P0,0), pw0[1]=PKW(P0,2), pw0); \
    VRD(4); SBAR(); GAPA(C1=__builtin_amdgcn_mfma_f32_32x32x16_bf16(kf[1],qr[0],C1,0,0,0), P0[6],P0[7],P0[8],P0[9],     pw0[2]=PKW(P0,4), pw0[3]=PKW(P0,6), pw0); \
    VRD(1); SBAR(); GAPA(C0=__builtin_amdgcn_mfma_f32_32x32x16_bf16(kf[2],qr[1],C0,0,0,0),   P0[10],P0[11],P0[12],P0[13], pw1[0]=PKW(P0,8), pw1[1]=PKW(P0,10), pw1); \
    VRD(5); SBAR(); GAPA(C1=__builtin_amdgcn_mfma_f32_32x32x16_bf16(kf[3],qr[1],C1,0,0,0),   P0[14],P0[15],P1[0],P1[1],   pw1[2]=PKW(P0,12),pw1[3]=PKW(P0,14), pw1); \
    VRD(2); SBAR(); GAPA(C0=__builtin_amdgcn_mfma_f32_32x32x16_bf16(kf[4],qr[2],C0,0,0,0),   P1[2],P1[3],P1[4],P1[5],     pw2[0]=PKW(P1,0), pw2[1]=PKW(P1,2), pw2); \
    VRD(6); SBAR(); GAPA(C1=__builtin_amdgcn_mfma_f32_32x32x16_bf16(kf[5],qr[2],C1,0,0,0),   P1[6],P1[7],P1[8],P1[9],     pw2[2]=PKW(P1,4), pw2[3]=PKW(P1,6), pw2); \
    VRD(3); SBAR(); GAPA(C0=__builtin_amdgcn_mfma_f32_32x32x16_bf16(kf[6],qr[3],C0,0,0,0),   P1[10],P1[11],P1[12],P1[13], pw3[0]=PKW(P1,8), pw3[1]=PKW(P1,10), pw3); \
    VRD(7); SBAR(); GAPA(C1=__builtin_amdgcn_mfma_f32_32x32x16_bf16(kf[7],qr[3],C1,0,0,0),   P1[14],P1[15],0.f,0.f,       pw3[2]=PKW(P1,12),pw3[3]=PKW(P1,14), pw3); \
    l_reg+=sacc; \
    if(GK){DMA_K((t)+3,sl_cur);} if(GV){DMA_V((t)+1,sl_next);} \
    CMASK(C0,C1,t); \
    { float a=MX3(C0[0],C0[1],C1[0]),b=MX3(C0[2],C0[3],C1[1]); a=MX3(a,C1[2],C1[3]); \
      _Pragma("unroll") for(int r=4;r<16;r+=4){a=MX3(a,C0[r],C0[r+1]);b=MX3(b,C0[r+2],C0[r+3]);a=MX3(a,C1[r],C1[r+1]);b=MX3(b,C1[r+2],C1[r+3]);} \
      float rm=__builtin_fmaxf(a,b); { auto rr=__builtin_amdgcn_permlane32_swap(__float_as_uint(rm),__float_as_uint(rm),false,false); rm=__builtin_fmaxf(__uint_as_float(rr[0]),__uint_as_float(rr[1])); } \
      resc=false; \
      if(__builtin_expect(__any(rm>(float)THRL),0)){ const float dl=__builtin_fmaxf(rm,0.f); fqm-=dl; \
        _Pragma("unroll") for(int r=0;r<16;++r){C0[r]-=dl;C1[r]-=dl;} \
        const float f=__builtin_amdgcn_exp2f(-dl); l_reg*=f; if(hi==0)wsf[r32]=f; resc=true; } } \
    SBAR(); \
    GAPB(o[0]=__builtin_amdgcn_mfma_f32_32x32x16_bf16(PAF(0),VFR(0),o[0],0,0,0), C0,0); \
    GAPB(o[1]=__builtin_amdgcn_mfma_f32_32x32x16_bf16(PAF(0),VFR(4),o[1],0,0,0), C0,4); \
    KRD(GL,0); GAPB(o[0]=__builtin_amdgcn_mfma_f32_32x32x16_bf16(PAF(1),VFR(1),o[0],0,0,0), C0,8); \
    KRD(GL,1); GAPB(o[1]=__builtin_amdgcn_mfma_f32_32x32x16_bf16(PAF(1),VFR(5),o[1],0,0,0), C0,12); \
    KRD(GL,2); GAPB(o[0]=__builtin_amdgcn_mfma_f32_32x32x16_bf16(PAF(2),VFR(2),o[0],0,0,0), C1,0); \
    KRD(GL,3); GAPB(o[1]=__builtin_amdgcn_mfma_f32_32x32x16_bf16(PAF(2),VFR(6),o[1],0,0,0), C1,4); \
    GAPB(o[0]=__builtin_amdgcn_mfma_f32_32x32x16_bf16(PAF(3),VFR(3),o[0],0,0,0), C1,8); \
    GAPB(o[1]=__builtin_amdgcn_mfma_f32_32x32x16_bf16(PAF(3),VFR(7),o[1],0,0,0), C1,12); \
    }while(0)
  int t=1;
  #undef CMASK
  #define CMASK(P0,P1,t) do{}while(0)
  for(;t+5<NT;t+=2){
    STEP(pB0,pB1,pA0,pA1,t,true,true,true);     WAIT_BAR(2); RESC(); ROT();
    STEP(pA0,pA1,pB0,pB1,t+1,true,true,true);   WAIT_BAR(2); RESC(); ROT();
  }
  #undef CMASK
  #define CMASK(P0,P1,t) do{int jb_=(t)-(NT-4); if(jb_>=0)cmask(P0,P1,jb_,qrel,hi);}while(0)
  #define ENDW(tt) do{ if((tt)+3<NT){WAIT_BAR(2);} else if((tt)+2<NT){WAIT_BAR(1);} else {WAIT_BAR(0);} }while(0)
  for(;t+1<NT;t+=2){
    STEP(pB0,pB1,pA0,pA1,t,(t+3<NT),(t+1<NT),(t+1<NT));       ENDW(t);   RESC(); ROT();
    STEP(pA0,pA1,pB0,pB1,t+1,(t+4<NT),(t+2<NT),(t+2<NT));     ENDW(t+1); RESC(); ROT();
  }
  STEP(pB0,pB1,pA0,pA1,NT-1,false,false,false); RESC();
  { float sacc=pB0[0]+pB0[1]; _Pragma("unroll") for(int r=2;r<16;++r)sacc+=pB0[r]; _Pragma("unroll") for(int r=0;r<16;++r)sacc+=pB1[r]; l_reg+=sacc;
    pw0=(u32x4){PKW(pB0,0),PKW(pB0,2),PKW(pB0,4),PKW(pB0,6)};pw1=(u32x4){PKW(pB0,8),PKW(pB0,10),PKW(pB0,12),PKW(pB0,14)};pw2=(u32x4){PKW(pB1,0),PKW(pB1,2),PKW(pB1,4),PKW(pB1,6)};pw3=(u32x4){PKW(pB1,8),PKW(pB1,10),PKW(pB1,12),PKW(pB1,14)};
    SBAR(); pv(o,vb0+sl_cur,PAF(0),PAF(1),PAF(2),PAF(3)); }
  #undef PKW
  #undef PAF
  #undef VFR
  #undef PIN
  #undef MX3
  #undef GAPA
  #undef GAPB
  #undef EX
  #undef VRD
  #undef KRD
  #undef STEP
  #undef ENDW
  {auto rr=__builtin_amdgcn_permlane32_swap(__float_as_uint(l_reg),__float_as_uint(l_reg),false,false);l_reg=__uint_as_float(rr[0])+__uint_as_float(rr[1]);}
  if(hi==0)wsf[32+r32]=l_reg;asm volatile("s_waitcnt lgkmcnt(0)":::"memory");
  float rli[16];
  #pragma unroll
  for(int r=0;r<16;++r)rli[r]=__builtin_amdgcn_rcpf(wsf[32+crow(r,hi)]);
  bf16*Ow=O+(rowbase+q0+wid*QBLK)*DM+h*D;
  { bf16*stg=(bf16*)(shm+LDS_OST)+wid*2048;
    #pragma unroll
    for(int r=0;r<16;++r){const int orow=crow(r,hi);
      #pragma unroll
      for(int d0=0;d0<2;++d0)stg[orow*64+d0*32+r32]=__float2bfloat16(o[d0][r]*rli[r]);}
    asm volatile("s_waitcnt lgkmcnt(0)":::"memory");
    const bf16*SZw=SZ+(rowbase+q0+wid*QBLK)*DM+h*D;
    #pragma unroll
    for(int i=0;i<4;++i){const int row=i*8+(lane>>3),ch=lane&7; const u32x4 v=*(const u32x4*)(stg+row*64+ch*8); const u32x4 g=*(const u32x4*)(SZw+(long)row*DM+ch*8); u32x4 w;
      #pragma unroll
      for(int k=0;k<4;++k){ const float a0=__uint_as_float(v[k]<<16)*__uint_as_float(g[k]<<16), a1=__uint_as_float(v[k]&0xffff0000u)*__uint_as_float(g[k]&0xffff0000u); w[k]=cvtpk_s(a0,a1); }
      ATTN_STORE16(Ow+(long)row*DM+ch*8,w);} }
  asm volatile("s_waitcnt lgkmcnt(0)\n\ts_barrier":::"memory");
  #undef DMA_K
  #undef DMA_V
  #undef CMASK
  #undef START
  #undef RESC
  #undef ROT
  #undef BIAS
}
constexpr int ATTN_LDS_BYTES=LDS_BYTES;
struct AttnTensors { const bf16* Q; const bf16* K; const bf16* V; bf16* O; const bf16* SZ; const float* LF; };
template<int THRL=8> __device__ __forceinline__ void attn_phase(char*lds,const AttnTensors&T,int vcu,int G){
  #pragma unroll 1
  for(int task=vcu;task<BATCH*NHEAD*2;task+=G){
    int tid=threadIdx.x; asm volatile("":"+v"(tid)); const int lane=tid&63,wid=tid>>6;
    const int bh=task>>1,s=task&1,b=bh/NHEAD,h=bh%NHEAD;
    { __attribute__((address_space(3))) float* Fs=(__attribute__((address_space(3))) float*)((lds_cptr)lds+LDS_FS);
      __attribute__((address_space(3))) float* WT=(__attribute__((address_space(3))) float*)((lds_cptr)lds+LDS_SCAN);
      const float* lf=T.LF+((long)b*SEQ+4*tid)*NHEAD+h;
      const float v0=lf[0],v1=lf[NHEAD],v2=lf[2*NHEAD],v3=lf[3*NHEAD];
      const float p1=v0+v1,p2=p1+v2,p3=p2+v3; float x=p3;
      #pragma unroll
      for(int off=1;off<64;off<<=1){const float y=__shfl_up(x,off); if(lane>=off)x+=y;}
      if(lane==63)WT[wid]=x;
      __syncthreads();
      float offs=0.f;
      #pragma unroll
      for(int w=0;w<NW;++w){const float tv=WT[w]; if(w<wid)offs+=tv;}
      const float ex=x-p3+offs; const float L2E=1.4426950408889634f;
      f32x4v o4; o4[0]=(ex+v0)*L2E; o4[1]=(ex+p1)*L2E; o4[2]=(ex+p2)*L2E; o4[3]=(ex+p3)*L2E;
      *(__attribute__((address_space(3))) f32x4v*)(Fs+4*tid)=o4;
      __syncthreads(); }
    #pragma unroll 1
    for(int i=0;i<4;++i){ const int qb=(i==0)?7-s:(i==1)?s:(i==2)?4+s:3-s;
      attn_unit<THRL>(b,h,qb,T.Q,T.K,T.V,T.O,T.SZ,lds); }
  }
}
#undef SBAR
#undef WAIT_BAR
}
#define GAS __attribute__((address_space(1)))
#define LAS __attribute__((address_space(3)))
typedef unsigned short bf16u;
typedef unsigned v4u __attribute__((ext_vector_type(4)));
typedef float f32x4 __attribute__((ext_vector_type(4)));
typedef float f32x16 __attribute__((ext_vector_type(16)));
typedef short bf16x8 __attribute__((ext_vector_type(8)));
#define LDS_WAIT() asm volatile("s_waitcnt lgkmcnt(0)" ::: "memory")

constexpr int NWAVES = 8;
constexpr int BATCH = 8, SEQ = 2048, D = 1024, M = BATCH * SEQ, NG = 64, NST = 64, NH = 16;
constexpr float EPS = 1e-6f;
constexpr float C2 = 0.125f * 1.4426950408889634f;

constexpr size_t MiB = 1u << 20;
constexpr size_t WS_W_IN_A = 0 * MiB, WS_W_GLU = 4 * MiB, WS_W_OUT_A = 6 * MiB, WS_W_KV = 8 * MiB, WS_W_IN_B = 12 * MiB, WS_W_OUT_B = 16 * MiB;
constexpr size_t WS_W_F = 18 * MiB;
constexpr size_t WS_MODP = 220 * MiB;
constexpr size_t WS_GATE = 21 * MiB;
constexpr size_t WS_ABAR = 21 * MiB + 128 * 1024, WS_AL = WS_ABAR + 32 * 1024, WS_BFRAG = WS_AL + 32 * 1024, WS_CFRAG = WS_BFRAG + 256 * 1024;
constexpr size_t WS_CTL = 21 * MiB + 768 * 1024, CTL_ZERO_BYTES = 16384;
constexpr size_t WS_E = 22 * MiB;
constexpr size_t WS_UZ = 24 * MiB;
constexpr size_t WS_K = 24 * MiB, WS_V = 56 * MiB;
constexpr size_t WS_R2 = 88 * MiB;
constexpr size_t WS_R3 = 120 * MiB;
constexpr size_t WS_QO = 152 * MiB, WS_SZ = 184 * MiB;
constexpr size_t WS_LF = 216 * MiB;
constexpr size_t WS_END = 224 * MiB;
constexpr int LDS_BYTES = 147456;

__device__ __forceinline__ unsigned f2bf(float f) { unsigned u = __builtin_bit_cast(unsigned, f); return (u + 0x7fffu + ((u >> 16) & 1u)) >> 16; }
__device__ __forceinline__ unsigned pk2(float lo, float hi) { return f2bf(lo) | (f2bf(hi) << 16); }
__device__ __forceinline__ float wave_sum(float v) {
#pragma unroll
    for (int o = 1; o < 64; o <<= 1) v += __shfl_xor(v, o);
    return v;
}
__host__ __device__ __forceinline__ int phys_row(int n) { const int q = n & 255; return (n - q) + 128 * ((q >> 5) & 1) + 32 * (q >> 6) + (q & 31); }

struct Args { const float* in[29]; float* out; unsigned char* ws; };

__device__ __forceinline__ void p0_transpose_item(const float* W, int ldw, int K, int N, bf16u* WT, LAS float* scr, int item, int lane) {
    const int nblk = N / 32, kb = item / nblk, nb = item % nblk, k0 = 64 * kb, n0 = 32 * nb;
#pragma unroll 8
    for (int i = 0; i < 32; ++i) { const int kk = 2 * i + (lane >> 5); scr[kk * 33 + (lane & 31)] = W[(size_t)(k0 + kk) * ldw + n0 + (lane & 31)]; }
    LDS_WAIT(); asm volatile("" ::: "memory");
    const int c = lane & 7; const int pr0 = phys_row(n0);
#pragma unroll
    for (int j = 0; j < 4; ++j) { const int n = (lane >> 3) + 8 * j; const LAS float* s = scr + (8 * c) * 33 + n;
        v4u o; o.x = pk2(s[0 * 33], s[1 * 33]); o.y = pk2(s[2 * 33], s[3 * 33]); o.z = pk2(s[4 * 33], s[5 * 33]); o.w = pk2(s[6 * 33], s[7 * 33]);
        *(v4u*)(WT + (size_t)(pr0 + n) * K + k0 + 8 * c) = o; }
    LDS_WAIT(); asm volatile("" ::: "memory");
}

__device__ __forceinline__ void sincos_d(double x, double& s, double& c) {
    const double kq = rint(x * 0.63661977236758134308), r = fma(-kq, 1.57079632679489661923, x) - kq * 6.123233995736766e-17, r2 = r * r;
    double sp = -7.6471637318198165e-13; sp = fma(sp, r2, 1.6059043836821613e-10); sp = fma(sp, r2, -2.5052108385441720e-08); sp = fma(sp, r2, 2.7557319223985893e-06);
    sp = fma(sp, r2, -1.9841269841269841e-04); sp = fma(sp, r2, 8.3333333333333332e-03); sp = fma(sp, r2, -1.6666666666666666e-01); sp = fma(sp * r2, r, r);
    double cp = 4.7794773323873853e-14; cp = fma(cp, r2, -1.1470745597729725e-11); cp = fma(cp, r2, 2.0876756987868100e-09); cp = fma(cp, r2, -2.7557319223985888e-07);
    cp = fma(cp, r2, 2.4801587301587302e-05); cp = fma(cp, r2, -1.3888888888888889e-03); cp = fma(cp, r2, 4.1666666666666664e-02); cp = fma(cp, r2, -0.5); cp = fma(cp, r2, 1.0);
    const int q = ((int)kq) & 3;
    s = (q == 0) ? sp : (q == 1) ? cp : (q == 2) ? -sp : -cp;
    c = (q == 0) ? cp : (q == 1) ? -sp : (q == 2) ? -cp : sp;
}

#define XB_TMO      128
#define XB_XCNT(j)  (256  + 64 * (j))
#define XB_XSUB(j)  (1280 + 64 * (j))
#define XB_XGEN(j)  (2304 + 64 * (j))
#define XB_TOP      3328
#define XB_TOPGEN   3392
#define XCD_BAR_WORDS 3456
#define XB_SPIN_CAP (1u << 18)

__device__ __forceinline__ unsigned xb_ld(unsigned* p)              { return __hip_atomic_load(p, __ATOMIC_RELAXED, __HIP_MEMORY_SCOPE_AGENT); }
__device__ __forceinline__ unsigned xb_add(unsigned* p, unsigned v) { return __hip_atomic_fetch_add(p, v, __ATOMIC_RELAXED, __HIP_MEMORY_SCOPE_AGENT); }
__device__ __forceinline__ unsigned xb_xcc_id() { return (unsigned)__builtin_amdgcn_s_getreg((3 << 11) | 20) & 0xFu; }
#define XB_SPIN(cond, bar) do { unsigned _sp = 0; while (cond) { __builtin_amdgcn_s_sleep(1); \
    if ((++_sp & 255u) == 0u) { if (xb_ld(&(bar)[XB_TMO])) break; if (_sp > XB_SPIN_CAP) { atomicAdd(&(bar)[XB_TMO], 1u); break; } } } } while (0)

struct XcdBarrier {
    unsigned* bar; unsigned x;
    volatile LAS unsigned* st;
};

__device__ __forceinline__ XcdBarrier xcd_barrier_post(unsigned* bar, volatile LAS unsigned* st) {
    XcdBarrier b; b.bar = bar; b.x = xb_xcc_id(); b.st = st;
    if (threadIdx.x == 0) st[2] = xb_add(&bar[XB_XCNT(b.x)], 1u);
    return b;
}
__device__ __forceinline__ void xcd_barrier_complete(unsigned* bar, unsigned x, unsigned& nloc, unsigned& nx) {
    const unsigned G = gridDim.x * gridDim.y * gridDim.z;
    unsigned sum, cnt, mine, sp = 0u;
    for (;;) {
        sum = 0u; cnt = 0u; mine = 0u;
#pragma unroll
        for (unsigned j = 0; j < 16; ++j) { const unsigned c = xb_ld(&bar[XB_XCNT(j)]); sum += c; cnt += (c > 0u) ? 1u : 0u; mine = (j == x) ? c : mine; }
        if (sum == G) break;
        __builtin_amdgcn_s_sleep(1);
        if ((++sp & 255u) == 0u) { if (xb_ld(&bar[XB_TMO])) break; if (sp > XB_SPIN_CAP) { atomicAdd(&bar[XB_TMO], 1u); break; } }
    }
    nloc = mine > 0u ? mine : 1u; nx = cnt > 0u ? cnt : 1u;
}

__device__ __forceinline__ void xcd_barrier(const XcdBarrier& b) {
    asm volatile("s_waitcnt vmcnt(0)" ::: "memory");
    __syncthreads();
    if (threadIdx.x == 0) {
        unsigned* bar = b.bar;
        __builtin_amdgcn_s_waitcnt(0);
        unsigned nloc = b.st[0], nx = b.st[1];
        if (nloc == 0u) { xcd_barrier_complete(bar, b.x, nloc, nx); b.st[0] = nloc; b.st[1] = nx; }
        const unsigned old = xb_add(&bar[XB_XSUB(b.x)], 1u);
        const unsigned gen = old / nloc;
        if (old + 1u == (gen + 1u) * nloc) {
            __builtin_amdgcn_fence(__ATOMIC_RELEASE, "agent");
            asm volatile("s_waitcnt vmcnt(0)" ::: "memory");
            const unsigned og = xb_add(&bar[XB_TOP], 1u);
            const unsigned tg = og / nx;
            if (og + 1u == (tg + 1u) * nx) xb_add(&bar[XB_TOPGEN], 1u);
            else XB_SPIN(xb_ld(&bar[XB_TOPGEN]) == tg, bar);
            __builtin_amdgcn_fence(__ATOMIC_ACQUIRE, "agent");
            xb_add(&bar[XB_XGEN(b.x)], 1u);
            asm volatile("s_waitcnt vmcnt(0)" ::: "memory");
        } else {
            XB_SPIN(xb_ld(&bar[XB_XGEN(b.x)]) == gen, bar);
            __builtin_amdgcn_fence(__ATOMIC_ACQUIRE, "agent");
            asm volatile("s_waitcnt vmcnt(0)" ::: "memory");
        }
    }
    __syncthreads();
}
#define REP_LOOP(k) REP_LOOP_(REP_P##k)
#define REP_LOOP_(n) REP_LOOP__(n)
#define REP_LOOP__(n) REP_LOOP_##n
#define REP_LOOP_1
#define REP_LOOP_2 _Pragma("unroll 1") for (int rep_ = 0; rep_ < 2; ++rep_)
#define REP_LOOP_3 _Pragma("unroll 1") for (int rep_ = 0; rep_ < 3; ++rep_)
#ifndef REP_P0
#define REP_P0 1
#endif
#ifndef REP_P1
#define REP_P1 1
#endif
#ifndef REP_P2
#define REP_P2 1
#endif
#ifndef REP_P3
#define REP_P3 1
#endif
#ifndef REP_P4
#define REP_P4 1
#endif
#ifndef REP_P5
#define REP_P5 1
#endif
#ifndef REP_P6
#define REP_P6 1
#endif
#ifndef REP_P7
#define REP_P7 1
#endif
#ifndef PH_MASK
#define PH_MASK 0x3ff
#endif
__device__ __forceinline__ float sigm_f(float x) { return __builtin_amdgcn_rcpf(1.0f + __builtin_amdgcn_exp2f(-1.4426950408889634f * x)); }
__device__ __forceinline__ float gelu_tanh(float y) { const float t = 1.5957691216057308f * (y + 0.044715f * y * y * y); return y * sigm_f(t); }
__device__ __forceinline__ int crow16(int r, int hi) { return (r & 3) + 8 * (r >> 2) + 4 * hi; }

template <int NOUT> __device__ __forceinline__ void norm_rows(const float* X, int v, int wave, int lane, const LAS float* GS0, const LAS float* SH0, bf16u* O0, const LAS float* GS1, const LAS float* SH1, bf16u* O1) {
    f32x4 gs0[4], sh0[4], gs1[4], sh1[4];
#pragma unroll
    for (int j = 0; j < 4; ++j) { gs0[j] = *(const LAS f32x4*)(GS0 + 256 * j + 4 * lane); sh0[j] = *(const LAS f32x4*)(SH0 + 256 * j + 4 * lane);
        if (NOUT == 2) { gs1[j] = *(const LAS f32x4*)(GS1 + 256 * j + 4 * lane); sh1[j] = *(const LAS f32x4*)(SH1 + 256 * j + 4 * lane); } }
#pragma unroll 2
    for (int i = 0; i < 8; ++i) { const size_t row = (size_t)(64 * v + 8 * wave + i);
        const f32x4* xr = (const f32x4*)(X + row * D) + lane;
        f32x4 x[4]; float s = 0.f;
#pragma unroll
        for (int j = 0; j < 4; ++j) { x[j] = xr[64 * j]; s += (x[j].x * x[j].x + x[j].y * x[j].y) + (x[j].z * x[j].z + x[j].w * x[j].w); }
        const float r = 1.0f / sqrtf(wave_sum(s) * (1.0f / D) + EPS);
        unsigned long long* o0 = (unsigned long long*)(O0 + row * D) + lane;
#pragma unroll
        for (int j = 0; j < 4; ++j) { const f32x4 h = x[j] * r * gs0[j] + sh0[j]; o0[64 * j] = (unsigned long long)pk2(h.x, h.y) | ((unsigned long long)pk2(h.z, h.w) << 32); }
        if (NOUT == 2) { unsigned long long* o1 = (unsigned long long*)(O1 + row * D) + lane;
#pragma unroll
            for (int j = 0; j < 4; ++j) { const f32x4 h = x[j] * r * gs1[j] + sh1[j]; o1[64 * j] = (unsigned long long)pk2(h.x, h.y) | ((unsigned long long)pk2(h.z, h.w) << 32); } }
    }
}
__device__ __forceinline__ void mod_vectors(const float* MODP, const float* bias, const float* g, int b, int cbase, LAS float* GS, LAS float* SH, int tid) {
    for (int k = tid; k < D; k += NWAVES * 64) { float sh = bias[k], sc = bias[D + k];
#pragma unroll
        for (int ks = 0; ks < 16; ++ks) { const float* p = MODP + (size_t)(ks * 8 + b) * 8192 + cbase + k; sh += p[0]; sc += p[D]; }
        GS[k] = g[k] * (1.0f + sc); SH[k] = sh; }
}

template <int PASS> __device__ __forceinline__ void s5_scan(LAS unsigned char* lds, const bf16u* UZp, bf16u* Y1, const float2* ABARp, const float2* ALp, const bf16u* BFRAGp, const bf16u* CFRAGp, const float* Dvec, int blk, int wave, int lane) {
    LAS unsigned char* Sl = lds + wave * 9728;
    LAS unsigned char* Ul = Sl + 8704;
    const int j = lane & 31, hi = lane >> 5;
    LAS f32x4* El = (LAS f32x4*)(lds + 8 * 9728);
    {
        const int seg = wave, g = blk & 63, bp = blk >> 6;
        if (PASS == 0 && seg == 7) return;
        const int seqA = (j >> 2) & 1, timeA = (j & 3) + 4 * (j >> 3);
        const bf16u* ap = UZp + ((size_t)((bp + 4 * seqA) * SEQ + seg * 256 + timeA)) * 2048 + g * 16 + 8 * hi;
        bf16x8 at[4];
#pragma unroll
        for (int q = 0; q < 4; ++q) at[q] = *(const bf16x8*)(ap + (size_t)q * 16 * 2048);
        f32x4 ev[7];
        if (PASS == 1) {
#pragma unroll
            for (int k = 0; k < 7; ++k) ev[k] = (k < seg) ? El[k * 64 + lane] : (f32x4){0.f, 0.f, 0.f, 0.f}; }
        const float2 a0 = ABARp[g * 64 + j], a1 = ABARp[g * 64 + 32 + j];
        bf16x8 bfr[4], cfr[4];
#pragma unroll
        for (int c = 0; c < 4; ++c) bfr[c] = *(const bf16x8*)(BFRAGp + ((size_t)(g * 4 + c) * 64 + lane) * 8);
        if (PASS == 1) {
#pragma unroll
            for (int c = 0; c < 4; ++c) cfr[c] = *(const bf16x8*)(CFRAGp + ((size_t)(g * 4 + c) * 64 + lane) * 8); }
        float s0r = 0.f, s0i = 0.f, s1r = 0.f, s1i = 0.f;
        if (PASS == 1) { const float2 l0 = ALp[g * 64 + j], l1 = ALp[g * 64 + 32 + j];
#pragma unroll
            for (int k = 0; k < 7; ++k) if (k < seg) { const f32x4 e = ev[k];
                const float n0r = l0.x * s0r - l0.y * s0i + e.x, n0i = l0.x * s0i + l0.y * s0r + e.y; s0r = n0r; s0i = n0i;
                const float n1r = l1.x * s1r - l1.y * s1i + e.z, n1i = l1.x * s1i + l1.y * s1r + e.w; s1r = n1r; s1i = n1i; } }
        const float dv = (PASS == 1) ? Dvec[g * 16 + (lane & 15)] : 0.f;
#pragma unroll 1
        for (int tg = 0; tg < 4; ++tg) {
#pragma unroll
            for (int tq = 0; tq < 4; ++tq) {
                const int tile = tg * 4 + tq;
                bf16x8 a = at[tq];
                asm volatile("" : "+v"(a) : "v"(s0r), "v"(s1r));
                if (tg < 3) at[tq] = *(const bf16x8*)(ap + (size_t)(tile + 4) * 16 * 2048);
                f32x16 acc[4];
#pragma unroll
                for (int c = 0; c < 4; ++c) { f32x16 z = {}; acc[c] = __builtin_amdgcn_mfma_f32_32x32x16_bf16(a, bfr[c], z, 0, 0, 0); }
                if (PASS == 1) *(LAS bf16x8*)(Ul + j * 32 + hi * 16) = a;
#pragma unroll
                for (int r = 0; r < 16; ++r) {
                    const float n0r = a0.x * s0r - a0.y * s0i + acc[0][r], n0i = a0.x * s0i + a0.y * s0r + acc[1][r]; s0r = n0r; s0i = n0i; acc[0][r] = n0r; acc[1][r] = n0i;
                    const float n1r = a1.x * s1r - a1.y * s1i + acc[2][r], n1i = a1.x * s1i + a1.y * s1r + acc[3][r]; s1r = n1r; s1i = n1i; acc[2][r] = n1r; acc[3][r] = n1i; }
                if (PASS == 1) {
#pragma unroll
                    for (int r = 0; r < 16; ++r) { const int row = crow16(r, hi);
                        *(LAS unsigned*)(Sl + row * 272 + 4 * j) = pg8::cvt_pk_bf16(acc[0][r], acc[1][r]);
                        *(LAS unsigned*)(Sl + row * 272 + 128 + 4 * j) = pg8::cvt_pk_bf16(acc[2][r], acc[3][r]); }
                    LDS_WAIT();
                    f32x4 Y[2] = {{0.f, 0.f, 0.f, 0.f}, {0.f, 0.f, 0.f, 0.f}};
#pragma unroll
                    for (int mt = 0; mt < 2; ++mt)
#pragma unroll
                        for (int ks = 0; ks < 4; ++ks) { const bf16x8 af = *(const LAS bf16x8*)(Sl + (16 * mt + (lane & 15)) * 272 + (32 * ks + 8 * (lane >> 4)) * 2);
                            Y[mt] = __builtin_amdgcn_mfma_f32_16x16x32_bf16(af, cfr[ks], Y[mt], 0, 0, 0); }
                    const int ch = lane & 15, lq = lane >> 4;
                    unsigned yoff = (unsigned)((((bp + 4 * (lq & 1)) * SEQ + seg * 256 + tile * 16 + 4 * (lq >> 1)) * D + g * 16 + ch) * 2);
                    asm volatile("" : "+v"(yoff));
                    float uv[2][4];
#pragma unroll
                    for (int mt = 0; mt < 2; ++mt)
#pragma unroll
                        for (int q = 0; q < 4; ++q) uv[mt][q] = __uint_as_float((unsigned)(*(const LAS unsigned short*)(Ul + (16 * mt + 4 * lq + q) * 32 + ch * 2)) << 16);
                    LDS_WAIT();
#pragma unroll
                    for (int mt = 0; mt < 2; ++mt)
#pragma unroll
                        for (int q = 0; q < 4; ++q) { const float y = gelu_tanh(Y[mt][q] + dv * uv[mt][q]);
                            *(bf16u*)((char*)Y1 + (yoff + (unsigned)((q + 8 * mt) * D * 2))) = (bf16u)f2bf(y); }
                }
            }
        }
        if (PASS == 0) El[seg * 64 + lane] = (f32x4){s0r, s0i, s1r, s1i};
    }
}


#define W_IN_A ((bf16u*)(GAS bf16u*)(ws + WS_W_IN_A))
#define W_GLU ((bf16u*)(GAS bf16u*)(ws + WS_W_GLU))
#define W_OUT_A ((bf16u*)(GAS bf16u*)(ws + WS_W_OUT_A))
#define W_KV ((bf16u*)(GAS bf16u*)(ws + WS_W_KV))
#define W_IN_B ((bf16u*)(GAS bf16u*)(ws + WS_W_IN_B))
#define W_OUT_B ((bf16u*)(GAS bf16u*)(ws + WS_W_OUT_B))
#define W_F ((bf16u*)(GAS bf16u*)(ws + WS_W_F))
#define MODP ((float*)(GAS float*)(ws + WS_MODP))
#define GATE ((float*)(GAS float*)(ws + WS_GATE))
#define ABAR ((float2*)(GAS float2*)(ws + WS_ABAR))
#define AL ((float2*)(GAS float2*)(ws + WS_AL))
#define BFRAG ((bf16u*)(GAS bf16u*)(ws + WS_BFRAG))
#define CFRAG ((bf16u*)(GAS bf16u*)(ws + WS_CFRAG))
#define E ((float4*)(GAS float4*)(ws + WS_E))
#define UZ ((bf16u*)(GAS bf16u*)(ws + WS_UZ))
#define KB ((bf16u*)(GAS bf16u*)(ws + WS_K))
#define VB ((bf16u*)(GAS bf16u*)(ws + WS_V))
#define R2 ((bf16u*)(GAS bf16u*)(ws + WS_R2))
#define R3 ((bf16u*)(GAS bf16u*)(ws + WS_R3))
#define QO ((bf16u*)(GAS bf16u*)(ws + WS_QO))
#define SZ ((bf16u*)(GAS bf16u*)(ws + WS_SZ))
#define LF ((float*)(GAS float*)(ws + WS_LF))
__device__ __forceinline__ const float* arg_in(const Args& a, int k) { asm volatile("" : "+s"(k)); return (const float*)(const GAS float*)a.in[k]; }
#define AIN(k) arg_in(args, (k))
#define PHASE_WS GAS unsigned char* ws = (GAS unsigned char*)args.ws; asm volatile("" : "+s"(ws))
__global__ void __launch_bounds__(NWAVES * 64, 2) fwd_mega(Args args) {
    extern __shared__ __attribute__((aligned(16))) unsigned char lds_raw[];
    cg::grid_group grid = cg::this_grid();
    LAS unsigned char* lds = (LAS unsigned char*)lds_raw;
    const int tid = threadIdx.x, lane = tid & 63, wave = __builtin_amdgcn_readfirstlane(tid >> 6);
    const int G = gridDim.x, bx = blockIdx.x;
    int vcu = (G % 8 == 0) ? (bx % 8) * (G / 8) + bx / 8 : bx;
    int gw = vcu * NWAVES + wave; const int NGW = G * NWAVES; int cid = bx;
    float* const out = args.out;
    volatile LAS unsigned* MISC = (volatile LAS unsigned*)(lds + 131072 + 320);
    if (tid < 32) MISC[tid] = 0u;
    __syncthreads();
    XcdBarrier bar = xcd_barrier_post((unsigned*)(args.ws + WS_CTL), MISC + 8);
    if (args.ws == nullptr) grid.sync();
#define GRID_BAR() xcd_barrier(bar)

#if (PH_MASK >> 0) & 1
    REP_LOOP(0) {
    PHASE_WS;
    {
        const float* cndp = AIN(1);
        LAS float* SC = (LAS float*)(lds + 73728);
        for (int idx = tid; idx < 8 * D; idx += NWAVES * 64) { const int b = idx >> 10, k = idx & 1023; const float cv = cndp[idx]; SC[k * 8 + b] = cv * sigm_f(cv); }
        __syncthreads();
        LAS float* scr = (LAS float*)(lds + wave * 8704);
        constexpr int I_2048 = (D / 64) * (2048 / 32), I_1024 = (D / 64) * (1024 / 32);
        constexpr int NT_ITEMS = 3 * I_2048 + 3 * I_1024, NITEMS = NT_ITEMS + 2048;
        for (int it = gw; it < NITEMS; it += NGW) {
            int r = it;
            if (r < NT_ITEMS) {
                if (r < I_2048) { p0_transpose_item(AIN(5), 2048, D, 2048, W_IN_A, scr, r, lane); continue; } r -= I_2048;
                if (r < I_2048) { p0_transpose_item(AIN(20), 2064, D, 2048, W_KV, scr, r, lane); continue; } r -= I_2048;
                if (r < I_2048) { p0_transpose_item(AIN(26), 2048, D, 2048, W_IN_B, scr, r, lane); continue; } r -= I_2048;
                if (r < I_1024) { p0_transpose_item(AIN(14), 1024, D, 1024, W_GLU, scr, r, lane); continue; } r -= I_1024;
                if (r < I_1024) { p0_transpose_item(AIN(16), 1024, D, 1024, W_OUT_A, scr, r, lane); continue; } r -= I_1024;
                p0_transpose_item(AIN(28), 1024, D, 1024, W_OUT_B, scr, r, lane); continue;
            }
            r -= NT_ITEMS;
            const int col = (r >> 4) * 64 + lane, ks = r & 15;
            const float* W; int ldw, cc;
            if (col < 3072) { W = AIN(3); ldw = 3072; cc = col; } else if (col < 5120) { W = AIN(18); ldw = 2048; cc = col - 3072; } else { W = AIN(24); ldw = 3072; cc = col - 5120; }
            float acc8[8] = {0.f, 0.f, 0.f, 0.f, 0.f, 0.f, 0.f, 0.f};
            const float* wp = W + (size_t)(ks * 64) * ldw + cc;
#pragma unroll 16
            for (int k = 0; k < 64; ++k) { const float w = wp[(size_t)k * ldw];
                const f32x4 s0 = *(const LAS f32x4*)(SC + (ks * 64 + k) * 8), s1 = *(const LAS f32x4*)(SC + (ks * 64 + k) * 8 + 4);
                acc8[0] += s0.x * w; acc8[1] += s0.y * w; acc8[2] += s0.z * w; acc8[3] += s0.w * w; acc8[4] += s1.x * w; acc8[5] += s1.y * w; acc8[6] += s1.z * w; acc8[7] += s1.w * w; }
#pragma unroll
            for (int b = 0; b < 8; ++b) MODP[(size_t)(ks * 8 + b) * 8192 + col] = acc8[b];
        }
        const int gtid = vcu * (NWAVES * 64) + tid, NGT = G * NWAVES * 64;
        for (int idx = gtid; idx < 16 * D; idx += NGT) { const int jf = idx >> 10, k = idx & 1023; W_F[idx] = (bf16u)f2bf(AIN(20)[(size_t)k * 2064 + 2048 + jf]); }
        for (int it = gtid; it < NG * NST * 16; it += NGT) {
            const int idx = it >> 4, ch = it & 15, g = idx >> 6, p = idx & 63;
            const double dt = exp((double)AIN(6)[g]), ar = (double)AIN(7)[idx], ai = (double)AIN(8)[idx];
            const double mag = exp(ar * dt); double sn, cs; sincos_d(ai * dt, sn, cs);
            const double abr = mag * cs, abi = mag * sn, den = ar * ar + ai * ai, nr = abr - 1.0;
            const double cr = (nr * ar + abi * ai) / den, ci = (abi * ar - nr * ai) / den;
            if (ch == 0) { ABAR[idx] = make_float2((float)abr, (float)abi);
                double pr = abr, pi = abi;
#pragma unroll
                for (int q = 0; q < 8; ++q) { const double t = pr * pr - pi * pi; pi = 2.0 * pr * pi; pr = t; }
                AL[idx] = make_float2((float)pr, (float)pi); }
            { const double br = AIN(9)[(size_t)idx * 16 + ch], bi = AIN(10)[(size_t)idx * 16 + ch]; const double bbr = cr * br - ci * bi, bbi = cr * bi + ci * br;
              const int c0 = (p >> 5) * 2, l = (ch >> 3) * 32 + (p & 31), jj = ch & 7;
              BFRAG[((size_t)(g * 4 + c0) * 64 + l) * 8 + jj] = (bf16u)f2bf((float)bbr); BFRAG[((size_t)(g * 4 + c0 + 1) * 64 + l) * 8 + jj] = (bf16u)f2bf((float)bbi); }
            { const float cre = AIN(11)[(size_t)(g * 16 + ch) * 64 + p], cim = AIN(12)[(size_t)(g * 16 + ch) * 64 + p];
#pragma unroll
              for (int ri = 0; ri < 2; ++ri) { const int kap = 2 * p + ri, ks2 = kap >> 5, l = ((kap & 31) >> 3) * 16 + ch, jj = kap & 7;
                  CFRAG[((size_t)(g * 4 + ks2) * 64 + l) * 8 + jj] = (bf16u)f2bf(ri == 0 ? cre : -cim); } }
        }
    }
#endif
    GRID_BAR();
    }
    {
        if (tid == 0) { unsigned ok = (G % 8 == 0) ? 1u : 0u;
            for (unsigned jx = 0; jx < 16; ++jx) { const unsigned c = xb_ld(&bar.bar[XB_XCNT(jx)]); ok &= (jx < 8 ? (c == (unsigned)(G / 8)) : (c == 0u)) ? 1u : 0u; }
            MISC[11] = ok; }
        __syncthreads();
        const int okm = __builtin_amdgcn_readfirstlane((int)MISC[11]), xrank = __builtin_amdgcn_readfirstlane((int)MISC[10]), xcc = (int)bar.x;
        if (okm) { cid = xrank * 8 + xcc; vcu = xcc * (G / 8) + xrank; gw = vcu * NWAVES + wave; }
    }

#if (PH_MASK >> 1) & 1
    REP_LOOP(1) {
    PHASE_WS;
    {
        if (tid < 64) { const int idx = vcu * 64 + tid; if (idx < 2 * 8 * D) { const int which = idx >> 13, b = (idx >> 10) & 7, n = idx & 1023;
                const int col = which == 0 ? 2048 + n : 5120 + 2048 + n; float s = which == 0 ? AIN(4)[2048 + n] : AIN(25)[2048 + n];
#pragma unroll
                for (int ks = 0; ks < 16; ++ks) s += MODP[(size_t)(ks * 8 + b) * 8192 + col];
                GATE[idx] = s; } }
        LAS float* GS = (LAS float*)lds; LAS float* SH = GS + D;
        for (int v = vcu; v < M / 64; v += G) {
            __syncthreads();
            mod_vectors(MODP, AIN(4), AIN(2), v >> 5, 0, GS, SH, tid);
            __syncthreads();
            norm_rows<1>(AIN(0), v, wave, lane, GS, SH, R2, GS, SH, R2);
        }
    }
#endif
    GRID_BAR();
    }

#if (PH_MASK >> 2) & 1
    REP_LOOP(2) {
    PHASE_WS;
    { pg8::Gemm g{R2, W_IN_A, M, 2048, D}; pg8::StaticOrder S; S.init(M, 2048, G, cid); pg8::EpiStore Ep{UZ, 2048};
      pg8::gemm_phase<pg8::EpiStore, pg8::StaticOrder, true, true>(lds, g, S, Ep); }
#endif
    GRID_BAR();
    }

#if (PH_MASK >> 3) & 1
    REP_LOOP(3) {
    PHASE_WS;
    for (int blk = vcu; blk < 256; blk += G) {
        __syncthreads();
        s5_scan<0>(lds, UZ, R2, ABAR, AL, BFRAG, CFRAG, AIN(13), blk, wave, lane);
        __syncthreads();
        s5_scan<1>(lds, UZ, R2, ABAR, AL, BFRAG, CFRAG, AIN(13), blk, wave, lane);
    }
#endif
    GRID_BAR();
    }

#if (PH_MASK >> 4) & 1
    REP_LOOP(4) {
    PHASE_WS;
    { pg8::Gemm g{R2, W_GLU, M, 1024, D}; pg8::StaticOrder S; S.init(M, 1024, G, cid); pg8::EpiGlu Ep{R2, UZ + 1024, AIN(15), R3};
      pg8::gemm_phase<pg8::EpiGlu, pg8::StaticOrder, true, true>(lds, g, S, Ep); }
#endif
    GRID_BAR();
    }

#if (PH_MASK >> 5) & 1
    REP_LOOP(5) {
    PHASE_WS;
    { pg8::Gemm g{R3, W_OUT_A, M, 1024, D}; pg8::StaticOrder S; S.init(M, 1024, G, cid); pg8::EpiRes Ep{AIN(0), GATE, out};
      pg8::gemm_phase<pg8::EpiRes, pg8::StaticOrder, true, true>(lds, g, S, Ep); }
#endif
    GRID_BAR();
    }

#if (PH_MASK >> 6) & 1
    REP_LOOP(6) {
    PHASE_WS;
    {
        LAS float* GS0 = (LAS float*)lds; LAS float* SH0 = GS0 + D; LAS float* GS1 = SH0 + D; LAS float* SH1 = GS1 + D;
        for (int v = vcu; v < M / 64; v += G) {
            __syncthreads();
            mod_vectors(MODP, AIN(19), AIN(17), v >> 5, 3072, GS0, SH0, tid);
            mod_vectors(MODP, AIN(25), AIN(23), v >> 5, 5120, GS1, SH1, tid);
            __syncthreads();
            norm_rows<2>(out, v, wave, lane, GS0, SH0, R2, GS1, SH1, R3);
        }
    }
#endif
    GRID_BAR();
    }

#if (PH_MASK >> 7) & 1
    REP_LOOP(7) {
    PHASE_WS;
    {
        for (int t = gw; t < M / 16; t += NGW) {
            f32x4 acc = {0.f, 0.f, 0.f, 0.f};
            const bf16u* ap = R2 + (size_t)(16 * t + (lane & 15)) * D + 8 * (lane >> 4); const bf16u* bp = W_F + (size_t)(lane & 15) * D + 8 * (lane >> 4);
#pragma unroll 8
            for (int ks = 0; ks < 32; ++ks) acc = __builtin_amdgcn_mfma_f32_16x16x32_bf16(*(const bf16x8*)(ap + ks * 32), *(const bf16x8*)(bp + ks * 32), acc, 0, 0, 0);
            const float fb = AIN(21)[lane & 15];
#pragma unroll
            for (int r = 0; r < 4; ++r) { const float xl = acc[r] + fb; const float ls = fminf(xl, 0.f) - log1pf(__expf(-fabsf(xl)));
                LF[(size_t)(16 * t + 4 * (lane >> 4) + r) * NH + (lane & 15)] = ls; }
        }
        { pg8::Gemm g{R2, W_KV, M, 2048, D}; pg8::StaticOrder S; S.init(M, 2048, G, cid); pg8::EpiHeadNorm<false> Ep{KB, VB, AIN(22), 1.0f};
          pg8::gemm_phase<pg8::EpiHeadNorm<false>, pg8::StaticOrder, true, true>(lds, g, S, Ep); }
        { pg8::Gemm g{R3, W_IN_B, M, 2048, D}; pg8::StaticOrder S; S.init(M, 2048, G, cid); pg8::EpiHeadNorm<true> Ep{QO, SZ, AIN(27), C2};
          pg8::gemm_phase<pg8::EpiHeadNorm<true>, pg8::StaticOrder, true, true>(lds, g, S, Ep); }
    }
#endif
    GRID_BAR();
    }

#if (PH_MASK >> 8) & 1
    { PHASE_WS; const attn_body::AttnTensors AT{(const attn_body::bf16*)QO, (const attn_body::bf16*)KB, (const attn_body::bf16*)VB, (attn_body::bf16*)QO, (const attn_body::bf16*)SZ, LF};
      attn_body::attn_phase<8>((char*)lds_raw, AT, vcu, G); }
#endif
    GRID_BAR();

#if (PH_MASK >> 9) & 1
    { PHASE_WS; pg8::Gemm g{QO, W_OUT_B, M, 1024, D}; pg8::StaticOrder S; S.init(M, 1024, G, cid); pg8::EpiRes Ep{out, GATE + 8 * D, out};
      pg8::gemm_phase<pg8::EpiRes, pg8::StaticOrder, true, true>(lds, g, S, Ep); }
#endif
}

extern "C" void kernel_launch(void* const* d_in, const int* in_sizes, int n_in, void* d_out, int out_size, void* d_ws, size_t ws_size, hipStream_t stream) {
    static int grid = 0;
    if (grid == 0) {
        if (n_in != 29 || out_size != M * D || ws_size < WS_END) { fprintf(stderr, "kernel_launch: unexpected problem (n_in %d out %d ws %zu)\n", n_in, out_size, ws_size); grid = -1; return; }
        int dev = 0, cus = 0, per_cu = 0;
        (void)hipGetDevice(&dev); (void)hipDeviceGetAttribute(&cus, hipDeviceAttributeMultiprocessorCount, dev);
        if (hipFuncSetAttribute((const void*)fwd_mega, hipFuncAttributeMaxDynamicSharedMemorySize, LDS_BYTES) != hipSuccess) { fprintf(stderr, "kernel_launch: hipFuncSetAttribute failed\n"); grid = -1; return; }
        if (hipOccupancyMaxActiveBlocksPerMultiprocessor(&per_cu, (const void*)fwd_mega, NWAVES * 64, LDS_BYTES) != hipSuccess || per_cu < 1) { fprintf(stderr, "kernel_launch: occupancy query says %d\n", per_cu); per_cu = 1; }
        (void)hipGetLastError();
        grid = cus > 0 ? cus : 256;
    }
    if (grid < 0) return;
    if (hipMemsetAsync((char*)d_ws + WS_CTL, 0, CTL_ZERO_BYTES, stream) != hipSuccess) { fprintf(stderr, "kernel_launch: memset failed\n"); return; }
    Args a{};
    for (int i = 0; i < 29; ++i) a.in[i] = (const float*)d_in[i];
    a.out = (float*)d_out; a.ws = (unsigned char*)d_ws;
    void* kargs[] = {&a};
    const hipError_t e = hipLaunchCooperativeKernel((const void*)fwd_mega, dim3(grid), dim3(NWAVES * 64), kargs, LDS_BYTES, stream);
    if (e != hipSuccess) fprintf(stderr, "cooperative launch failed: %s (grid %d)\n", hipGetErrorString(e), grid);
}
```

```cpp
#include <hip/hip_runtime.h>
#include <hip/hip_cooperative_groups.h>
#include <cstdio>
#include <cstdint>
namespace cg = cooperative_groups;
namespace pg8 {
#define PG8_LAS __attribute__((address_space(3)))
typedef unsigned short bf16_t;
typedef short bf16x8 __attribute__((ext_vector_type(8)));
typedef float f32x4 __attribute__((ext_vector_type(4)));
typedef unsigned u32x4 __attribute__((ext_vector_type(4)));
constexpr int BM = 256, BK = 64, HALF = 128, HTB = HALF * BK * 2  , STAGE_BYTES = 8 * HTB, NXCD = 8, WGM = 8;

__host__ __device__ __forceinline__ int lds_byte(int r, int c) { const int st = (r >> 4) * 2 + (c >> 5), rr = r & 15, cc = c & 31, ob = rr * 64 + cc * 2; return st * 1024 + (ob ^ (((ob >> 9) & 1) << 5)); }
__host__ __device__ __forceinline__ void stage_rc(int b, int& R, int& C) { const int st = b / 1024, sb = b % 1024, swz = sb ^ (((sb >> 9) & 1) << 5); R = (st >> 1) * 16 + swz / 64; C = (st & 1) * 32 + (swz % 64) / 2; }
__host__ __device__ __forceinline__ int perm32(int rho) { const int n = rho >> 4, i = rho & 15; return 8 * (i >> 2) + 4 * n + (i & 3); }

struct Unit { int pm, pn; };
struct Gemm { const bf16_t* A; const bf16_t* Bt; int M, N, K; };

struct StaticOrder {
    int nM, nN, nwg, G, c;
    __host__ __device__ void init(int M, int N, int G_, int c_) { nM = M / BM; nN = N / BM; nwg = nM * nN; G = G_; c = c_; }
    __host__ __device__ bool next(int i, Unit& u) const {
        const long L = (long)i * G + c; if (L >= nwg) return false;
        int wgid = (int)L; { const int q = nwg / NXCD, r = nwg % NXCD, xcd = wgid % NXCD, off = wgid / NXCD; wgid = (xcd < r ? xcd * (q + 1) : r * (q + 1) + (xcd - r) * q) + off; }
        const int nig = WGM * nN, gid = wgid / nig, fm = gid * WGM, gsz = (nM - fm) < WGM ? (nM - fm) : WGM;
        u.pm = fm + ((wgid % nig) % gsz); u.pn = (wgid % nig) / gsz; return true;
    }
    __device__ __forceinline__ void a_ready(const Unit&) const {}
    __device__ __forceinline__ void done(const Unit&) const {}
};

__device__ __forceinline__ unsigned cvt_pk_bf16(float lo, float hi) { unsigned r; asm volatile("v_cvt_pk_bf16_f32 %0, %1, %2" : "=v"(r) : "v"(lo), "v"(hi)); return r; }
typedef float f32x2 __attribute__((ext_vector_type(2)));
typedef unsigned u32x4e __attribute__((ext_vector_type(4)));
__device__ __forceinline__ float bf_lo(unsigned u) { return __uint_as_float(u << 16); }
__device__ __forceinline__ float bf_hi(unsigned u) { return __uint_as_float(u & 0xffff0000u); }
__device__ __forceinline__ float sigm(float x) { return __builtin_amdgcn_rcpf(1.0f + __builtin_amdgcn_exp2f(-1.4426950408889634f * x)); }
__device__ __forceinline__ u32x4e pack8(const f32x4& a, const f32x4& b) { u32x4e w; w.x = cvt_pk_bf16(a[0], a[1]); w.y = cvt_pk_bf16(a[2], a[3]); w.z = cvt_pk_bf16(b[0], b[1]); w.w = cvt_pk_bf16(b[2], b[3]); return w; }

struct EpiStore {
    static constexpr bool PERM = true, AFTER_DRAIN = false;
    bf16_t* O; int ldc;
    __device__ __forceinline__ void operator()(const f32x4 (&acc)[2][2][4][2], const Unit& u, int wr, int wc, int fr, int fq) const {
        const int row0 = u.pm * BM + wr * 64 + fr, colb = u.pn * BM + wc * 64 + 8 * fq;
#pragma unroll
        for (int ai = 0; ai < 2; ++ai)
#pragma unroll
            for (int m = 0; m < 4; ++m) { bf16_t* rowp = O + (size_t)(row0 + ai * HALF + m * 16) * ldc + colb;
#pragma unroll
                for (int bj = 0; bj < 2; ++bj) *(u32x4e*)(rowp + bj * 32) = pack8(acc[ai][bj][m][0], acc[ai][bj][m][1]); }
    }
};
struct EpiGlu {
    static constexpr bool PERM = true, AFTER_DRAIN = false;
    const bf16_t* Y1; const bf16_t* Z; const float* bias; bf16_t* O;
    __device__ __forceinline__ void operator()(const f32x4 (&acc)[2][2][4][2], const Unit& u, int wr, int wc, int fr, int fq) const {
        constexpr int PD = 6;
        const int row0 = u.pm * BM + wr * 64 + fr, colb = u.pn * BM + wc * 64 + 8 * fq;
        f32x4 bv[2][2];
#pragma unroll
        for (int bj = 0; bj < 2; ++bj)
#pragma unroll
            for (int n = 0; n < 2; ++n) bv[bj][n] = *(const f32x4*)(bias + colb + bj * 32 + 4 * n);
        u32x4e yb[PD], zb[PD];
#define EG_ROW(it) ((size_t)(row0 + ((it) >> 3) * HALF + (((it) >> 1) & 3) * 16))
#define EG_COL(it) (colb + ((it) & 1) * 32)
#pragma unroll
        for (int it = 0; it < PD; ++it) { yb[it] = *(const u32x4e*)(Y1 + EG_ROW(it) * 1024 + EG_COL(it)); zb[it] = *(const u32x4e*)(Z + EG_ROW(it) * 2048 + EG_COL(it)); }
#pragma unroll
        for (int it = 0; it < 16; ++it) { const int ai = it >> 3, m = (it >> 1) & 3, bj = it & 1;
            const u32x4e yv = yb[it % PD], zv = zb[it % PD];
            if (it + PD < 16) { yb[it % PD] = *(const u32x4e*)(Y1 + EG_ROW(it + PD) * 1024 + EG_COL(it + PD)); zb[it % PD] = *(const u32x4e*)(Z + EG_ROW(it + PD) * 2048 + EG_COL(it + PD)); }
            asm volatile("" ::: "memory");
            f32x4 o0, o1;
#pragma unroll
            for (int k = 0; k < 2; ++k) { const float g0 = acc[ai][bj][m][0][2 * k] + bv[bj][0][2 * k], g1 = acc[ai][bj][m][0][2 * k + 1] + bv[bj][0][2 * k + 1];
                const float z0 = bf_lo(zv[k]), z1 = bf_hi(zv[k]);
                o0[2 * k] = bf_lo(yv[k]) * sigm(g0) * z0 * sigm(z0); o0[2 * k + 1] = bf_hi(yv[k]) * sigm(g1) * z1 * sigm(z1); }
#pragma unroll
            for (int k = 0; k < 2; ++k) { const float g0 = acc[ai][bj][m][1][2 * k] + bv[bj][1][2 * k], g1 = acc[ai][bj][m][1][2 * k + 1] + bv[bj][1][2 * k + 1];
                const float z0 = bf_lo(zv[2 + k]), z1 = bf_hi(zv[2 + k]);
                o1[2 * k] = bf_lo(yv[2 + k]) * sigm(g0) * z0 * sigm(z0); o1[2 * k + 1] = bf_hi(yv[2 + k]) * sigm(g1) * z1 * sigm(z1); }
            *(u32x4e*)(O + EG_ROW(it) * 1024 + EG_COL(it)) = pack8(o0, o1);
            asm volatile("" ::: "memory"); }
    }
};
struct EpiRes {
    static constexpr bool PERM = true, AFTER_DRAIN = false;
    const float* X; const float* gate; float* OUT;
    __device__ __forceinline__ void operator()(const f32x4 (&acc)[2][2][4][2], const Unit& u, int wr, int wc, int fr, int fq) const {
        constexpr int PD = 6;
        const int row0 = u.pm * BM + wr * 64 + fr, colb = u.pn * BM + wc * 64 + 8 * fq;
        const float* gp = gate + (size_t)(u.pm >> 3) * 1024 + colb;
        f32x4 gv[2][2];
#pragma unroll
        for (int bj = 0; bj < 2; ++bj)
#pragma unroll
            for (int n = 0; n < 2; ++n) gv[bj][n] = *(const f32x4*)(gp + bj * 32 + 4 * n);
        f32x4 xb[PD][2];
#pragma unroll
        for (int it = 0; it < PD; ++it) { const float* p = X + EG_ROW(it) * 1024 + EG_COL(it); xb[it][0] = *(const f32x4*)p; xb[it][1] = *(const f32x4*)(p + 4); }
#pragma unroll
        for (int it = 0; it < 16; ++it) { const int ai = it >> 3, m = (it >> 1) & 3, bj = it & 1;
            const f32x4 x0 = xb[it % PD][0], x1 = xb[it % PD][1];
            if (it + PD < 16) { const float* p = X + EG_ROW(it + PD) * 1024 + EG_COL(it + PD); xb[it % PD][0] = *(const f32x4*)p; xb[it % PD][1] = *(const f32x4*)(p + 4); }
            asm volatile("" ::: "memory");
            float* q = OUT + EG_ROW(it) * 1024 + EG_COL(it);
            *(f32x4*)q = x0 + gv[bj][0] * acc[ai][bj][m][0]; *(f32x4*)(q + 4) = x1 + gv[bj][1] * acc[ai][bj][m][1];
            asm volatile("" ::: "memory"); }
#undef EG_ROW
#undef EG_COL
    }
};
template <bool SILU> struct EpiHeadNorm {
    static constexpr bool PERM = true, AFTER_DRAIN = false;
    bf16_t* O0; bf16_t* O1; const float* g; float scale;
    __device__ __forceinline__ void operator()(const f32x4 (&acc)[2][2][4][2], const Unit& u, int wr, int wc, int fr, int fq) const {
        const int row0 = u.pm * BM + wr * 64 + fr;
        if (u.pn < 4) {
            const int colb = u.pn * BM + wc * 64 + 8 * fq;
            f32x4 gv[2][2];
#pragma unroll
            for (int bj = 0; bj < 2; ++bj)
#pragma unroll
                for (int n = 0; n < 2; ++n) gv[bj][n] = *(const f32x4*)(g + bj * 32 + 8 * fq + 4 * n) * scale;
#pragma unroll
            for (int ai = 0; ai < 2; ++ai)
#pragma unroll
                for (int m = 0; m < 4; ++m) { float s = 0.f;
#pragma unroll
                    for (int bj = 0; bj < 2; ++bj)
#pragma unroll
                        for (int n = 0; n < 2; ++n) { const f32x4 x = acc[ai][bj][m][n]; s += (x[0] * x[0] + x[1] * x[1]) + (x[2] * x[2] + x[3] * x[3]); }
                    s += __shfl_xor(s, 16); s += __shfl_xor(s, 32);
                    const float r = 1.0f / sqrtf(s * (1.0f / 64.0f) + 1e-6f);
                    bf16_t* rowp = O0 + (size_t)(row0 + ai * HALF + m * 16) * 1024 + colb;
#pragma unroll
                    for (int bj = 0; bj < 2; ++bj) *(u32x4e*)(rowp + bj * 32) = pack8(acc[ai][bj][m][0] * r * gv[bj][0], acc[ai][bj][m][1] * r * gv[bj][1]); }
        } else {
            const int colb = (u.pn - 4) * BM + wc * 64 + 8 * fq;
#pragma unroll
            for (int ai = 0; ai < 2; ++ai)
#pragma unroll
                for (int m = 0; m < 4; ++m) { bf16_t* rowp = O1 + (size_t)(row0 + ai * HALF + m * 16) * 1024 + colb;
#pragma unroll
                    for (int bj = 0; bj < 2; ++bj) { f32x4 a = acc[ai][bj][m][0], b = acc[ai][bj][m][1];
                        if (SILU) {
#pragma unroll
                            for (int k = 0; k < 4; ++k) { a[k] = a[k] * sigm(a[k]); b[k] = b[k] * sigm(b[k]); } }
                        *(u32x4e*)(rowp + bj * 32) = pack8(a, b); } }
        }
    }
};
template <class Epi, class Sched, bool ALIGN_EPI = false, bool SP2 = false>
__device__ __forceinline__ void gemm_phase(PG8_LAS unsigned char* lds, const Gemm g, const Sched& S, const Epi& E) {
    int tid_ = threadIdx.x; asm volatile("" : "+v"(tid_));
    const int tid = tid_, wid = __builtin_amdgcn_readfirstlane(tid >> 6), lane = tid & 63, wr = wid >> 2, wc = wid & 3, fr = lane & 15, fq = lane >> 4;
    const int K = g.K, nt = K / BK;
    unsigned voffA[2], voffB[2];
#pragma unroll
    for (int i = 0; i < 2; ++i) { int R, C; stage_rc(tid * 16 + i * 8192, R, C); const int Rb = Epi::PERM ? ((R & ~31) + perm32(R & 31)) : R;
        voffA[i] = (unsigned)(R * K + C) * 2u; voffB[i] = (unsigned)(Rb * K + C) * 2u; }
    const size_t kstep = (size_t)(BK * 2);
    const size_t hstep = (size_t)HALF * K * 2;
    const size_t tstep = 2 * hstep;
    const unsigned ldsw = (unsigned)wid * 1024u;
    const int aoff = lds_byte(wr * 64 + fr, fq * 8), boff = lds_byte(wc * 32 + fr, fq * 8);
#define PG8_SA(b, h) (((b) * 2 + (h)) * HTB)
#define PG8_SB(b, h) ((4 + (b) * 2 + (h)) * HTB)
#define PG8_STAGE(bufoff, gbase, voff) do { _Pragma("unroll") for (int _i = 0; _i < 2; ++_i) \
        __builtin_amdgcn_global_load_lds((const unsigned*)((const char*)(gbase) + (voff)[_i]), (PG8_LAS unsigned*)(lds + (bufoff) + ldsw + _i * 8192), 16, 0, 0); } while (0)
#define PG8_LDA(dst, b, h) do { _Pragma("unroll") for (int m = 0; m < 4; ++m) _Pragma("unroll") for (int k = 0; k < 2; ++k) dst[m][k] = *(const PG8_LAS bf16x8*)(lds + PG8_SA(b, h) + aoff + m * 2048 + k * 1024); } while (0)
#define PG8_LDB(dst, b, h) do { _Pragma("unroll") for (int n = 0; n < 2; ++n) _Pragma("unroll") for (int k = 0; k < 2; ++k) dst[n][k] = *(const PG8_LAS bf16x8*)(lds + PG8_SB(b, h) + boff + n * 2048 + k * 1024); } while (0)
#define PG8_MMA(ai, bj, At, Bt) do { __builtin_amdgcn_s_setprio(1); _Pragma("unroll") for (int m = 0; m < 4; ++m) _Pragma("unroll") for (int n = 0; n < 2; ++n) _Pragma("unroll") for (int k = 0; k < 2; ++k) \
        acc[ai][bj][m][n] = __builtin_amdgcn_mfma_f32_16x16x32_bf16(Bt[n][k], At[m][k], acc[ai][bj][m][n], 0, 0, 0); __builtin_amdgcn_s_setprio(0); } while (0)
#define PG8_WAIT_V(n) asm volatile("s_waitcnt vmcnt(" #n ")" ::: "memory")
#define PG8_WAIT_L(n) asm volatile("s_waitcnt lgkmcnt(" #n ")" ::: "memory")
#define PG8_BAR __builtin_amdgcn_s_barrier()
#define PG8_SCHED __builtin_amdgcn_sched_barrier(0)
    Unit cur, nxt; int ui = 0;
    if (!S.next(0, cur)) return;
    f32x4 acc[2][2][4][2];
#pragma unroll
    for (int a = 0; a < 2; ++a)
#pragma unroll
        for (int b = 0; b < 2; ++b)
#pragma unroll
            for (int m = 0; m < 4; ++m)
#pragma unroll
                for (int n = 0; n < 2; ++n) acc[a][b][m][n] = (f32x4){0.f, 0.f, 0.f, 0.f};
    bf16x8 At[4][2], B0[2][2], B1[2][2];
    const char* cA = (const char*)g.A + (size_t)cur.pm * tstep; const char* cB = (const char*)g.Bt + (size_t)cur.pn * tstep;
    S.a_ready(cur);
    if constexpr (SP2) {
        PG8_STAGE(PG8_SB(0, 0), cB, voffB); PG8_STAGE(PG8_SB(0, 1), cB + hstep, voffB); PG8_STAGE(PG8_SA(0, 0), cA, voffA); PG8_STAGE(PG8_SA(0, 1), cA + hstep, voffA);
        if (wr == 1) PG8_BAR;
        PG8_WAIT_V(2); PG8_BAR;
        PG8_STAGE(PG8_SB(1, 0), cB + kstep, voffB); PG8_STAGE(PG8_SA(1, 0), cA + kstep, voffA); PG8_STAGE(PG8_SB(1, 1), cB + hstep + kstep, voffB);
        PG8_WAIT_V(6); PG8_BAR;
    } else {
        PG8_STAGE(PG8_SB(0, 0), cB, voffB); PG8_STAGE(PG8_SA(0, 0), cA, voffA); PG8_STAGE(PG8_SB(0, 1), cB + hstep, voffB); PG8_STAGE(PG8_SA(0, 1), cA + hstep, voffA);
        if (wr == 1) PG8_BAR;
        PG8_WAIT_V(4); PG8_BAR;
        PG8_STAGE(PG8_SB(1, 0), cB + kstep, voffB); PG8_STAGE(PG8_SA(1, 0), cA + kstep, voffA); PG8_STAGE(PG8_SB(1, 1), cB + hstep + kstep, voffB);
        PG8_WAIT_V(6); PG8_BAR;
    }
    for (;;) {
        const bool has_next = S.next(ui + 1, nxt);
        const char* nA = has_next ? (const char*)g.A + (size_t)nxt.pm * tstep : cA; const char* nB = has_next ? (const char*)g.Bt + (size_t)nxt.pn * tstep : cB;
        for (int t = 0; t < nt; t += 2) {
            const bool last = (t == nt - 2);
            const char* a1 = cA + (size_t)(t + 1) * kstep;
            const char* a2 = last ? nA : cA + (size_t)(t + 2) * kstep; const char* b2 = last ? nB : cB + (size_t)(t + 2) * kstep;
            const char* a3 = a2 + kstep; const char* b3 = b2 + kstep;
            if (last && has_next) S.a_ready(nxt);
            if constexpr (SP2) {
            PG8_LDB(B0, 0, 0); PG8_LDB(B1, 0, 1); PG8_SCHED; PG8_LDA(At, 0, 0); PG8_STAGE(PG8_SA(1, 1), a1 + hstep, voffA);
            PG8_WAIT_V(8); PG8_WAIT_L(0); PG8_BAR; PG8_MMA(0, 0, At, B0); PG8_MMA(0, 1, At, B1); PG8_BAR; PG8_SCHED;
            PG8_LDA(At, 0, 1); PG8_STAGE(PG8_SB(0, 0), b2, voffB); PG8_STAGE(PG8_SB(0, 1), b2 + hstep, voffB); PG8_STAGE(PG8_SA(0, 0), a2, voffA);
            PG8_WAIT_V(8); PG8_WAIT_L(0); PG8_BAR; PG8_MMA(1, 0, At, B0); PG8_MMA(1, 1, At, B1); PG8_BAR; PG8_SCHED;
            PG8_LDB(B0, 1, 0); PG8_LDB(B1, 1, 1); PG8_SCHED; PG8_LDA(At, 1, 0); PG8_STAGE(PG8_SA(0, 1), a2 + hstep, voffA);
            PG8_WAIT_V(8); PG8_WAIT_L(0); PG8_BAR; PG8_MMA(0, 0, At, B0); PG8_MMA(0, 1, At, B1); PG8_BAR; PG8_SCHED;
            PG8_LDA(At, 1, 1); PG8_STAGE(PG8_SB(1, 0), b3, voffB); PG8_STAGE(PG8_SB(1, 1), b3 + hstep, voffB); PG8_STAGE(PG8_SA(1, 0), a3, voffA);
            PG8_WAIT_V(8); PG8_WAIT_L(0); PG8_BAR; PG8_MMA(1, 0, At, B0); PG8_MMA(1, 1, At, B1); PG8_BAR; PG8_SCHED;
            } else {
            PG8_LDB(B0, 0, 0); PG8_SCHED; PG8_LDA(At, 0, 0); PG8_STAGE(PG8_SA(1, 1), a1 + hstep, voffA);
            PG8_WAIT_L(8); PG8_BAR; PG8_WAIT_L(0); PG8_MMA(0, 0, At, B0); PG8_BAR; PG8_SCHED;
            PG8_LDB(B1, 0, 1); PG8_STAGE(PG8_SB(0, 0), b2, voffB);
            PG8_BAR; PG8_WAIT_L(0); PG8_MMA(0, 1, At, B1); PG8_BAR;
            PG8_LDA(At, 0, 1); PG8_STAGE(PG8_SA(0, 0), a2, voffA);
            PG8_BAR; PG8_WAIT_L(0); PG8_MMA(1, 0, At, B0); PG8_BAR; PG8_SCHED;
            PG8_STAGE(PG8_SB(0, 1), b2 + hstep, voffB);
            PG8_WAIT_V(6); PG8_BAR; PG8_MMA(1, 1, At, B1); PG8_BAR;
            PG8_LDB(B0, 1, 0); PG8_SCHED; PG8_LDA(At, 1, 0); PG8_STAGE(PG8_SA(0, 1), a2 + hstep, voffA);
            PG8_WAIT_L(8); PG8_BAR; PG8_WAIT_L(0); PG8_MMA(0, 0, At, B0); PG8_BAR; PG8_SCHED;
            PG8_LDB(B1, 1, 1); PG8_STAGE(PG8_SB(1, 0), b3, voffB);
            PG8_BAR; PG8_WAIT_L(0); PG8_MMA(0, 1, At, B1); PG8_BAR;
            PG8_LDA(At, 1, 1); PG8_STAGE(PG8_SA(1, 0), a3, voffA);
            PG8_BAR; PG8_WAIT_L(0); PG8_MMA(1, 0, At, B0); PG8_BAR; PG8_SCHED;
            PG8_STAGE(PG8_SB(1, 1), b3 + hstep, voffB);
            PG8_WAIT_V(6); PG8_BAR; PG8_MMA(1, 1, At, B1); PG8_BAR;
            }
        }
        if constexpr (ALIGN_EPI) { if (wr == 0) PG8_BAR; }
        if constexpr (!Epi::AFTER_DRAIN) { E(acc, cur, wr, wc, fr, fq); S.done(cur); }
        if (!has_next) break;
#pragma unroll
        for (int a = 0; a < 2; ++a)
#pragma unroll
            for (int b = 0; b < 2; ++b)
#pragma unroll
                for (int m = 0; m < 4; ++m)
#pragma unroll
                    for (int n = 0; n < 2; ++n) acc[a][b][m][n] = (f32x4){0.f, 0.f, 0.f, 0.f};
        cur = nxt; cA = nA; cB = nB; ++ui;
        if constexpr (ALIGN_EPI) { if (wr == 1) PG8_BAR; }
    }
    PG8_WAIT_V(0);
    if constexpr (!ALIGN_EPI) { if (wr == 0) PG8_BAR; }
    PG8_BAR;
    if constexpr (Epi::AFTER_DRAIN) { E.fused(acc, cur, wr, wc, fr, fq, lds, wid, lane); S.done(cur); }
#undef PG8_SA
#undef PG8_SB
#undef PG8_STAGE
#undef PG8_LDA
#undef PG8_LDB
#undef PG8_MMA
#undef PG8_WAIT_V
#undef PG8_WAIT_L
#undef PG8_BAR
#undef PG8_SCHED
}
}
#include <hip/hip_bf16.h>
#include <cmath>
namespace attn_body {
using bf16=__hip_bfloat16;
using bf16x8=__attribute__((ext_vector_type(8)))short;
using s16x4=__attribute__((ext_vector_type(4)))short;
using f32x16=__attribute__((ext_vector_type(16)))float;
using u32x4=__attribute__((ext_vector_type(4)))unsigned;
constexpr int BATCH=8,NHEAD=16,SEQ=2048,D=64,DM=NHEAD*D;
constexpr int NW=8,QBLK=32,QB=QBLK*NW,KVBLK=64,NQB=SEQ/QB;
constexpr int ATTN_PITCH=DM, ATTN_UNIT_ROWS=QB;
__device__ __forceinline__ int crow(int r,int hi){return (r&3)+8*(r>>2)+4*hi;}
#define SBAR() __builtin_amdgcn_sched_barrier(0)
__device__ __forceinline__ void cmask(f32x16&p0,f32x16&p1,int jb,int qrel,int hi){
  const float NEG=-INFINITY; int d=qrel-(64*jb+4*hi); asm volatile("":"+v"(d));
  #pragma unroll
  for(int r=0;r<16;++r){const int c=(r&3)+8*(r>>2); if(c>d)p0[r]=NEG; if(c+32>d)p1[r]=NEG;}
}

constexpr int NSLOT=3, SLOTB=8192;
constexpr int LDS_K=0, LDS_V=NSLOT*SLOTB, LDS_WS=2*NSLOT*SLOTB, LDS_OST=LDS_WS+NW*64*4, LDS_FS=LDS_OST+NW*4096, LDS_SCAN=LDS_FS+SEQ*4, LDS_BYTES=LDS_SCAN+256; typedef float f32x4v __attribute__((ext_vector_type(4)));
constexpr float C2=0.125f*1.4426950408889634f;
__device__ __forceinline__ void glds16(const void*gsrc,unsigned lds_dst){unsigned keep;
  asm volatile("s_mov_b32 %0, m0\n\ts_mov_b32 m0, %2\n\ts_nop 0\n\tglobal_load_lds_dwordx4 %1, off\n\ts_mov_b32 m0, %0":"=&s"(keep):"v"(gsrc),"s"(lds_dst):"memory");}
__device__ __forceinline__ float max3f(float a,float b,float c){float r;asm("v_max3_f32 %0, %1, %2, %3":"=v"(r):"v"(a),"v"(b),"v"(c));return r;}
__device__ __forceinline__ float max2f(float a,float b){float r;asm("v_max_f32_e32 %0, %1, %2":"=v"(r):"v"(a),"v"(b));return r;}
__device__ __forceinline__ float fadd_s(float a,float b){float r;asm("v_add_f32_e32 %0, %1, %2":"=v"(r):"v"(a),"v"(b));return r;}
__device__ __forceinline__ float fsub_s(float a,float b){float r;asm("v_sub_f32_e32 %0, %1, %2":"=v"(r):"v"(a),"v"(b));return r;}
typedef float f32x2_t __attribute__((ext_vector_type(2))); typedef __bf16 bf16x2_t __attribute__((ext_vector_type(2)));
__device__ __forceinline__ unsigned cvtpk_s(float lo,float hi){f32x2_t v={lo,hi};bf16x2_t b=__builtin_convertvector(v,bf16x2_t);return __builtin_bit_cast(unsigned,b);}
#define WAIT_BAR(N) asm volatile("s_waitcnt vmcnt(" #N ") lgkmcnt(0)\n\ts_barrier":::"memory")

__device__ __forceinline__ void qkt(f32x16&p0,f32x16&p1,const char*Kslot,const bf16x8*qr,int r32,int hi){
  const char*kb=Kslot+hi*1024+r32*16;
  #pragma unroll
  for(int d0=0;d0<4;++d0){
    const bf16x8 b0=*reinterpret_cast<const bf16x8*>(kb+d0*2048);
    const bf16x8 b1=*reinterpret_cast<const bf16x8*>(kb+d0*2048+512);
    p0=__builtin_amdgcn_mfma_f32_32x32x16_bf16(b0,qr[d0],p0,0,0,0);p1=__builtin_amdgcn_mfma_f32_32x32x16_bf16(b1,qr[d0],p1,0,0,0);}
}
typedef __attribute__((address_space(3))) const char* lds_cptr;
typedef short v4i16_t __attribute__((ext_vector_type(4)));
__device__ __forceinline__ void kload8(bf16x8*kf,lds_cptr kp){
  kf[0]=*(const __attribute__((address_space(3))) bf16x8*)(kp);      kf[1]=*(const __attribute__((address_space(3))) bf16x8*)(kp+512);
  kf[2]=*(const __attribute__((address_space(3))) bf16x8*)(kp+2048); kf[3]=*(const __attribute__((address_space(3))) bf16x8*)(kp+2560);
  kf[4]=*(const __attribute__((address_space(3))) bf16x8*)(kp+4096); kf[5]=*(const __attribute__((address_space(3))) bf16x8*)(kp+4608);
  kf[6]=*(const __attribute__((address_space(3))) bf16x8*)(kp+6144); kf[7]=*(const __attribute__((address_space(3))) bf16x8*)(kp+6656);
}
__device__ __forceinline__ void kload2(bf16x8*kf,lds_cptr kp,int j){ kf[2*j]=*(const __attribute__((address_space(3))) bf16x8*)(kp+j*2048); kf[2*j+1]=*(const __attribute__((address_space(3))) bf16x8*)(kp+j*2048+512); }
__device__ __forceinline__ s16x4 vtr(lds_cptr p){ return __builtin_bit_cast(s16x4,__builtin_amdgcn_ds_read_tr16_b64_v4i16((__attribute__((address_space(3))) v4i16_t*)p)); }
__device__ __forceinline__ float rowmax(const f32x16&p0,const f32x16&p1){
  float a=max3f(p0[0],p0[1],p1[0]),b=max3f(p0[2],p0[3],p1[1]);a=max3f(a,p1[2],p1[3]);
  #pragma unroll
  for(int r=4;r<16;r+=4){a=max3f(a,p0[r],p0[r+1]);b=max3f(b,p0[r+2],p0[r+3]);a=max3f(a,p1[r],p1[r+1]);b=max3f(b,p1[r+2],p1[r+3]);}
  const float m=max2f(a,b);
  auto rr=__builtin_amdgcn_permlane32_swap(__float_as_uint(m),__float_as_uint(m),false,false);
  return max2f(__uint_as_float(rr[0]),__uint_as_float(rr[1]));
}
__device__ __forceinline__ void pv(f32x16*o,int vb,bf16x8 pa0,bf16x8 pa1,bf16x8 pa2,bf16x8 pa3){
  #pragma unroll
  for(int d0=0;d0<2;++d0){s16x4 lo[4],hi[4];
    #pragma unroll
    for(int ks=0;ks<4;++ks){
      asm volatile("ds_read_b64_tr_b16 %0,%1 offset:%c2":"=&v"(lo[ks]):"v"(vb),"i"(d0*4096+ks*1024):"memory");
      asm volatile("ds_read_b64_tr_b16 %0,%1 offset:%c2":"=&v"(hi[ks]):"v"(vb),"i"(d0*4096+ks*1024+512):"memory");}
    asm volatile("s_waitcnt lgkmcnt(0)":::"memory");SBAR();
    #define PK(k) (bf16x8){lo[k][0],lo[k][1],lo[k][2],lo[k][3],hi[k][0],hi[k][1],hi[k][2],hi[k][3]}
    o[d0]=__builtin_amdgcn_mfma_f32_32x32x16_bf16(pa0,PK(0),o[d0],0,0,0);
    o[d0]=__builtin_amdgcn_mfma_f32_32x32x16_bf16(pa1,PK(1),o[d0],0,0,0);
    o[d0]=__builtin_amdgcn_mfma_f32_32x32x16_bf16(pa2,PK(2),o[d0],0,0,0);
    o[d0]=__builtin_amdgcn_mfma_f32_32x32x16_bf16(pa3,PK(3),o[d0],0,0,0);
    #undef PK
  }
}

#ifndef ATTN_STORE16
#define ATTN_STORE16(p,v) (*(u32x4*)(p)=(v))
#endif
template<int THRL> __device__ __forceinline__ void attn_unit(int b,int h,int qb,const bf16*Q,const bf16*__restrict__ K,const bf16*__restrict__ V,bf16*O,const bf16*__restrict__ SZ,char*shm){
  int tid_=threadIdx.x; asm volatile("":"+v"(tid_)); const int tid=tid_,lane=tid&63,r32=lane&31,hi=lane>>5; const int wid=__builtin_amdgcn_readfirstlane(tid>>6);
  const long rowbase=(long)b*SEQ; const int q0=qb*QB;
  const bf16*Qw=Q+(rowbase+q0+wid*QBLK)*DM+h*D;
  const bf16*Kh=K+rowbase*DM+h*D,*Vh=V+rowbase*DM+h*D;
  const unsigned lds0=(unsigned)(uintptr_t)shm;
  float*wsf=(float*)(shm+LDS_WS)+wid*64;
  const bf16*ksrc=Kh+(long)lane*DM+wid*8;
  const bf16*vsrc=Vh+(long)(16*(wid&3)+(lane>>2))*DM+(wid>>2)*32+(lane&3)*8;
  const unsigned kdst=lds0+LDS_K+wid*1024, vdst=lds0+LDS_V+wid*1024;
  #define DMA_K(t,slot) glds16(ksrc+(long)(t)*KVBLK*DM,(unsigned)__builtin_amdgcn_readfirstlane(kdst+(slot)))
  #define DMA_V(t,slot) glds16(vsrc+(long)(t)*KVBLK*DM,(unsigned)__builtin_amdgcn_readfirstlane(vdst+(slot)))
  const int vb0=(int)(lds0+LDS_V)+((lane>>4)&1)*32+(lane&3)*8+(4*hi+((lane&15)>>2))*64;
  const char*Kbase=shm+LDS_K; bf16x8 kf[8];
  const lds_cptr shm3=(lds_cptr)shm; const lds_cptr kp0=shm3+LDS_K+hi*1024+r32*16; const lds_cptr vp0=shm3+LDS_V+((lane>>4)&1)*32+(lane&3)*8+(4*hi+((lane&15)>>2))*64;
  const int NT=(q0+QB)/KVBLK;
  DMA_K(0,0);DMA_V(0,0);DMA_K(1,SLOTB);
  bf16x8 qr[4];
  #pragma unroll
  for(int d0=0;d0<4;++d0)qr[d0]=*reinterpret_cast<const bf16x8*>(&Qw[(long)r32*DM+d0*16+hi*8]);
  float l_reg=0.f;f32x16 o[2];o[0]=f32x16{};o[1]=f32x16{};
  const int qrel=wid*QBLK+r32;
  const __attribute__((address_space(3))) float* Fs3=(const __attribute__((address_space(3))) float*)((lds_cptr)shm+LDS_FS);
  float fqm=Fs3[q0+qrel];
  #define BIAS(C0,C1,t) do{ const __attribute__((address_space(3))) f32x4v* fk_=(const __attribute__((address_space(3))) f32x4v*)(Fs3+(t)*64+4*hi); \
    _Pragma("unroll") for(int i_=0;i_<4;++i_){ const f32x4v a_=fk_[2*i_], b_=fk_[2*i_+8]; \
      _Pragma("unroll") for(int k_=0;k_<4;++k_){ C0[4*i_+k_]=fqm-a_[k_]; C1[4*i_+k_]=fqm-b_[k_]; } } }while(0)
  #define CMASK(P0,P1,t) do{int jb_=(t)-(NT-4); if(jb_>=0)cmask(P0,P1,jb_,qrel,hi);}while(0)
  bool resc=false;
  #define START(P0,P1) do{ const float rm=rowmax(P0,P1); resc=false; \
    { const float dl=rm; fqm=fsub_s(fqm,dl); \
      _Pragma("unroll") for(int r=0;r<16;++r){P0[r]=fsub_s(P0[r],dl);P1[r]=fsub_s(P1[r],dl);} } \
    _Pragma("unroll") for(int r=0;r<16;++r)P0[r]=__builtin_amdgcn_exp2f(P0[r]); }while(0)
  #define RESC() do{ if(resc){ asm volatile("s_waitcnt lgkmcnt(0)":::"memory"); \
      _Pragma("unroll") for(int d_=0;d_<2;++d_) _Pragma("unroll") for(int r=0;r<16;++r)o[d_][r]*=wsf[crow(r,hi)]; } }while(0)
  f32x16 pA0,pA1,pB0,pB1;
  int sl_prev=0,sl_cur=0,sl_next=SLOTB;
  #define ROT() do{sl_prev=sl_cur;sl_cur=sl_next;sl_next=(sl_next==(NSLOT-1)*SLOTB)?0:sl_next+SLOTB;}while(0)
  DMA_K(2,2*SLOTB);
  WAIT_BAR(3);
  BIAS(pA0,pA1,0); qkt(pA0,pA1,Kbase,qr,r32,hi);asm volatile("s_nop 15\n\ts_nop 7":"+v"(pA0),"+v"(pA1));CMASK(pA0,pA1,0);
  START(pA0,pA1);
  _Pragma("unroll") for(int r=0;r<16;++r)pA1[r]=__builtin_amdgcn_exp2f(pA1[r]);
  WAIT_BAR(0);
  DMA_K(3,0);DMA_V(1,SLOTB);
  ROT();
  kload8(kf,kp0+sl_cur);
  WAIT_BAR(2);
  s16x4 vlo[8],vhi[8]; u32x4 pw0,pw1,pw2,pw3;
  #define PKW(P,B) cvtpk_s(P[B],P[B+1])
  #define PAF(k) __builtin_bit_cast(bf16x8,pw##k)
  #define VFR(i) (bf16x8){vlo[i][0],vlo[i][1],vlo[i][2],vlo[i][3],vhi[i][0],vhi[i][1],vhi[i][2],vhi[i][3]}
  #define PIN(x) asm volatile("":"+v"(x))
  #define MX3(a,b,c) __builtin_fmaxf(__builtin_fmaxf((a),(b)),(c))
  #define GAPA(MF,A0,A1,A2,A3,W0,W1,PW) do{ MF; sacc+=A0; sacc+=A1; sacc+=A2; sacc+=A3; PIN(sacc); W0; W1; PIN(PW); SBAR(); }while(0)
  #define EX(v) __builtin_amdgcn_exp2f(v)
  #define GAPB(MF,X,B) do{ MF; X[B]=EX(X[B]); X[B+1]=EX(X[B+1]); X[B+2]=EX(X[B+2]); X[B+3]=EX(X[B+3]); PIN(X); SBAR(); }while(0)
  #define VRD(i) do{ vlo[i]=vtr(vp_+(((i)>>2)*4096+((i)&3)*1024)); vhi[i]=vtr(vp_+(((i)>>2)*4096+((i)&3)*1024+512)); }while(0)
  #define KRD(G,j) do{ if(G){ kload2(kf,kp0+sl_next,j); SBAR(); } }while(0)
  #define STEP(C0,C1,P0,P1,t,GK,GV,GL) do{ SBAR(); BIAS(C0,C1,t); SBAR(); \
    const lds_cptr vp_=vp0+sl_prev; \
    VRD(0); SBAR(); float sacc=(P0[0]+P0[1]); \
    GAPA(C0=__builtin_amdgcn_mfma_f32_32x32x16_bf16(kf[0],qr[0],C0,0,0,0), P0[2],P0[3],P0[4],P0[5],     pw0[0]=PKW(P0,0), pw0[1]=PKW(P0,2), pw0); \
    VRD(4); SBAR(); GAPA(C1=__builtin_amdgcn_mfma_f32_32x32x16_bf16(kf[1],qr[0],C1,0,0,0), P0[6],P0[7],P0[8],P0[9],     pw0[2]=PKW(P0,4), pw0[3]=PKW(P0,6), pw0); \
    VRD(1); SBAR(); GAPA(C0=__builtin_amdgcn_mfma_f32_32x32x16_bf16(kf[2],qr[1],C0,0,0,0),   P0[10],P0[11],P0[12],P0[13], pw1[0]=PKW(P0,8), pw1[1]=PKW(P0,10), pw1); \
    VRD(5); SBAR(); GAPA(C1=__builtin_amdgcn_mfma_f32_32x32x16_bf16(kf[3],qr[1],C1,0,0,0),   P0[14],P0[15],P1[0],P1[1],   pw1[2]=PKW(P0,12),pw1[3]=PKW(P0,14), pw1); \
    VRD(2); SBAR(); GAPA(C0=__builtin_amdgcn_mfma_f32_32x32x16_bf16(kf[4],qr[2],C0,0,0,0),   P1[2],P1[3],P1[4],P1[5],     pw2[0]=PKW(P1,0), pw2[1]=PKW(P1,2), pw2); \
    VRD(6); SBAR(); GAPA(C1=__builtin_amdgcn_mfma_f32_32x32x16_bf16(kf[5],qr[2],C1,0,0,0),   P1[6],P1[7],P1[8],P1[9],     pw2[2]=PKW(P1,4), pw2[3]=PKW(P1,6), pw2); \
    VRD(3); SBAR(); GAPA(C0=__builtin_amdgcn_mfma_f32_32x32x16_bf16(kf[6],qr[3],C0,0,0,0),   P1[10],P1[11],P1[12],P1[13], pw3[0]=PKW(P1,8), pw3[1]=PKW(P1,10), pw3); \
    VRD(7); SBAR(); GAPA(C1=__builtin_amdgcn_mfma_f32_32x32x16_bf16(kf[7],qr[3],C1,0,0,0),   P1[14],P1[15],0.f,0.f,       pw3[2]=PKW(P1,12),pw3[3]=PKW(P1,14), pw3); \
    l_reg+=sacc; \
    if(GK){DMA_K((t)+3,sl_cur);} if(GV){DMA_V((t)+1,sl_next);} \
    CMASK(C0,C1,t); \
    { float a=MX3(C0[0],C0[1],C1[0]),b=MX3(C0[2],C0[3],C1[1]); a=MX3(a,C1[2],C1[3]); \
      _Pragma("unroll") for(int r=4;r<16;r+=4){a=MX3(a,C0[r],C0[r+1]);b=MX3(b,C0[r+2],C0[r+3]);a=MX3(a,C1[r],C1[r+1]);b=MX3(b,C1[r+2],C1[r+3]);} \
      float rm=__builtin_fmaxf(a,b); { auto rr=__builtin_amdgcn_permlane32_swap(__float_as_uint(rm),__float_as_uint(rm),false,false); rm=__builtin_fmaxf(__uint_as_float(rr[0]),__uint_as_float(rr[1])); } \
      resc=false; \
      if(__builtin_expect(__any(rm>(float)THRL),0)){ const float dl=__builtin_fmaxf(rm,0.f); fqm-=dl; \
        _Pragma("unroll") for(int r=0;r<16;++r){C0[r]-=dl;C1[r]-=dl;} \
        const float f=__builtin_amdgcn_exp2f(-dl); l_reg*=f; if(hi==0)wsf[r32]=f; resc=true; } } \
    SBAR(); \
    GAPB(o[0]=__builtin_amdgcn_mfma_f32_32x32x16_bf16(PAF(0),VFR(0),o[0],0,0,0), C0,0); \
    GAPB(o[1]=__builtin_amdgcn_mfma_f32_32x32x16_bf16(PAF(0),VFR(4),o[1],0,0,0), C0,4); \
    KRD(GL,0); GAPB(o[0]=__builtin_amdgcn_mfma_f32_32x32x16_bf16(PAF(1),VFR(1),o[0],0,0,0), C0,8); \
    KRD(GL,1); GAPB(o[1]=__builtin_amdgcn_mfma_f32_32x32x16_bf16(PAF(1),VFR(5),o[1],0,0,0), C0,12); \
    KRD(GL,2); GAPB(o[0]=__builtin_amdgcn_mfma_f32_32x32x16_bf16(PAF(2),VFR(2),o[0],0,0,0), C1,0); \
    KRD(GL,3); GAPB(o[1]=__builtin_amdgcn_mfma_f32_32x32x16_bf16(PAF(2),VFR(6),o[1],0,0,0), C1,4); \
    GAPB(o[0]=__builtin_amdgcn_mfma_f32_32x32x16_bf16(PAF(3),VFR(3),o[0],0,0,0), C1,8); \
    GAPB(o[1]=__builtin_amdgcn_mfma_f32_32x32x16_bf16(PAF(3),VFR(7),o[1],0,0,0), C1,12); \
    }while(0)
  int t=1;
  #undef CMASK
  #define CMASK(P0,P1,t) do{}while(0)
  for(;t+5<NT;t+=2){
    STEP(pB0,pB1,pA0,pA1,t,true,true,true);     WAIT_BAR(2); RESC(); ROT();
    STEP(pA0,pA1,pB0,pB1,t+1,true,true,true);   WAIT_BAR(2); RESC(); ROT();
  }
  #undef CMASK
  #define CMASK(P0,P1,t) do{int jb_=(t)-(NT-4); if(jb_>=0)cmask(P0,P1,jb_,qrel,hi);}while(0)
  #define ENDW(tt) do{ if((tt)+3<NT){WAIT_BAR(2);} else if((tt)+2<NT){WAIT_BAR(1);} else {WAIT_BAR(0);} }while(0)
  for(;t+1<NT;t+=2){
    STEP(pB0,pB1,pA0,pA1,t,(t+3<NT),(t+1<NT),(t+1<NT));       ENDW(t);   RESC(); ROT();
    STEP(pA0,pA1,pB0,pB1,t+1,(t+4<NT),(t+2<NT),(t+2<NT));     ENDW(t+1); RESC(); ROT();
  }
  STEP(pB0,pB1,pA0,pA1,NT-1,false,false,false); RESC();
  { float sacc=pB0[0]+pB0[1]; _Pragma("unroll") for(int r=2;r<16;++r)sacc+=pB0[r]; _Pragma("unroll") for(int r=0;r<16;++r)sacc+=pB1[r]; l_reg+=sacc;
    pw0=(u32x4){PKW(pB0,0),PKW(pB0,2),PKW(pB0,4),PKW(pB0,6)};pw1=(u32x4){PKW(pB0,8),PKW(pB0,10),PKW(pB0,12),PKW(pB0,14)};pw2=(u32x4){PKW(pB1,0),PKW(pB1,2),PKW(pB1,4),PKW(pB1,6)};pw3=(u32x4){PKW(pB1,8),PKW(pB1,10),PKW(pB1,12),PKW(pB1,14)};
    SBAR(); pv(o,vb0+sl_cur,PAF(0),PAF(1),PAF(2),PAF(3)); }
  #undef PKW
  #undef PAF
  #undef VFR
  #undef PIN
  #undef MX3
  #undef GAPA
  #undef GAPB
  #undef EX
  #undef VRD
  #undef KRD
  #undef STEP
  #undef ENDW
  {auto rr=__builtin_amdgcn_permlane32_swap(__float_as_uint(l_reg),__float_as_uint(l_reg),false,false);l_reg=__uint_as_float(rr[0])+__uint_as_float(rr[1]);}
  if(hi==0)wsf[32+r32]=l_reg;asm volatile("s_waitcnt lgkmcnt(0)":::"memory");
  float rli[16];
  #pragma unroll
  for(int r=0;r<16;++r)rli[r]=__builtin_amdgcn_rcpf(wsf[32+crow(r,hi)]);
  bf16*Ow=O+(rowbase+q0+wid*QBLK)*DM+h*D;
  { bf16*stg=(bf16*)(shm+LDS_OST)+wid*2048;
    #pragma unroll
    for(int r=0;r<16;++r){const int orow=crow(r,hi);
      #pragma unroll
      for(int d0=0;d0<2;++d0)stg[orow*64+d0*32+r32]=__float2bfloat16(o[d0][r]*rli[r]);}
    asm volatile("s_waitcnt lgkmcnt(0)":::"memory");
    const bf16*SZw=SZ+(rowbase+q0+wid*QBLK)*DM+h*D;
    #pragma unroll
    for(int i=0;i<4;++i){const int row=i*8+(lane>>3),ch=lane&7; const u32x4 v=*(const u32x4*)(stg+row*64+ch*8); const u32x4 g=*(const u32x4*)(SZw+(long)row*DM+ch*8); u32x4 w;
      #pragma unroll
      for(int k=0;k<4;++k){ const float a0=__uint_as_float(v[k]<<16)*__uint_as_float(g[k]<<16), a1=__uint_as_float(v[k]&0xffff0000u)*__uint_as_float(g[k]&0xffff0000u); w[k]=cvtpk_s(a0,a1); }
      ATTN_STORE16(Ow+(long)row*DM+ch*8,w);} }
  asm volatile("s_waitcnt lgkmcnt(0)\n\ts_barrier":::"memory");
  #undef DMA_K
  #undef DMA_V
  #undef CMASK
  #undef START
  #undef RESC
  #undef ROT
  #undef BIAS
}
constexpr int ATTN_LDS_BYTES=LDS_BYTES;
struct AttnTensors { const bf16* Q; const bf16* K; const bf16* V; bf16* O; const bf16* SZ; const float* LF; };
template<int THRL=8> __device__ __forceinline__ void attn_phase(char*lds,const AttnTensors&T,int vcu,int G){
  #pragma unroll 1
  for(int task=vcu;task<BATCH*NHEAD*2;task+=G){
    int tid=threadIdx.x; asm volatile("":"+v"(tid)); const int lane=tid&63,wid=tid>>6;
    const int bh=task>>1,s=task&1,b=bh/NHEAD,h=bh%NHEAD;
    { __attribute__((address_space(3))) float* Fs=(__attribute__((address_space(3))) float*)((lds_cptr)lds+LDS_FS);
      __attribute__((address_space(3))) float* WT=(__attribute__((address_space(3))) float*)((lds_cptr)lds+LDS_SCAN);
      const float* lf=T.LF+((long)b*SEQ+4*tid)*NHEAD+h;
      const float v0=lf[0],v1=lf[NHEAD],v2=lf[2*NHEAD],v3=lf[3*NHEAD];
      const float p1=v0+v1,p2=p1+v2,p3=p2+v3; float x=p3;
      #pragma unroll
      for(int off=1;off<64;off<<=1){const float y=__shfl_up(x,off); if(lane>=off)x+=y;}
      if(lane==63)WT[wid]=x;
      __syncthreads();
      float offs=0.f;
      #pragma unroll
      for(int w=0;w<NW;++w){const float tv=WT[w]; if(w<wid)offs+=tv;}
      const float ex=x-p3+offs; const float L2E=1.4426950408889634f;
      f32x4v o4; o4[0]=(ex+v0)*L2E; o4[1]=(ex+p1)*L2E; o4[2]=(ex+p2)*L2E; o4[3]=(ex+p3)*L2E;
      *(__attribute__((address_space(3))) f32x4v*)(Fs+4*tid)=o4;
      __syncthreads(); }
    #pragma unroll 1
    for(int i=0;i<4;++i){ const int qb=(i==0)?7-s:(i==1)?s:(i==2)?4+s:3-s;
      attn_unit<THRL>(b,h,qb,T.Q,T.K,T.V,T.O,T.SZ,lds); }
  }
}
#undef SBAR
#undef WAIT_BAR
}
#define GAS __attribute__((address_space(1)))
#define LAS __attribute__((address_space(3)))
typedef unsigned short bf16u;
typedef unsigned v4u __attribute__((ext_vector_type(4)));
typedef float f32x4 __attribute__((ext_vector_type(4)));
typedef float f32x16 __attribute__((ext_vector_type(16)));
typedef short bf16x8 __attribute__((ext_vector_type(8)));
#define LDS_WAIT() asm volatile("s_waitcnt lgkmcnt(0)" ::: "memory")

constexpr int NWAVES = 8;
constexpr int BATCH = 8, SEQ = 2048, D = 1024, M = BATCH * SEQ, NG = 64, NST = 64, NH = 16;
constexpr float EPS = 1e-6f;
constexpr float C2 = 0.125f * 1.4426950408889634f;

constexpr size_t MiB = 1u << 20;
constexpr size_t WS_W_IN_A = 0 * MiB, WS_W_GLU = 4 * MiB, WS_W_OUT_A = 6 * MiB, WS_W_KV = 8 * MiB, WS_W_IN_B = 12 * MiB, WS_W_OUT_B = 16 * MiB;
constexpr size_t WS_W_F = 18 * MiB;
constexpr size_t WS_MODP = 220 * MiB;
constexpr size_t WS_GATE = 21 * MiB;
constexpr size_t WS_ABAR = 21 * MiB + 128 * 1024, WS_AL = WS_ABAR + 32 * 1024, WS_BFRAG = WS_AL + 32 * 1024, WS_CFRAG = WS_BFRAG + 256 * 1024;
constexpr size_t WS_CTL = 21 * MiB + 768 * 1024, CTL_ZERO_BYTES = 16384;
constexpr size_t WS_E = 22 * MiB;
constexpr size_t WS_UZ = 24 * MiB;
constexpr size_t WS_K = 24 * MiB, WS_V = 56 * MiB;
constexpr size_t WS_R2 = 88 * MiB;
constexpr size_t WS_R3 = 120 * MiB;
constexpr size_t WS_QO = 152 * MiB, WS_SZ = 184 * MiB;
constexpr size_t WS_LF = 216 * MiB;
constexpr size_t WS_END = 224 * MiB;
constexpr int LDS_BYTES = 147456;

__device__ __forceinline__ unsigned f2bf(float f) { unsigned u = __builtin_bit_cast(unsigned, f); return (u + 0x7fffu + ((u >> 16) & 1u)) >> 16; }
__device__ __forceinline__ unsigned pk2(float lo, float hi) { return f2bf(lo) | (f2bf(hi) << 16); }
__device__ __forceinline__ float wave_sum(float v) {
#pragma unroll
    for (int o = 1; o < 64; o <<= 1) v += __shfl_xor(v, o);
    return v;
}
__host__ __device__ __forceinline__ int phys_row(int n) { const int q = n & 255; return (n - q) + 128 * ((q >> 5) & 1) + 32 * (q >> 6) + (q & 31); }

struct Args { const float* in[29]; float* out; unsigned char* ws; };

__device__ __forceinline__ void p0_transpose_item(const float* W, int ldw, int K, int N, bf16u* WT, LAS float* scr, int item, int lane) {
    const int nblk = N / 32, kb = item / nblk, nb = item % nblk, k0 = 64 * kb, n0 = 32 * nb;
#pragma unroll 8
    for (int i = 0; i < 32; ++i) { const int kk = 2 * i + (lane >> 5); scr[kk * 33 + (lane & 31)] = W[(size_t)(k0 + kk) * ldw + n0 + (lane & 31)]; }
    LDS_WAIT(); asm volatile("" ::: "memory");
    const int c = lane & 7; const int pr0 = phys_row(n0);
#pragma unroll
    for (int j = 0; j < 4; ++j) { const int n = (lane >> 3) + 8 * j; const LAS float* s = scr + (8 * c) * 33 + n;
        v4u o; o.x = pk2(s[0 * 33], s[1 * 33]); o.y = pk2(s[2 * 33], s[3 * 33]); o.z = pk2(s[4 * 33], s[5 * 33]); o.w = pk2(s[6 * 33], s[7 * 33]);
        *(v4u*)(WT + (size_t)(pr0 + n) * K + k0 + 8 * c) = o; }
    LDS_WAIT(); asm volatile("" ::: "memory");
}

__device__ __forceinline__ void sincos_d(double x, double& s, double& c) {
    const double kq = rint(x * 0.63661977236758134308), r = fma(-kq, 1.57079632679489661923, x) - kq * 6.123233995736766e-17, r2 = r * r;
    double sp = -7.6471637318198165e-13; sp = fma(sp, r2, 1.6059043836821613e-10); sp = fma(sp, r2, -2.5052108385441720e-08); sp = fma(sp, r2, 2.7557319223985893e-06);
    sp = fma(sp, r2, -1.9841269841269841e-04); sp = fma(sp, r2, 8.3333333333333332e-03); sp = fma(sp, r2, -1.6666666666666666e-01); sp = fma(sp * r2, r, r);
    double cp = 4.7794773323873853e-14; cp = fma(cp, r2, -1.1470745597729725e-11); cp = fma(cp, r2, 2.0876756987868100e-09); cp = fma(cp, r2, -2.7557319223985888e-07);
    cp = fma(cp, r2, 2.4801587301587302e-05); cp = fma(cp, r2, -1.3888888888888889e-03); cp = fma(cp, r2, 4.1666666666666664e-02); cp = fma(cp, r2, -0.5); cp = fma(cp, r2, 1.0);
    const int q = ((int)kq) & 3;
    s = (q == 0) ? sp : (q == 1) ? cp : (q == 2) ? -sp : -cp;
    c = (q == 0) ? cp : (q == 1) ? -sp : (q == 2) ? -cp : sp;
}

#define XB_TMO      128
#define XB_XCNT(j)  (256  + 64 * (j))
#define XB_XSUB(j)  (1280 + 64 * (j))
#define XB_XGEN(j)  (2304 + 64 * (j))
#define XB_TOP      3328
#define XB_TOPGEN   3392
#define XCD_BAR_WORDS 3456
#define XB_SPIN_CAP (1u << 18)

__device__ __forceinline__ unsigned xb_ld(unsigned* p)              { return __hip_atomic_load(p, __ATOMIC_RELAXED, __HIP_MEMORY_SCOPE_AGENT); }
__device__ __forceinline__ unsigned xb_add(unsigned* p, unsigned v) { return __hip_atomic_fetch_add(p, v, __ATOMIC_RELAXED, __HIP_MEMORY_SCOPE_AGENT); }
__device__ __forceinline__ unsigned xb_xcc_id() { return (unsigned)__builtin_amdgcn_s_getreg((3 << 11) | 20) & 0xFu; }
#define XB_SPIN(cond, bar) do { unsigned _sp = 0; while (cond) { __builtin_amdgcn_s_sleep(1); \
    if ((++_sp & 255u) == 0u) { if (xb_ld(&(bar)[XB_TMO])) break; if (_sp > XB_SPIN_CAP) { atomicAdd(&(bar)[XB_TMO], 1u); break; } } } } while (0)

struct XcdBarrier {
    unsigned* bar; unsigned x;
    volatile LAS unsigned* st;
};

__device__ __forceinline__ XcdBarrier xcd_barrier_post(unsigned* bar, volatile LAS unsigned* st) {
    XcdBarrier b; b.bar = bar; b.x = xb_xcc_id(); b.st = st;
    if (threadIdx.x == 0) st[2] = xb_add(&bar[XB_XCNT(b.x)], 1u);
    return b;
}
__device__ __forceinline__ void xcd_barrier_complete(unsigned* bar, unsigned x, unsigned& nloc, unsigned& nx) {
    const unsigned G = gridDim.x * gridDim.y * gridDim.z;
    unsigned sum, cnt, mine, sp = 0u;
    for (;;) {
        sum = 0u; cnt = 0u; mine = 0u;
#pragma unroll
        for (unsigned j = 0; j < 16; ++j) { const unsigned c = xb_ld(&bar[XB_XCNT(j)]); sum += c; cnt += (c > 0u) ? 1u : 0u; mine = (j == x) ? c : mine; }
        if (sum == G) break;
        __builtin_amdgcn_s_sleep(1);
        if ((++sp & 255u) == 0u) { if (xb_ld(&bar[XB_TMO])) break; if (sp > XB_SPIN_CAP) { atomicAdd(&bar[XB_TMO], 1u); break; } }
    }
    nloc = mine > 0u ? mine : 1u; nx = cnt > 0u ? cnt : 1u;
}

__device__ __forceinline__ void xcd_barrier(const XcdBarrier& b) {
    asm volatile("s_waitcnt vmcnt(0)" ::: "memory");
    __syncthreads();
    if (threadIdx.x == 0) {
        unsigned* bar = b.bar;
        __builtin_amdgcn_s_waitcnt(0);
        unsigned nloc = b.st[0], nx = b.st[1];
        if (nloc == 0u) { xcd_barrier_complete(bar, b.x, nloc, nx); b.st[0] = nloc; b.st[1] = nx; }
        const unsigned bidx = b.st[3]; b.st[3] = bidx + 1u;
        const unsigned old = xb_add(&bar[XB_XSUB(b.x)], 1u);
        const unsigned gen = old / nloc;
        if (old + 1u == (gen + 1u) * nloc) {
            __builtin_amdgcn_fence(__ATOMIC_RELEASE, "agent");
            asm volatile("s_waitcnt vmcnt(0)" ::: "memory");
            const unsigned og = xb_add(&bar[XB_TOP], 1u);
            const unsigned tg = og / nx;
            if (og + 1u == (tg + 1u) * nx) xb_add(&bar[XB_TOPGEN], 1u);
            else XB_SPIN(xb_ld(&bar[XB_TOPGEN]) == tg, bar);
            __builtin_amdgcn_fence(__ATOMIC_ACQUIRE, "agent");
            asm volatile("s_waitcnt vmcnt(0)" ::: "memory");
        } else {
            XB_SPIN(xb_ld(&bar[XB_TOPGEN]) == bidx, bar);
            __builtin_amdgcn_fence(__ATOMIC_ACQUIRE, "agent");
            asm volatile("s_waitcnt vmcnt(0)" ::: "memory");
        }
    }
    __syncthreads();
}

__device__ __forceinline__ void xcd_local_barrier(const XcdBarrier& b) {
    asm volatile("s_waitcnt vmcnt(0)" ::: "memory");
    __syncthreads();
    if (threadIdx.x == 0) {
        unsigned* bar = b.bar;
        __builtin_amdgcn_s_waitcnt(0);
        const unsigned nloc = b.st[0];
        const unsigned lidx = b.st[5]; b.st[5] = lidx + 1u;
        (void)xb_add(&bar[XB_XGEN(b.x)], 1u);
        const unsigned want = (lidx + 1u) * nloc;
        XB_SPIN(xb_ld(&bar[XB_XGEN(b.x)]) < want, bar);
        __builtin_amdgcn_fence(__ATOMIC_ACQUIRE, "agent");
        asm volatile("s_waitcnt vmcnt(0)" ::: "memory");
    }
    __syncthreads();
}
#define REP_LOOP(k) REP_LOOP_(REP_P##k)
#define REP_LOOP_(n) REP_LOOP__(n)
#define REP_LOOP__(n) REP_LOOP_##n
#define REP_LOOP_1
#define REP_LOOP_2 _Pragma("unroll 1") for (int rep_ = 0; rep_ < 2; ++rep_)
#define REP_LOOP_3 _Pragma("unroll 1") for (int rep_ = 0; rep_ < 3; ++rep_)
#ifndef REP_P0
#define REP_P0 1
#endif
#ifndef REP_P1
#define REP_P1 1
#endif
#ifndef REP_P2
#define REP_P2 1
#endif
#ifndef REP_P3
#define REP_P3 1
#endif
#ifndef REP_P4
#define REP_P4 1
#endif
#ifndef REP_P5
#define REP_P5 1
#endif
#ifndef REP_P6
#define REP_P6 1
#endif
#ifndef REP_P7
#define REP_P7 1
#endif
#ifndef PH_MASK
#define PH_MASK 0x3ff
#endif
__device__ __forceinline__ float sigm_f(float x) { return __builtin_amdgcn_rcpf(1.0f + __builtin_amdgcn_exp2f(-1.4426950408889634f * x)); }
__device__ __forceinline__ float gelu_tanh(float y) { const float t = 1.5957691216057308f * (y + 0.044715f * y * y * y); return y * sigm_f(t); }
__device__ __forceinline__ int crow16(int r, int hi) { return (r & 3) + 8 * (r >> 2) + 4 * hi; }

template <int NOUT> __device__ __forceinline__ void norm_rows(const float* X, int v, int wave, int lane, const LAS float* GS0, const LAS float* SH0, bf16u* O0, const LAS float* GS1, const LAS float* SH1, bf16u* O1) {
    f32x4 gs0[4], sh0[4], gs1[4], sh1[4];
#pragma unroll
    for (int j = 0; j < 4; ++j) { gs0[j] = *(const LAS f32x4*)(GS0 + 256 * j + 4 * lane); sh0[j] = *(const LAS f32x4*)(SH0 + 256 * j + 4 * lane);
        if (NOUT == 2) { gs1[j] = *(const LAS f32x4*)(GS1 + 256 * j + 4 * lane); sh1[j] = *(const LAS f32x4*)(SH1 + 256 * j + 4 * lane); } }
    f32x4 x[8][4];
#pragma unroll
    for (int i = 0; i < 8; ++i) { const f32x4* xr = (const f32x4*)(X + (size_t)(64 * v + 8 * wave + i) * D) + lane;
#pragma unroll
        for (int j = 0; j < 4; ++j) x[i][j] = xr[64 * j]; }
#pragma unroll
    for (int i = 0; i < 8; ++i) { const size_t row = (size_t)(64 * v + 8 * wave + i);
        float s = 0.f;
#pragma unroll
        for (int j = 0; j < 4; ++j) s += (x[i][j].x * x[i][j].x + x[i][j].y * x[i][j].y) + (x[i][j].z * x[i][j].z + x[i][j].w * x[i][j].w);
        const float r = 1.0f / sqrtf(wave_sum(s) * (1.0f / D) + EPS);
        unsigned long long* o0 = (unsigned long long*)(O0 + row * D) + lane;
#pragma unroll
        for (int j = 0; j < 4; ++j) { const f32x4 h = x[i][j] * r * gs0[j] + sh0[j]; o0[64 * j] = (unsigned long long)pk2(h.x, h.y) | ((unsigned long long)pk2(h.z, h.w) << 32); }
        if (NOUT == 2) { unsigned long long* o1 = (unsigned long long*)(O1 + row * D) + lane;
#pragma unroll
            for (int j = 0; j < 4; ++j) { const f32x4 h = x[i][j] * r * gs1[j] + sh1[j]; o1[64 * j] = (unsigned long long)pk2(h.x, h.y) | ((unsigned long long)pk2(h.z, h.w) << 32); } }
    }
}
__device__ __forceinline__ void mod_vectors(const float* MODP, const float* bias, const float* g, int b, int cbase, LAS float* GS, LAS float* SH, int tid) {
    for (int k = tid; k < D; k += NWAVES * 64) { float sh = bias[k], sc = bias[D + k];
#pragma unroll
        for (int ks = 0; ks < 16; ++ks) { const float* p = MODP + (size_t)(ks * 8 + b) * 8192 + cbase + k; sh += p[0]; sc += p[D]; }
        GS[k] = g[k] * (1.0f + sc); SH[k] = sh; }
}

template <int PASS> __device__ __forceinline__ void s5_scan(LAS unsigned char* lds, const bf16u* UZp, bf16u* Y1, const float2* ABARp, const float2* ALp, const bf16u* BFRAGp, const bf16u* CFRAGp, const float* Dvec, int blk, int wave, int lane) {
    LAS unsigned char* Sl = lds + wave * 9728;
    LAS unsigned char* Ul = Sl + 8704;
    const int j = lane & 31, hi = lane >> 5;
    LAS f32x4* El = (LAS f32x4*)(lds + 8 * 9728);
    {
        const int g = blk & 63, bb_ = blk >> 6;
        const int sgi = wave + 8 * hi;
        const int seqA = (j >> 2) & 1, timeA = (j & 3) + 4 * (j >> 3);
        const bf16u* ap = UZp + ((size_t)(bb_ * SEQ + (wave + 8 * seqA) * 128 + timeA)) * 2048 + g * 16 + 8 * hi;
        bf16x8 at[4];
#pragma unroll
        for (int q = 0; q < 4; ++q) at[q] = *(const bf16x8*)(ap + (size_t)q * 16 * 2048);
        const float2 a0 = ABARp[g * 64 + j], a1 = ABARp[g * 64 + 32 + j];
        bf16x8 bfr[4], cfr[4];
#pragma unroll
        for (int c = 0; c < 4; ++c) bfr[c] = *(const bf16x8*)(BFRAGp + ((size_t)(g * 4 + c) * 64 + lane) * 8);
        if (PASS == 1) {
#pragma unroll
            for (int c = 0; c < 4; ++c) cfr[c] = *(const bf16x8*)(CFRAGp + ((size_t)(g * 4 + c) * 64 + lane) * 8); }
        float s0r = 0.f, s0i = 0.f, s1r = 0.f, s1i = 0.f;
        if (PASS == 1) { const float2 l0 = ALp[g * 64 + j], l1 = ALp[g * 64 + 32 + j];
#pragma unroll
            for (int k = 0; k < 15; ++k) { const f32x4 e = El[k * 32 + j]; const bool on = k < sgi;
                const float n0r = l0.x * s0r - l0.y * s0i + e.x, n0i = l0.x * s0i + l0.y * s0r + e.y; s0r = on ? n0r : s0r; s0i = on ? n0i : s0i;
                const float n1r = l1.x * s1r - l1.y * s1i + e.z, n1i = l1.x * s1i + l1.y * s1r + e.w; s1r = on ? n1r : s1r; s1i = on ? n1i : s1i; } }
        const float dv = (PASS == 1) ? Dvec[g * 16 + (lane & 15)] : 0.f;
#pragma unroll 1
        for (int tg = 0; tg < 2; ++tg) {
#pragma unroll
            for (int tq = 0; tq < 4; ++tq) {
                const int tile = tg * 4 + tq;
                bf16x8 a = at[tq];
                asm volatile("" : "+v"(a) : "v"(s0r), "v"(s1r));
                if (tg < 1) at[tq] = *(const bf16x8*)(ap + (size_t)(tile + 4) * 16 * 2048);
                f32x16 acc[4];
#pragma unroll
                for (int c = 0; c < 4; ++c) { f32x16 z = {}; acc[c] = __builtin_amdgcn_mfma_f32_32x32x16_bf16(a, bfr[c], z, 0, 0, 0); }
                if (PASS == 1) *(LAS bf16x8*)(Ul + j * 32 + hi * 16) = a;
#pragma unroll
                for (int r = 0; r < 16; ++r) {
                    const float n0r = a0.x * s0r - a0.y * s0i + acc[0][r], n0i = a0.x * s0i + a0.y * s0r + acc[1][r]; s0r = n0r; s0i = n0i; acc[0][r] = n0r; acc[1][r] = n0i;
                    const float n1r = a1.x * s1r - a1.y * s1i + acc[2][r], n1i = a1.x * s1i + a1.y * s1r + acc[3][r]; s1r = n1r; s1i = n1i; acc[2][r] = n1r; acc[3][r] = n1i; }
                if (PASS == 1) {
#pragma unroll
                    for (int r = 0; r < 16; ++r) { const int row = crow16(r, hi);
                        *(LAS unsigned*)(Sl + row * 272 + 4 * j) = pg8::cvt_pk_bf16(acc[0][r], acc[1][r]);
                        *(LAS unsigned*)(Sl + row * 272 + 128 + 4 * j) = pg8::cvt_pk_bf16(acc[2][r], acc[3][r]); }
                    LDS_WAIT();
                    f32x4 Y[2] = {{0.f, 0.f, 0.f, 0.f}, {0.f, 0.f, 0.f, 0.f}};
#pragma unroll
                    for (int mt = 0; mt < 2; ++mt)
#pragma unroll
                        for (int ks = 0; ks < 4; ++ks) { const bf16x8 af = *(const LAS bf16x8*)(Sl + (16 * mt + (lane & 15)) * 272 + (32 * ks + 8 * (lane >> 4)) * 2);
                            Y[mt] = __builtin_amdgcn_mfma_f32_16x16x32_bf16(af, cfr[ks], Y[mt], 0, 0, 0); }
                    const int ch = lane & 15, lq = lane >> 4;
                    unsigned yoff = (unsigned)(((bb_ * SEQ + (wave + 8 * (lq & 1)) * 128 + tile * 16 + 4 * (lq >> 1)) * D + g * 16 + ch) * 2);
                    asm volatile("" : "+v"(yoff));
                    float uv[2][4];
#pragma unroll
                    for (int mt = 0; mt < 2; ++mt)
#pragma unroll
                        for (int q = 0; q < 4; ++q) uv[mt][q] = __uint_as_float((unsigned)(*(const LAS unsigned short*)(Ul + (16 * mt + 4 * lq + q) * 32 + ch * 2)) << 16);
                    LDS_WAIT();
#pragma unroll
                    for (int mt = 0; mt < 2; ++mt)
#pragma unroll
                        for (int q = 0; q < 4; ++q) { const float y = gelu_tanh(Y[mt][q] + dv * uv[mt][q]);
                            *(bf16u*)((char*)Y1 + (yoff + (unsigned)((q + 8 * mt) * D * 2))) = (bf16u)f2bf(y); }
                }
            }
        }
        if (PASS == 0) El[sgi * 32 + j] = (f32x4){s0r, s0i, s1r, s1i};
    }
}


#define W_IN_A ((bf16u*)(GAS bf16u*)(ws + WS_W_IN_A))
#define W_GLU ((bf16u*)(GAS bf16u*)(ws + WS_W_GLU))
#define W_OUT_A ((bf16u*)(GAS bf16u*)(ws + WS_W_OUT_A))
#define W_KV ((bf16u*)(GAS bf16u*)(ws + WS_W_KV))
#define W_IN_B ((bf16u*)(GAS bf16u*)(ws + WS_W_IN_B))
#define W_OUT_B ((bf16u*)(GAS bf16u*)(ws + WS_W_OUT_B))
#define W_F ((bf16u*)(GAS bf16u*)(ws + WS_W_F))
#define MODP ((float*)(GAS float*)(ws + WS_MODP))
#define GATE ((float*)(GAS float*)(ws + WS_GATE))
#define ABAR ((float2*)(GAS float2*)(ws + WS_ABAR))
#define AL ((float2*)(GAS float2*)(ws + WS_AL))
#define BFRAG ((bf16u*)(GAS bf16u*)(ws + WS_BFRAG))
#define CFRAG ((bf16u*)(GAS bf16u*)(ws + WS_CFRAG))
#define E ((float4*)(GAS float4*)(ws + WS_E))
#define UZ ((bf16u*)(GAS bf16u*)(ws + WS_UZ))
#define KB ((bf16u*)(GAS bf16u*)(ws + WS_K))
#define VB ((bf16u*)(GAS bf16u*)(ws + WS_V))
#define R2 ((bf16u*)(GAS bf16u*)(ws + WS_R2))
#define R3 ((bf16u*)(GAS bf16u*)(ws + WS_R3))
#define QO ((bf16u*)(GAS bf16u*)(ws + WS_QO))
#define SZ ((bf16u*)(GAS bf16u*)(ws + WS_SZ))
#define LF ((float*)(GAS float*)(ws + WS_LF))
__device__ __forceinline__ const float* arg_in(const Args& a, int k) { asm volatile("" : "+s"(k)); return (const float*)(const GAS float*)a.in[k]; }
#define AIN(k) arg_in(args, (k))
#define PHASE_WS GAS unsigned char* ws = (GAS unsigned char*)args.ws; asm volatile("" : "+s"(ws))
__global__ void __launch_bounds__(NWAVES * 64, 2) fwd_mega(Args args) {
    extern __shared__ __attribute__((aligned(16))) unsigned char lds_raw[];
    cg::grid_group grid = cg::this_grid();
    LAS unsigned char* lds = (LAS unsigned char*)lds_raw;
    const int tid = threadIdx.x, lane = tid & 63, wave = __builtin_amdgcn_readfirstlane(tid >> 6);
    const int G = gridDim.x, bx = blockIdx.x;
    int vcu = (G % 8 == 0) ? (bx % 8) * (G / 8) + bx / 8 : bx;
    int gw = vcu * NWAVES + wave; const int NGW = G * NWAVES; int cid = bx;
    int xmap = 0, xrank_ = 0, xcc_ = 0;
    float* const out = args.out;
    volatile LAS unsigned* MISC = (volatile LAS unsigned*)(lds + 131072 + 320);
    if (tid < 32) MISC[tid] = 0u;
    __syncthreads();
    XcdBarrier bar = xcd_barrier_post((unsigned*)(args.ws + WS_CTL), MISC + 8);
    if (args.ws == nullptr) grid.sync();
#define GRID_BAR() xcd_barrier(bar)
#define LOCAL_BAR() do { if (xmap) xcd_local_barrier(bar); else xcd_barrier(bar); } while (0)

#if (PH_MASK >> 0) & 1
    REP_LOOP(0) {
    PHASE_WS;
    {
        const float* cndp = AIN(1);
        LAS float* SC = (LAS float*)(lds + 73728);
        for (int idx = tid; idx < 8 * D; idx += NWAVES * 64) { const int b = idx >> 10, k = idx & 1023; const float cv = cndp[idx]; SC[k * 8 + b] = cv * sigm_f(cv); }
        __syncthreads();
        LAS float* scr = (LAS float*)(lds + wave * 8704);
        constexpr int I_2048 = (D / 64) * (2048 / 32), I_1024 = (D / 64) * (1024 / 32);
        constexpr int NT_ITEMS = 3 * I_2048 + 3 * I_1024, NITEMS = NT_ITEMS + 2048;
        for (int it = gw; it < NITEMS; it += NGW) {
            int r = it;
            if (r < NT_ITEMS) {
                if (r < I_2048) { p0_transpose_item(AIN(5), 2048, D, 2048, W_IN_A, scr, r, lane); continue; } r -= I_2048;
                if (r < I_2048) { p0_transpose_item(AIN(20), 2064, D, 2048, W_KV, scr, r, lane); continue; } r -= I_2048;
                if (r < I_2048) { p0_transpose_item(AIN(26), 2048, D, 2048, W_IN_B, scr, r, lane); continue; } r -= I_2048;
                if (r < I_1024) { p0_transpose_item(AIN(14), 1024, D, 1024, W_GLU, scr, r, lane); continue; } r -= I_1024;
                if (r < I_1024) { p0_transpose_item(AIN(16), 1024, D, 1024, W_OUT_A, scr, r, lane); continue; } r -= I_1024;
                p0_transpose_item(AIN(28), 1024, D, 1024, W_OUT_B, scr, r, lane); continue;
            }
            r -= NT_ITEMS;
            const int col = (r >> 4) * 64 + lane, ks = r & 15;
            const float* W; int ldw, cc;
            if (col < 3072) { W = AIN(3); ldw = 3072; cc = col; } else if (col < 5120) { W = AIN(18); ldw = 2048; cc = col - 3072; } else { W = AIN(24); ldw = 3072; cc = col - 5120; }
            float acc8[8] = {0.f, 0.f, 0.f, 0.f, 0.f, 0.f, 0.f, 0.f};
            const float* wp = W + (size_t)(ks * 64) * ldw + cc;
#pragma unroll 16
            for (int k = 0; k < 64; ++k) { const float w = wp[(size_t)k * ldw];
                const f32x4 s0 = *(const LAS f32x4*)(SC + (ks * 64 + k) * 8), s1 = *(const LAS f32x4*)(SC + (ks * 64 + k) * 8 + 4);
                acc8[0] += s0.x * w; acc8[1] += s0.y * w; acc8[2] += s0.z * w; acc8[3] += s0.w * w; acc8[4] += s1.x * w; acc8[5] += s1.y * w; acc8[6] += s1.z * w; acc8[7] += s1.w * w; }
#pragma unroll
            for (int b = 0; b < 8; ++b) MODP[(size_t)(ks * 8 + b) * 8192 + col] = acc8[b];
        }
        const int gtid = vcu * (NWAVES * 64) + tid, NGT = G * NWAVES * 64;
        for (int idx = gtid; idx < 16 * D; idx += NGT) { const int jf = idx >> 10, k = idx & 1023; W_F[idx] = (bf16u)f2bf(AIN(20)[(size_t)k * 2064 + 2048 + jf]); }
        for (int it = gtid; it < NG * NST * 16; it += NGT) {
            const int idx = it >> 4, ch = it & 15, g = idx >> 6, p = idx & 63;
            const double dt = exp((double)AIN(6)[g]), ar = (double)AIN(7)[idx], ai = (double)AIN(8)[idx];
            const double mag = exp(ar * dt); double sn, cs; sincos_d(ai * dt, sn, cs);
            const double abr = mag * cs, abi = mag * sn, den = ar * ar + ai * ai, nr = abr - 1.0;
            const double cr = (nr * ar + abi * ai) / den, ci = (abi * ar - nr * ai) / den;
            if (ch == 0) { ABAR[idx] = make_float2((float)abr, (float)abi);
                double pr = abr, pi = abi;
#pragma unroll
                for (int q = 0; q < 7; ++q) { const double t = pr * pr - pi * pi; pi = 2.0 * pr * pi; pr = t; }
                AL[idx] = make_float2((float)pr, (float)pi); }
            { const double br = AIN(9)[(size_t)idx * 16 + ch], bi = AIN(10)[(size_t)idx * 16 + ch]; const double bbr = cr * br - ci * bi, bbi = cr * bi + ci * br;
              const int c0 = (p >> 5) * 2, l = (ch >> 3) * 32 + (p & 31), jj = ch & 7;
              BFRAG[((size_t)(g * 4 + c0) * 64 + l) * 8 + jj] = (bf16u)f2bf((float)bbr); BFRAG[((size_t)(g * 4 + c0 + 1) * 64 + l) * 8 + jj] = (bf16u)f2bf((float)bbi); }
            { const float cre = AIN(11)[(size_t)(g * 16 + ch) * 64 + p], cim = AIN(12)[(size_t)(g * 16 + ch) * 64 + p];
#pragma unroll
              for (int ri = 0; ri < 2; ++ri) { const int kap = 2 * p + ri, ks2 = kap >> 5, l = ((kap & 31) >> 3) * 16 + ch, jj = kap & 7;
                  CFRAG[((size_t)(g * 4 + ks2) * 64 + l) * 8 + jj] = (bf16u)f2bf(ri == 0 ? cre : -cim); } }
        }
    }
#endif
    GRID_BAR();
    }
    {
        if (tid == 0) { unsigned ok = (G % 8 == 0) ? 1u : 0u;
            for (unsigned jx = 0; jx < 16; ++jx) { const unsigned c = xb_ld(&bar.bar[XB_XCNT(jx)]); ok &= (jx < 8 ? (c == (unsigned)(G / 8)) : (c == 0u)) ? 1u : 0u; }
            MISC[12] = ok; }
        __syncthreads();
        const int okm = __builtin_amdgcn_readfirstlane((int)MISC[12]), xrank = __builtin_amdgcn_readfirstlane((int)MISC[10]), xcc = (int)bar.x;
        if (okm && G == 256) { cid = xrank * 8 + xcc; vcu = xcc * (G / 8) + xrank; gw = vcu * NWAVES + wave; xmap = 1; xrank_ = xrank; xcc_ = xcc; }
    }

#if (PH_MASK >> 1) & 1
    REP_LOOP(1) {
    PHASE_WS;
    {
        if (tid < 64) { const int idx = xmap ? ((((xrank_ * 64 + tid) >> 10) << 13) | (xcc_ << 10) | ((xrank_ * 64 + tid) & 1023)) : vcu * 64 + tid;
            if (idx < 2 * 8 * D) { const int which = idx >> 13, b = (idx >> 10) & 7, n = idx & 1023;
                const int col = which == 0 ? 2048 + n : 5120 + 2048 + n; float s = which == 0 ? AIN(4)[2048 + n] : AIN(25)[2048 + n];
#pragma unroll
                for (int ks = 0; ks < 16; ++ks) s += MODP[(size_t)(ks * 8 + b) * 8192 + col];
                GATE[idx] = s; } }
        LAS float* GS = (LAS float*)lds; LAS float* SH = GS + D;
        for (int v = vcu; v < M / 64; v += G) {
            __syncthreads();
            mod_vectors(MODP, AIN(4), AIN(2), v >> 5, 0, GS, SH, tid);
            __syncthreads();
            norm_rows<1>(AIN(0), v, wave, lane, GS, SH, R2, GS, SH, R2);
        }
    }
#endif
    LOCAL_BAR();
    }

#if (PH_MASK >> 2) & 1
    REP_LOOP(2) {
    PHASE_WS;
    { pg8::Gemm g{R2, W_IN_A, M, 2048, D}; pg8::StaticOrder S; S.init(M, 2048, G, cid); pg8::EpiStore Ep{UZ, 2048};
      pg8::gemm_phase<pg8::EpiStore, pg8::StaticOrder, true, true>(lds, g, S, Ep); }
#endif
    LOCAL_BAR();
    }

#if (PH_MASK >> 3) & 1
    REP_LOOP(3) {
    PHASE_WS;
    for (int it_ = 0; it_ < 2; ++it_) for (int v_ = vcu; v_ < 256; v_ += G) {
        const int blk = (v_ >> 5) * 64 + (v_ & 31) + 32 * it_;
        __syncthreads();
        s5_scan<0>(lds, UZ, R2, ABAR, AL, BFRAG, CFRAG, AIN(13), blk, wave, lane);
        __syncthreads();
        s5_scan<1>(lds, UZ, R2, ABAR, AL, BFRAG, CFRAG, AIN(13), blk, wave, lane);
    }
#endif
    LOCAL_BAR();
    }

#if (PH_MASK >> 4) & 1
    REP_LOOP(4) {
    PHASE_WS;
    { pg8::Gemm g{R2, W_GLU, M, 1024, D}; pg8::StaticOrder S; S.init(M, 1024, G, cid); pg8::EpiGlu Ep{R2, UZ + 1024, AIN(15), R3};
      pg8::gemm_phase<pg8::EpiGlu, pg8::StaticOrder, true, true>(lds, g, S, Ep); }
#endif
    LOCAL_BAR();
    }

#if (PH_MASK >> 5) & 1
    REP_LOOP(5) {
    PHASE_WS;
    { pg8::Gemm g{R3, W_OUT_A, M, 1024, D}; pg8::StaticOrder S; S.init(M, 1024, G, cid); pg8::EpiRes Ep{AIN(0), GATE, out};
      pg8::gemm_phase<pg8::EpiRes, pg8::StaticOrder, true, true>(lds, g, S, Ep); }
#endif
    LOCAL_BAR();
    }

#if (PH_MASK >> 6) & 1
    REP_LOOP(6) {
    PHASE_WS;
    {
        LAS float* GS0 = (LAS float*)lds; LAS float* SH0 = GS0 + D; LAS float* GS1 = SH0 + D; LAS float* SH1 = GS1 + D;
        for (int v = vcu; v < M / 64; v += G) {
            __syncthreads();
            mod_vectors(MODP, AIN(19), AIN(17), v >> 5, 3072, GS0, SH0, tid);
            mod_vectors(MODP, AIN(25), AIN(23), v >> 5, 5120, GS1, SH1, tid);
            __syncthreads();
            norm_rows<2>(out, v, wave, lane, GS0, SH0, R2, GS1, SH1, R3);
        }
    }
#endif
    LOCAL_BAR();
    }

#if (PH_MASK >> 7) & 1
    REP_LOOP(7) {
    PHASE_WS;
    {
        for (int v_ = vcu; v_ < M / 64; v_ += G) if (wave < 4) { const int t = 4 * v_ + wave;
            f32x4 acc = {0.f, 0.f, 0.f, 0.f};
            const bf16u* ap = R2 + (size_t)(16 * t + (lane & 15)) * D + 8 * (lane >> 4); const bf16u* bp = W_F + (size_t)(lane & 15) * D + 8 * (lane >> 4);
#pragma unroll 16
            for (int ks = 0; ks < 32; ++ks) acc = __builtin_amdgcn_mfma_f32_16x16x32_bf16(*(const bf16x8*)(ap + ks * 32), *(const bf16x8*)(bp + ks * 32), acc, 0, 0, 0);
            const float fb = AIN(21)[lane & 15];
#pragma unroll
            for (int r = 0; r < 4; ++r) { const float xl = acc[r] + fb; const float ls = fminf(xl, 0.f) - log1pf(__expf(-fabsf(xl)));
                LF[(size_t)(16 * t + 4 * (lane >> 4) + r) * NH + (lane & 15)] = ls; }
        }
        { pg8::Gemm g{R2, W_KV, M, 2048, D}; pg8::StaticOrder S; S.init(M, 2048, G, cid); pg8::EpiHeadNorm<false> Ep{KB, VB, AIN(22), 1.0f};
          pg8::gemm_phase<pg8::EpiHeadNorm<false>, pg8::StaticOrder, true, true>(lds, g, S, Ep); }
        { pg8::Gemm g{R3, W_IN_B, M, 2048, D}; pg8::StaticOrder S; S.init(M, 2048, G, cid); pg8::EpiHeadNorm<true> Ep{QO, SZ, AIN(27), C2};
          pg8::gemm_phase<pg8::EpiHeadNorm<true>, pg8::StaticOrder, true, true>(lds, g, S, Ep); }
    }
#endif
    LOCAL_BAR();
    }

#if (PH_MASK >> 8) & 1
    { PHASE_WS; const attn_body::AttnTensors AT{(const attn_body::bf16*)QO, (const attn_body::bf16*)KB, (const attn_body::bf16*)VB, (attn_body::bf16*)QO, (const attn_body::bf16*)SZ, LF};
      attn_body::attn_phase<8>((char*)lds_raw, AT, vcu, G); }
#endif
    LOCAL_BAR();

#if (PH_MASK >> 9) & 1
    { PHASE_WS; pg8::Gemm g{QO, W_OUT_B, M, 1024, D}; pg8::StaticOrder S; S.init(M, 1024, G, cid); pg8::EpiRes Ep{out, GATE + 8 * D, out};
      pg8::gemm_phase<pg8::EpiRes, pg8::StaticOrder, true, true>(lds, g, S, Ep); }
#endif
}

extern "C" void kernel_launch(void* const* d_in, const int* in_sizes, int n_in, void* d_out, int out_size, void* d_ws, size_t ws_size, hipStream_t stream) {
    static int grid = 0;
    if (grid == 0) {
        if (n_in != 29 || out_size != M * D || ws_size < WS_END) { fprintf(stderr, "kernel_launch: unexpected problem (n_in %d out %d ws %zu)\n", n_in, out_size, ws_size); grid = -1; return; }
        int dev = 0, cus = 0, per_cu = 0;
        (void)hipGetDevice(&dev); (void)hipDeviceGetAttribute(&cus, hipDeviceAttributeMultiprocessorCount, dev);
        if (hipFuncSetAttribute((const void*)fwd_mega, hipFuncAttributeMaxDynamicSharedMemorySize, LDS_BYTES) != hipSuccess) { fprintf(stderr, "kernel_launch: hipFuncSetAttribute failed\n"); grid = -1; return; }
        if (hipOccupancyMaxActiveBlocksPerMultiprocessor(&per_cu, (const void*)fwd_mega, NWAVES * 64, LDS_BYTES) != hipSuccess || per_cu < 1) { fprintf(stderr, "kernel_launch: occupancy query says %d\n", per_cu); per_cu = 1; }
        (void)hipGetLastError();
        grid = cus > 0 ? cus : 256;
    }
    if (grid < 0) return;
    if (hipMemsetAsync((char*)d_ws + WS_CTL, 0, CTL_ZERO_BYTES, stream) != hipSuccess) { fprintf(stderr, "kernel_launch: memset failed\n"); return; }
    Args a{};
    for (int i = 0; i < 29; ++i) a.in[i] = (const float*)d_in[i];
    a.out = (float*)d_out; a.ws = (unsigned char*)d_ws;
    void* kargs[] = {&a};
    const hipError_t e = hipLaunchCooperativeKernel((const void*)fwd_mega, dim3(grid), dim3(NWAVES * 64), kargs, LDS_BYTES, stream);
    if (e != hipSuccess) fprintf(stderr, "cooperative launch failed: %s (grid %d)\n", hipGetErrorString(e), grid);
}
```

```cpp
#include <hip/hip_runtime.h>
#include <hip/hip_cooperative_groups.h>
#include <cstdio>
#include <cstdint>
namespace cg = cooperative_groups;
namespace pg8 {
#define PG8_LAS __attribute__((address_space(3)))
typedef unsigned short bf16_t;
typedef short bf16x8 __attribute__((ext_vector_type(8)));
typedef float f32x4 __attribute__((ext_vector_type(4)));
typedef unsigned u32x4 __attribute__((ext_vector_type(4)));
constexpr int BM = 256, BK = 64, HALF = 128, HTB = HALF * BK * 2  , STAGE_BYTES = 8 * HTB, NXCD = 8, WGM = 8;

__host__ __device__ __forceinline__ int lds_byte(int r, int c) { const int st = (r >> 4) * 2 + (c >> 5), rr = r & 15, cc = c & 31, ob = rr * 64 + cc * 2; return st * 1024 + (ob ^ (((ob >> 9) & 1) << 5)); }
__host__ __device__ __forceinline__ void stage_rc(int b, int& R, int& C) { const int st = b / 1024, sb = b % 1024, swz = sb ^ (((sb >> 9) & 1) << 5); R = (st >> 1) * 16 + swz / 64; C = (st & 1) * 32 + (swz % 64) / 2; }
__host__ __device__ __forceinline__ int perm32(int rho) { const int n = rho >> 4, i = rho & 15; return 8 * (i >> 2) + 4 * n + (i & 3); }

struct Unit { int pm, pn; };
struct Gemm { const bf16_t* A; const bf16_t* Bt; int M, N, K; };

struct StaticOrder {
    int nM, nN, nwg, G, c;
    __host__ __device__ void init(int M, int N, int G_, int c_) { nM = M / BM; nN = N / BM; nwg = nM * nN; G = G_; c = c_; }
    __host__ __device__ bool next(int i, Unit& u) const {
        const long L = (long)i * G + c; if (L >= nwg) return false;
        int wgid = (int)L; { const int q = nwg / NXCD, r = nwg % NXCD, xcd = wgid % NXCD, off = wgid / NXCD; wgid = (xcd < r ? xcd * (q + 1) : r * (q + 1) + (xcd - r) * q) + off; }
        const int nig = WGM * nN, gid = wgid / nig, fm = gid * WGM, gsz = (nM - fm) < WGM ? (nM - fm) : WGM;
        u.pm = fm + ((wgid % nig) % gsz); u.pn = (wgid % nig) / gsz; return true;
    }
    __device__ __forceinline__ void a_ready(const Unit&) const {}
    __device__ __forceinline__ void done(const Unit&) const {}
};

__device__ __forceinline__ unsigned cvt_pk_bf16(float lo, float hi) { unsigned r; asm volatile("v_cvt_pk_bf16_f32 %0, %1, %2" : "=v"(r) : "v"(lo), "v"(hi)); return r; }
typedef float f32x2 __attribute__((ext_vector_type(2)));
typedef unsigned u32x4e __attribute__((ext_vector_type(4)));
__device__ __forceinline__ float bf_lo(unsigned u) { return __uint_as_float(u << 16); }
__device__ __forceinline__ float bf_hi(unsigned u) { return __uint_as_float(u & 0xffff0000u); }
__device__ __forceinline__ float sigm(float x) { return __builtin_amdgcn_rcpf(1.0f + __builtin_amdgcn_exp2f(-1.4426950408889634f * x)); }
__device__ __forceinline__ u32x4e pack8(const f32x4& a, const f32x4& b) { u32x4e w; w.x = cvt_pk_bf16(a[0], a[1]); w.y = cvt_pk_bf16(a[2], a[3]); w.z = cvt_pk_bf16(b[0], b[1]); w.w = cvt_pk_bf16(b[2], b[3]); return w; }

struct EpiStore {
    static constexpr bool PERM = true, AFTER_DRAIN = false;
    bf16_t* O; int ldc;
    __device__ __forceinline__ void operator()(const f32x4 (&acc)[2][2][4][2], const Unit& u, int wr, int wc, int fr, int fq) const {
        const int row0 = u.pm * BM + wr * 64 + fr, colb = u.pn * BM + wc * 64 + 8 * fq;
#pragma unroll
        for (int ai = 0; ai < 2; ++ai)
#pragma unroll
            for (int m = 0; m < 4; ++m) { bf16_t* rowp = O + (size_t)(row0 + ai * HALF + m * 16) * ldc + colb;
#pragma unroll
                for (int bj = 0; bj < 2; ++bj) *(u32x4e*)(rowp + bj * 32) = pack8(acc[ai][bj][m][0], acc[ai][bj][m][1]); }
    }
};
struct EpiGlu {
    static constexpr bool PERM = true, AFTER_DRAIN = false;
    const bf16_t* Y1; const bf16_t* Z; const float* bias; bf16_t* O;
    __device__ __forceinline__ void operator()(const f32x4 (&acc)[2][2][4][2], const Unit& u, int wr, int wc, int fr, int fq) const {
        constexpr int PD = 6;
        const int row0 = u.pm * BM + wr * 64 + fr, colb = u.pn * BM + wc * 64 + 8 * fq;
        f32x4 bv[2][2];
#pragma unroll
        for (int bj = 0; bj < 2; ++bj)
#pragma unroll
            for (int n = 0; n < 2; ++n) bv[bj][n] = *(const f32x4*)(bias + colb + bj * 32 + 4 * n);
        u32x4e yb[PD], zb[PD];
#define EG_ROW(it) ((size_t)(row0 + ((it) >> 3) * HALF + (((it) >> 1) & 3) * 16))
#define EG_COL(it) (colb + ((it) & 1) * 32)
#pragma unroll
        for (int it = 0; it < PD; ++it) { yb[it] = __builtin_nontemporal_load((const u32x4e*)(Y1 + EG_ROW(it) * 1024 + EG_COL(it))); zb[it] = __builtin_nontemporal_load((const u32x4e*)(Z + EG_ROW(it) * 2048 + EG_COL(it)));     }
#pragma unroll
        for (int it = 0; it < 16; ++it) { const int ai = it >> 3, m = (it >> 1) & 3, bj = it & 1;
            const u32x4e yv = yb[it % PD], zv = zb[it % PD];
            if (it + PD < 16) { yb[it % PD] = __builtin_nontemporal_load((const u32x4e*)(Y1 + EG_ROW(it + PD) * 1024 + EG_COL(it + PD))); zb[it % PD] = __builtin_nontemporal_load((const u32x4e*)(Z + EG_ROW(it + PD) * 2048 + EG_COL(it + PD))); }
            asm volatile("" ::: "memory");
            f32x4 o0, o1;
#pragma unroll
            for (int k = 0; k < 2; ++k) { const float g0 = acc[ai][bj][m][0][2 * k] + bv[bj][0][2 * k], g1 = acc[ai][bj][m][0][2 * k + 1] + bv[bj][0][2 * k + 1];
                const float z0 = bf_lo(zv[k]), z1 = bf_hi(zv[k]);
                o0[2 * k] = bf_lo(yv[k]) * sigm(g0) * z0 * sigm(z0); o0[2 * k + 1] = bf_hi(yv[k]) * sigm(g1) * z1 * sigm(z1); }
#pragma unroll
            for (int k = 0; k < 2; ++k) { const float g0 = acc[ai][bj][m][1][2 * k] + bv[bj][1][2 * k], g1 = acc[ai][bj][m][1][2 * k + 1] + bv[bj][1][2 * k + 1];
                const float z0 = bf_lo(zv[2 + k]), z1 = bf_hi(zv[2 + k]);
                o1[2 * k] = bf_lo(yv[2 + k]) * sigm(g0) * z0 * sigm(z0); o1[2 * k + 1] = bf_hi(yv[2 + k]) * sigm(g1) * z1 * sigm(z1); }
            *(u32x4e*)(O + EG_ROW(it) * 1024 + EG_COL(it)) = pack8(o0, o1);
            asm volatile("" ::: "memory"); }
    }
};
template <bool NT> struct EpiResT {
    static constexpr bool PERM = true, AFTER_DRAIN = false;
    const float* X; const float* gate; float* OUT;
    __device__ __forceinline__ void operator()(const f32x4 (&acc)[2][2][4][2], const Unit& u, int wr, int wc, int fr, int fq) const {
        constexpr int PD = 6;
        const int row0 = u.pm * BM + wr * 64 + fr, colb = u.pn * BM + wc * 64 + 8 * fq;
        const float* gp = gate + (size_t)(u.pm >> 3) * 1024 + colb;
        f32x4 gv[2][2];
#pragma unroll
        for (int bj = 0; bj < 2; ++bj)
#pragma unroll
            for (int n = 0; n < 2; ++n) gv[bj][n] = *(const f32x4*)(gp + bj * 32 + 4 * n);
        f32x4 xb[PD][2];
#pragma unroll
        for (int it = 0; it < PD; ++it) { const float* p = X + EG_ROW(it) * 1024 + EG_COL(it); xb[it][0] = __builtin_nontemporal_load((const f32x4*)p); xb[it][1] = __builtin_nontemporal_load((const f32x4*)(p + 4));     }
#pragma unroll
        for (int it = 0; it < 16; ++it) { const int ai = it >> 3, m = (it >> 1) & 3, bj = it & 1;
            const f32x4 x0 = xb[it % PD][0], x1 = xb[it % PD][1];
            if (it + PD < 16) { const float* p = X + EG_ROW(it + PD) * 1024 + EG_COL(it + PD); xb[it % PD][0] = __builtin_nontemporal_load((const f32x4*)p); xb[it % PD][1] = __builtin_nontemporal_load((const f32x4*)(p + 4)); }
            asm volatile("" ::: "memory");
            float* q = OUT + EG_ROW(it) * 1024 + EG_COL(it);
            const f32x4 o0 = x0 + gv[bj][0] * acc[ai][bj][m][0], o1 = x1 + gv[bj][1] * acc[ai][bj][m][1];
            if (NT) { __builtin_nontemporal_store(o0, (f32x4*)q); __builtin_nontemporal_store(o1, (f32x4*)(q + 4)); }
            else { *(f32x4*)q = o0; *(f32x4*)(q + 4) = o1; }
            asm volatile("" ::: "memory"); }
#undef EG_ROW
#undef EG_COL
    }
};
typedef EpiResT<false> EpiRes;
template <bool SILU> struct EpiHeadNorm {
    static constexpr bool PERM = true, AFTER_DRAIN = false;
    bf16_t* O0; bf16_t* O1; const float* g; float scale;
    __device__ __forceinline__ void operator()(const f32x4 (&acc)[2][2][4][2], const Unit& u, int wr, int wc, int fr, int fq) const {
        const int row0 = u.pm * BM + wr * 64 + fr;
        if (u.pn < 4) {
            const int colb = u.pn * BM + wc * 64 + 8 * fq;
            f32x4 gv[2][2];
#pragma unroll
            for (int bj = 0; bj < 2; ++bj)
#pragma unroll
                for (int n = 0; n < 2; ++n) gv[bj][n] = *(const f32x4*)(g + bj * 32 + 8 * fq + 4 * n) * scale;
#pragma unroll
            for (int ai = 0; ai < 2; ++ai)
#pragma unroll
                for (int m = 0; m < 4; ++m) { float s = 0.f;
#pragma unroll
                    for (int bj = 0; bj < 2; ++bj)
#pragma unroll
                        for (int n = 0; n < 2; ++n) { const f32x4 x = acc[ai][bj][m][n]; s += (x[0] * x[0] + x[1] * x[1]) + (x[2] * x[2] + x[3] * x[3]); }
                    s += __shfl_xor(s, 16); s += __shfl_xor(s, 32);
                    const float r = 1.0f / sqrtf(s * (1.0f / 64.0f) + 1e-6f);
                    bf16_t* rowp = O0 + (size_t)(row0 + ai * HALF + m * 16) * 1024 + colb;
#pragma unroll
                    for (int bj = 0; bj < 2; ++bj) *(u32x4e*)(rowp + bj * 32) = pack8(acc[ai][bj][m][0] * r * gv[bj][0], acc[ai][bj][m][1] * r * gv[bj][1]); }
        } else {
            const int colb = (u.pn - 4) * BM + wc * 64 + 8 * fq;
#pragma unroll
            for (int ai = 0; ai < 2; ++ai)
#pragma unroll
                for (int m = 0; m < 4; ++m) { bf16_t* rowp = O1 + (size_t)(row0 + ai * HALF + m * 16) * 1024 + colb;
#pragma unroll
                    for (int bj = 0; bj < 2; ++bj) { f32x4 a = acc[ai][bj][m][0], b = acc[ai][bj][m][1];
                        if (SILU) {
#pragma unroll
                            for (int k = 0; k < 4; ++k) { a[k] = a[k] * sigm(a[k]); b[k] = b[k] * sigm(b[k]); } }
                        *(u32x4e*)(rowp + bj * 32) = pack8(a, b); } }
        }
    }
};
template <class Epi, class Sched, bool ALIGN_EPI = false, bool SP2 = false>
__device__ __forceinline__ void gemm_phase(PG8_LAS unsigned char* lds, const Gemm g, const Sched& S, const Epi& E) {
    int tid_ = threadIdx.x; asm volatile("" : "+v"(tid_));
    const int tid = tid_, wid = __builtin_amdgcn_readfirstlane(tid >> 6), lane = tid & 63, wr = wid >> 2, wc = wid & 3, fr = lane & 15, fq = lane >> 4;
    const int K = g.K, nt = K / BK;
    unsigned voffA[2], voffB[2];
#pragma unroll
    for (int i = 0; i < 2; ++i) { int R, C; stage_rc(tid * 16 + i * 8192, R, C); const int Rb = Epi::PERM ? ((R & ~31) + perm32(R & 31)) : R;
        voffA[i] = (unsigned)(R * K + C) * 2u; voffB[i] = (unsigned)(Rb * K + C) * 2u; }
    const size_t kstep = (size_t)(BK * 2);
    const size_t hstep = (size_t)HALF * K * 2;
    const size_t tstep = 2 * hstep;
    const unsigned ldsw = (unsigned)wid * 1024u;
    const int aoff = lds_byte(wr * 64 + fr, fq * 8), boff = lds_byte(wc * 32 + fr, fq * 8);
#define PG8_SA(b, h) (((b) * 2 + (h)) * HTB)
#define PG8_SB(b, h) ((4 + (b) * 2 + (h)) * HTB)
#define PG8_STAGE(bufoff, gbase, voff) do { _Pragma("unroll") for (int _i = 0; _i < 2; ++_i) \
        __builtin_amdgcn_global_load_lds((const unsigned*)((const char*)(gbase) + (voff)[_i]), (PG8_LAS unsigned*)(lds + (bufoff) + ldsw + _i * 8192), 16, 0, 0); } while (0)
#define PG8_LDA(dst, b, h) do { _Pragma("unroll") for (int m = 0; m < 4; ++m) _Pragma("unroll") for (int k = 0; k < 2; ++k) dst[m][k] = *(const PG8_LAS bf16x8*)(lds + PG8_SA(b, h) + aoff + m * 2048 + k * 1024); } while (0)
#define PG8_LDB(dst, b, h) do { _Pragma("unroll") for (int n = 0; n < 2; ++n) _Pragma("unroll") for (int k = 0; k < 2; ++k) dst[n][k] = *(const PG8_LAS bf16x8*)(lds + PG8_SB(b, h) + boff + n * 2048 + k * 1024); } while (0)
#define PG8_MMA(ai, bj, At, Bt) do { __builtin_amdgcn_s_setprio(1); _Pragma("unroll") for (int m = 0; m < 4; ++m) _Pragma("unroll") for (int n = 0; n < 2; ++n) _Pragma("unroll") for (int k = 0; k < 2; ++k) \
        acc[ai][bj][m][n] = __builtin_amdgcn_mfma_f32_16x16x32_bf16(Bt[n][k], At[m][k], acc[ai][bj][m][n], 0, 0, 0); __builtin_amdgcn_s_setprio(0); } while (0)
#define PG8_WAIT_V(n) asm volatile("s_waitcnt vmcnt(" #n ")" ::: "memory")
#define PG8_WAIT_L(n) asm volatile("s_waitcnt lgkmcnt(" #n ")" ::: "memory")
#define PG8_BAR __builtin_amdgcn_s_barrier()
#define PG8_SCHED __builtin_amdgcn_sched_barrier(0)
    Unit cur, nxt; int ui = 0;
    if (!S.next(0, cur)) return;
    f32x4 acc[2][2][4][2];
#pragma unroll
    for (int a = 0; a < 2; ++a)
#pragma unroll
        for (int b = 0; b < 2; ++b)
#pragma unroll
            for (int m = 0; m < 4; ++m)
#pragma unroll
                for (int n = 0; n < 2; ++n) acc[a][b][m][n] = (f32x4){0.f, 0.f, 0.f, 0.f};
    bf16x8 At[4][2], B0[2][2], B1[2][2];
    const char* cA = (const char*)g.A + (size_t)cur.pm * tstep; const char* cB = (const char*)g.Bt + (size_t)cur.pn * tstep;
    S.a_ready(cur);
    if constexpr (SP2) {
        PG8_STAGE(PG8_SB(0, 0), cB, voffB); PG8_STAGE(PG8_SB(0, 1), cB + hstep, voffB); PG8_STAGE(PG8_SA(0, 0), cA, voffA); PG8_STAGE(PG8_SA(0, 1), cA + hstep, voffA);
        if (wr == 1) PG8_BAR;
        PG8_WAIT_V(2); PG8_BAR;
        PG8_STAGE(PG8_SB(1, 0), cB + kstep, voffB); PG8_STAGE(PG8_SA(1, 0), cA + kstep, voffA); PG8_STAGE(PG8_SB(1, 1), cB + hstep + kstep, voffB);
        PG8_WAIT_V(6); PG8_BAR;
    } else {
        PG8_STAGE(PG8_SB(0, 0), cB, voffB); PG8_STAGE(PG8_SA(0, 0), cA, voffA); PG8_STAGE(PG8_SB(0, 1), cB + hstep, voffB); PG8_STAGE(PG8_SA(0, 1), cA + hstep, voffA);
        if (wr == 1) PG8_BAR;
        PG8_WAIT_V(4); PG8_BAR;
        PG8_STAGE(PG8_SB(1, 0), cB + kstep, voffB); PG8_STAGE(PG8_SA(1, 0), cA + kstep, voffA); PG8_STAGE(PG8_SB(1, 1), cB + hstep + kstep, voffB);
        PG8_WAIT_V(6); PG8_BAR;
    }
    for (;;) {
        const bool has_next = S.next(ui + 1, nxt);
        const char* nA = has_next ? (const char*)g.A + (size_t)nxt.pm * tstep : cA; const char* nB = has_next ? (const char*)g.Bt + (size_t)nxt.pn * tstep : cB;
        for (int t = 0; t < nt; t += 2) {
            const bool last = (t == nt - 2);
            const char* a1 = cA + (size_t)(t + 1) * kstep;
            const char* a2 = last ? nA : cA + (size_t)(t + 2) * kstep; const char* b2 = last ? nB : cB + (size_t)(t + 2) * kstep;
            const char* a3 = a2 + kstep; const char* b3 = b2 + kstep;
            if (last && has_next) S.a_ready(nxt);
            if constexpr (SP2) {
            PG8_LDB(B0, 0, 0); PG8_LDB(B1, 0, 1); PG8_SCHED; PG8_LDA(At, 0, 0); PG8_STAGE(PG8_SA(1, 1), a1 + hstep, voffA);
            PG8_WAIT_V(8); PG8_WAIT_L(0); PG8_BAR; PG8_MMA(0, 0, At, B0); PG8_MMA(0, 1, At, B1); PG8_BAR; PG8_SCHED;
            PG8_LDA(At, 0, 1); PG8_STAGE(PG8_SB(0, 0), b2, voffB); PG8_STAGE(PG8_SB(0, 1), b2 + hstep, voffB); PG8_STAGE(PG8_SA(0, 0), a2, voffA);
            PG8_WAIT_V(8); PG8_WAIT_L(0); PG8_BAR; PG8_MMA(1, 0, At, B0); PG8_MMA(1, 1, At, B1); PG8_BAR; PG8_SCHED;
            PG8_LDB(B0, 1, 0); PG8_LDB(B1, 1, 1); PG8_SCHED; PG8_LDA(At, 1, 0); PG8_STAGE(PG8_SA(0, 1), a2 + hstep, voffA);
            PG8_WAIT_V(8); PG8_WAIT_L(0); PG8_BAR; PG8_MMA(0, 0, At, B0); PG8_MMA(0, 1, At, B1); PG8_BAR; PG8_SCHED;
            PG8_LDA(At, 1, 1); PG8_STAGE(PG8_SB(1, 0), b3, voffB); PG8_STAGE(PG8_SB(1, 1), b3 + hstep, voffB); PG8_STAGE(PG8_SA(1, 0), a3, voffA);
            PG8_WAIT_V(8); PG8_WAIT_L(0); PG8_BAR; PG8_MMA(1, 0, At, B0); PG8_MMA(1, 1, At, B1); PG8_BAR; PG8_SCHED;
            } else {
            PG8_LDB(B0, 0, 0); PG8_SCHED; PG8_LDA(At, 0, 0); PG8_STAGE(PG8_SA(1, 1), a1 + hstep, voffA);
            PG8_WAIT_L(8); PG8_BAR; PG8_WAIT_L(0); PG8_MMA(0, 0, At, B0); PG8_BAR; PG8_SCHED;
            PG8_LDB(B1, 0, 1); PG8_STAGE(PG8_SB(0, 0), b2, voffB);
            PG8_BAR; PG8_WAIT_L(0); PG8_MMA(0, 1, At, B1); PG8_BAR;
            PG8_LDA(At, 0, 1); PG8_STAGE(PG8_SA(0, 0), a2, voffA);
            PG8_BAR; PG8_WAIT_L(0); PG8_MMA(1, 0, At, B0); PG8_BAR; PG8_SCHED;
            PG8_STAGE(PG8_SB(0, 1), b2 + hstep, voffB);
            PG8_WAIT_V(6); PG8_BAR; PG8_MMA(1, 1, At, B1); PG8_BAR;
            PG8_LDB(B0, 1, 0); PG8_SCHED; PG8_LDA(At, 1, 0); PG8_STAGE(PG8_SA(0, 1), a2 + hstep, voffA);
            PG8_WAIT_L(8); PG8_BAR; PG8_WAIT_L(0); PG8_MMA(0, 0, At, B0); PG8_BAR; PG8_SCHED;
            PG8_LDB(B1, 1, 1); PG8_STAGE(PG8_SB(1, 0), b3, voffB);
            PG8_BAR; PG8_WAIT_L(0); PG8_MMA(0, 1, At, B1); PG8_BAR;
            PG8_LDA(At, 1, 1); PG8_STAGE(PG8_SA(1, 0), a3, voffA);
            PG8_BAR; PG8_WAIT_L(0); PG8_MMA(1, 0, At, B0); PG8_BAR; PG8_SCHED;
            PG8_STAGE(PG8_SB(1, 1), b3 + hstep, voffB);
            PG8_WAIT_V(6); PG8_BAR; PG8_MMA(1, 1, At, B1); PG8_BAR;
            }
        }
        if constexpr (ALIGN_EPI) { if (wr == 0) PG8_BAR; }
        if constexpr (!Epi::AFTER_DRAIN) { E(acc, cur, wr, wc, fr, fq); S.done(cur); }
        if (!has_next) break;
#pragma unroll
        for (int a = 0; a < 2; ++a)
#pragma unroll
            for (int b = 0; b < 2; ++b)
#pragma unroll
                for (int m = 0; m < 4; ++m)
#pragma unroll
                    for (int n = 0; n < 2; ++n) acc[a][b][m][n] = (f32x4){0.f, 0.f, 0.f, 0.f};
        cur = nxt; cA = nA; cB = nB; ++ui;
        if constexpr (ALIGN_EPI) { if (wr == 1) PG8_BAR; }
    }
    PG8_WAIT_V(0);
    if constexpr (!ALIGN_EPI) { if (wr == 0) PG8_BAR; }
    PG8_BAR;
    if constexpr (Epi::AFTER_DRAIN) { E.fused(acc, cur, wr, wc, fr, fq, lds, wid, lane); S.done(cur); }
#undef PG8_SA
#undef PG8_SB
#undef PG8_STAGE
#undef PG8_LDA
#undef PG8_LDB
#undef PG8_MMA
#undef PG8_WAIT_V
#undef PG8_WAIT_L
#undef PG8_BAR
#undef PG8_SCHED
}
}
#include <hip/hip_bf16.h>
#include <cmath>
namespace attn_body {
using bf16=__hip_bfloat16;
using bf16x8=__attribute__((ext_vector_type(8)))short;
using s16x4=__attribute__((ext_vector_type(4)))short;
using f32x16=__attribute__((ext_vector_type(16)))float;
using u32x4=__attribute__((ext_vector_type(4)))unsigned;
constexpr int BATCH=8,NHEAD=16,SEQ=2048,D=64,DM=NHEAD*D;
constexpr int NW=8,QBLK=32,QB=QBLK*NW,KVBLK=64,NQB=SEQ/QB;
constexpr int ATTN_PITCH=DM, ATTN_UNIT_ROWS=QB;
__device__ __forceinline__ int crow(int r,int hi){return (r&3)+8*(r>>2)+4*hi;}
#define SBAR() __builtin_amdgcn_sched_barrier(0)
__device__ __forceinline__ void cmask(f32x16&p0,f32x16&p1,int jb,int qrel,int hi){
  const float NEG=-INFINITY; int d=qrel-(64*jb+4*hi); asm volatile("":"+v"(d));
  #pragma unroll
  for(int r=0;r<16;++r){const int c=(r&3)+8*(r>>2); if(c>d)p0[r]=NEG; if(c+32>d)p1[r]=NEG;}
}

constexpr int NSLOT=3, SLOTB=8192;
constexpr int LDS_K=0, LDS_V=NSLOT*SLOTB, LDS_WS=2*NSLOT*SLOTB, LDS_OST=LDS_WS+NW*64*4, LDS_FS=LDS_OST+NW*4096, LDS_SCAN=LDS_FS+SEQ*4, LDS_BYTES=LDS_SCAN+256; typedef float f32x4v __attribute__((ext_vector_type(4)));
constexpr float C2=0.125f*1.4426950408889634f;
__device__ __forceinline__ void glds16(const void*gsrc,unsigned lds_dst){unsigned keep;
  asm volatile("s_mov_b32 %0, m0\n\ts_mov_b32 m0, %2\n\ts_nop 0\n\tglobal_load_lds_dwordx4 %1, off\n\ts_mov_b32 m0, %0":"=&s"(keep):"v"(gsrc),"s"(lds_dst):"memory");}
__device__ __forceinline__ float max3f(float a,float b,float c){float r;asm("v_max3_f32 %0, %1, %2, %3":"=v"(r):"v"(a),"v"(b),"v"(c));return r;}
__device__ __forceinline__ float max2f(float a,float b){float r;asm("v_max_f32_e32 %0, %1, %2":"=v"(r):"v"(a),"v"(b));return r;}
__device__ __forceinline__ float fadd_s(float a,float b){float r;asm("v_add_f32_e32 %0, %1, %2":"=v"(r):"v"(a),"v"(b));return r;}
__device__ __forceinline__ float fsub_s(float a,float b){float r;asm("v_sub_f32_e32 %0, %1, %2":"=v"(r):"v"(a),"v"(b));return r;}
typedef float f32x2_t __attribute__((ext_vector_type(2))); typedef __bf16 bf16x2_t __attribute__((ext_vector_type(2)));
__device__ __forceinline__ unsigned cvtpk_s(float lo,float hi){f32x2_t v={lo,hi};bf16x2_t b=__builtin_convertvector(v,bf16x2_t);return __builtin_bit_cast(unsigned,b);}
#define WAIT_BAR(N) asm volatile("s_waitcnt vmcnt(" #N ") lgkmcnt(0)\n\ts_barrier":::"memory")

__device__ __forceinline__ void qkt(f32x16&p0,f32x16&p1,const char*Kslot,const bf16x8*qr,int r32,int hi){
  const char*kb=Kslot+hi*1024+r32*16;
  #pragma unroll
  for(int d0=0;d0<4;++d0){
    const bf16x8 b0=*reinterpret_cast<const bf16x8*>(kb+d0*2048);
    const bf16x8 b1=*reinterpret_cast<const bf16x8*>(kb+d0*2048+512);
    p0=__builtin_amdgcn_mfma_f32_32x32x16_bf16(b0,qr[d0],p0,0,0,0);p1=__builtin_amdgcn_mfma_f32_32x32x16_bf16(b1,qr[d0],p1,0,0,0);}
}
typedef __attribute__((address_space(3))) const char* lds_cptr;
typedef short v4i16_t __attribute__((ext_vector_type(4)));
__device__ __forceinline__ void kload8(bf16x8*kf,lds_cptr kp){
  kf[0]=*(const __attribute__((address_space(3))) bf16x8*)(kp);      kf[1]=*(const __attribute__((address_space(3))) bf16x8*)(kp+512);
  kf[2]=*(const __attribute__((address_space(3))) bf16x8*)(kp+2048); kf[3]=*(const __attribute__((address_space(3))) bf16x8*)(kp+2560);
  kf[4]=*(const __attribute__((address_space(3))) bf16x8*)(kp+4096); kf[5]=*(const __attribute__((address_space(3))) bf16x8*)(kp+4608);
  kf[6]=*(const __attribute__((address_space(3))) bf16x8*)(kp+6144); kf[7]=*(const __attribute__((address_space(3))) bf16x8*)(kp+6656);
}
__device__ __forceinline__ void kload2(bf16x8*kf,lds_cptr kp,int j){ kf[2*j]=*(const __attribute__((address_space(3))) bf16x8*)(kp+j*2048); kf[2*j+1]=*(const __attribute__((address_space(3))) bf16x8*)(kp+j*2048+512); }
__device__ __forceinline__ s16x4 vtr(lds_cptr p){ return __builtin_bit_cast(s16x4,__builtin_amdgcn_ds_read_tr16_b64_v4i16((__attribute__((address_space(3))) v4i16_t*)p)); }
__device__ __forceinline__ float rowmax(const f32x16&p0,const f32x16&p1){
  float a=max3f(p0[0],p0[1],p1[0]),b=max3f(p0[2],p0[3],p1[1]);a=max3f(a,p1[2],p1[3]);
  #pragma unroll
  for(int r=4;r<16;r+=4){a=max3f(a,p0[r],p0[r+1]);b=max3f(b,p0[r+2],p0[r+3]);a=max3f(a,p1[r],p1[r+1]);b=max3f(b,p1[r+2],p1[r+3]);}
  const float m=max2f(a,b);
  auto rr=__builtin_amdgcn_permlane32_swap(__float_as_uint(m),__float_as_uint(m),false,false);
  return max2f(__uint_as_float(rr[0]),__uint_as_float(rr[1]));
}
__device__ __forceinline__ void pv(f32x16*o,int vb,bf16x8 pa0,bf16x8 pa1,bf16x8 pa2,bf16x8 pa3){
  #pragma unroll
  for(int d0=0;d0<2;++d0){s16x4 lo[4],hi[4];
    #pragma unroll
    for(int ks=0;ks<4;++ks){
      asm volatile("ds_read_b64_tr_b16 %0,%1 offset:%c2":"=&v"(lo[ks]):"v"(vb),"i"(d0*4096+ks*1024):"memory");
      asm volatile("ds_read_b64_tr_b16 %0,%1 offset:%c2":"=&v"(hi[ks]):"v"(vb),"i"(d0*4096+ks*1024+512):"memory");}
    asm volatile("s_waitcnt lgkmcnt(0)":::"memory");SBAR();
    #define PK(k) (bf16x8){lo[k][0],lo[k][1],lo[k][2],lo[k][3],hi[k][0],hi[k][1],hi[k][2],hi[k][3]}
    o[d0]=__builtin_amdgcn_mfma_f32_32x32x16_bf16(pa0,PK(0),o[d0],0,0,0);
    o[d0]=__builtin_amdgcn_mfma_f32_32x32x16_bf16(pa1,PK(1),o[d0],0,0,0);
    o[d0]=__builtin_amdgcn_mfma_f32_32x32x16_bf16(pa2,PK(2),o[d0],0,0,0);
    o[d0]=__builtin_amdgcn_mfma_f32_32x32x16_bf16(pa3,PK(3),o[d0],0,0,0);
    #undef PK
  }
}

#ifndef ATTN_STORE16
#define ATTN_STORE16(p,v) (*(u32x4*)(p)=(v))
#endif
template<int THRL> __device__ __forceinline__ void attn_unit(int b,int h,int qb,const bf16*Q,const bf16*__restrict__ K,const bf16*__restrict__ V,bf16*O,const bf16*__restrict__ SZ,char*shm,float skip_thr){
  int tid_=threadIdx.x; asm volatile("":"+v"(tid_)); const int tid=tid_,lane=tid&63,r32=lane&31,hi=lane>>5; const int wid=__builtin_amdgcn_readfirstlane(tid>>6);
  const long rowbase=(long)b*SEQ; const int q0=qb*QB;
  const bf16*Qw=Q+(rowbase+q0+wid*QBLK)*DM+h*D;
  const __attribute__((address_space(3))) float* Fs3=(const __attribute__((address_space(3))) float*)((lds_cptr)shm+LDS_FS);
  int t0s;
  { const int NT0=(q0+QB)/KVBLK; const int tl=lane&31; const float fq0=Fs3[q0];
    const bool sk=(tl<NT0)&&(fq0-Fs3[64*tl+63]<-skip_thr);
    const unsigned long long mb=__ballot(sk);
    int cnt=__popcll(mb&0xffffffffull); cnt=__builtin_amdgcn_readfirstlane(cnt)&~1; t0s=cnt<NT0-4?cnt:NT0-4; }
  const __attribute__((address_space(3))) float* FsK=Fs3+64*t0s;
  const bf16*Kh=K+(rowbase+64*t0s)*DM+h*D,*Vh=V+(rowbase+64*t0s)*DM+h*D;
  const unsigned lds0=(unsigned)(uintptr_t)shm;
  float*wsf=(float*)(shm+LDS_WS)+wid*64;
  const bf16*ksrc=Kh+(long)lane*DM+wid*8;
  const bf16*vsrc=Vh+(long)(16*(wid&3)+(lane>>2))*DM+(wid>>2)*32+(lane&3)*8;
  const unsigned kdst=lds0+LDS_K+wid*1024, vdst=lds0+LDS_V+wid*1024;
  #define DMA_K(t,slot) glds16(ksrc+(long)(t)*KVBLK*DM,(unsigned)__builtin_amdgcn_readfirstlane(kdst+(slot)))
  #define DMA_V(t,slot) glds16(vsrc+(long)(t)*KVBLK*DM,(unsigned)__builtin_amdgcn_readfirstlane(vdst+(slot)))
  const int vb0=(int)(lds0+LDS_V)+((lane>>4)&1)*32+(lane&3)*8+(4*hi+((lane&15)>>2))*64;
  const char*Kbase=shm+LDS_K; bf16x8 kf[8];
  const lds_cptr shm3=(lds_cptr)shm; const lds_cptr kp0=shm3+LDS_K+hi*1024+r32*16; const lds_cptr vp0=shm3+LDS_V+((lane>>4)&1)*32+(lane&3)*8+(4*hi+((lane&15)>>2))*64;
  const int NT=(q0+QB)/KVBLK-t0s;
  DMA_K(0,0);DMA_V(0,0);DMA_K(1,SLOTB);
  bf16x8 qr[4];
  #pragma unroll
  for(int d0=0;d0<4;++d0)qr[d0]=*reinterpret_cast<const bf16x8*>(&Qw[(long)r32*DM+d0*16+hi*8]);
  float l_reg=0.f;f32x16 o[2];o[0]=f32x16{};o[1]=f32x16{};
  const int qrel=wid*QBLK+r32;
  float fqm=Fs3[q0+qrel];
  #define BLOAD(C0,C1,t) do{ const __attribute__((address_space(3))) f32x4v* fk_=(const __attribute__((address_space(3))) f32x4v*)(FsK+(t)*64+4*hi); \
    _Pragma("unroll") for(int i_=0;i_<4;++i_){ const f32x4v a_=fk_[2*i_], b_=fk_[2*i_+8]; \
      _Pragma("unroll") for(int k_=0;k_<4;++k_){ C0[4*i_+k_]=a_[k_]; C1[4*i_+k_]=b_[k_]; } } }while(0)
  #define BSUB(C0,C1) do{ _Pragma("unroll") for(int r_=0;r_<16;++r_){ C0[r_]=fqm-C0[r_]; C1[r_]=fqm-C1[r_]; } }while(0)
  #define BIAS(C0,C1,t) do{ const __attribute__((address_space(3))) f32x4v* fk_=(const __attribute__((address_space(3))) f32x4v*)(FsK+(t)*64+4*hi); \
    _Pragma("unroll") for(int i_=0;i_<4;++i_){ const f32x4v a_=fk_[2*i_], b_=fk_[2*i_+8]; \
      _Pragma("unroll") for(int k_=0;k_<4;++k_){ C0[4*i_+k_]=fqm-a_[k_]; C1[4*i_+k_]=fqm-b_[k_]; } } }while(0)
  #define CMASK(P0,P1,t) do{int jb_=(t)-(NT-4); if(jb_>=0)cmask(P0,P1,jb_,qrel,hi);}while(0)
  bool resc=false;
  #define START(P0,P1) do{ const float rm=rowmax(P0,P1); resc=false; \
    { const float dl=rm; fqm=fsub_s(fqm,dl); \
      _Pragma("unroll") for(int r=0;r<16;++r){P0[r]=fsub_s(P0[r],dl);P1[r]=fsub_s(P1[r],dl);} } \
    _Pragma("unroll") for(int r=0;r<16;++r)P0[r]=__builtin_amdgcn_exp2f(P0[r]); }while(0)
  #define RESC() do{ if(resc){ asm volatile("s_waitcnt lgkmcnt(0)":::"memory"); \
      _Pragma("unroll") for(int d_=0;d_<2;++d_) _Pragma("unroll") for(int r=0;r<16;++r)o[d_][r]*=wsf[crow(r,hi)]; } }while(0)
  f32x16 pA0,pA1,pB0,pB1;
  int sl_prev=0,sl_cur=0,sl_next=SLOTB;
  #define ROT() do{sl_prev=sl_cur;sl_cur=sl_next;sl_next=(sl_next==(NSLOT-1)*SLOTB)?0:sl_next+SLOTB;}while(0)
  DMA_K(2,2*SLOTB);
  WAIT_BAR(3);
  BIAS(pA0,pA1,0); qkt(pA0,pA1,Kbase,qr,r32,hi);asm volatile("s_nop 15\n\ts_nop 7":"+v"(pA0),"+v"(pA1));CMASK(pA0,pA1,0);
  START(pA0,pA1);
  _Pragma("unroll") for(int r=0;r<16;++r)pA1[r]=__builtin_amdgcn_exp2f(pA1[r]);
  WAIT_BAR(0);
  DMA_K(3,0);DMA_V(1,SLOTB);
  ROT();
  kload8(kf,kp0+sl_cur);
  WAIT_BAR(2);
  s16x4 vlo[8],vhi[8]; u32x4 pw0,pw1,pw2,pw3;
  #define PKW(P,B) cvtpk_s(P[B],P[B+1])
  #define PAF(k) __builtin_bit_cast(bf16x8,pw##k)
  #define VFR(i) (bf16x8){vlo[i][0],vlo[i][1],vlo[i][2],vlo[i][3],vhi[i][0],vhi[i][1],vhi[i][2],vhi[i][3]}
  #define PIN(x) asm volatile("":"+v"(x))
  #define MX3(a,b,c) __builtin_fmaxf(__builtin_fmaxf((a),(b)),(c))
  #define GAPA(MF,A0,A1,A2,A3,W0,W1,PW) do{ MF; sacc+=A0; sacc+=A1; sacc+=A2; sacc+=A3; PIN(sacc); W0; W1; PIN(PW); SBAR(); }while(0)
  #define EX(v) __builtin_amdgcn_exp2f(v)
  #define GAPB(MF,X,B) do{ MF; X[B]=EX(X[B]); X[B+1]=EX(X[B+1]); X[B+2]=EX(X[B+2]); X[B+3]=EX(X[B+3]); PIN(X); SBAR(); }while(0)
  #define VRD(i) do{ vlo[i]=vtr(vp_+(((i)>>2)*4096+((i)&3)*1024)); vhi[i]=vtr(vp_+(((i)>>2)*4096+((i)&3)*1024+512)); }while(0)
  #define KRD(G,j) do{ if(G){ kload2(kf,kp0+sl_next,j); SBAR(); } }while(0)
  #define STEP(C0,C1,P0,P1,t,GK,GV,GL) do{ SBAR(); BSUB(C0,C1); SBAR(); \
    const lds_cptr vp_=vp0+sl_prev; \
    VRD(0); SBAR(); float sacc=(P0[0]+P0[1]); \
    GAPA(C0=__builtin_amdgcn_mfma_f32_32x32x16_bf16(kf[0],qr[0],C0,0,0,0), P0[2],P0[3],P0[4],P0[5],     pw0[0]=PKW(P0,0), pw0[1]=PKW(P0,2), pw0); \
    VRD(4); SBAR(); GAPA(C1=__builtin_amdgcn_mfma_f32_32x32x16_bf16(kf[1],qr[0],C1,0,0,0), P0[6],P0[7],P0[8],P0[9],     pw0[2]=PKW(P0,4), pw0[3]=PKW(P0,6), pw0); \
    VRD(1); SBAR(); GAPA(C0=__builtin_amdgcn_mfma_f32_32x32x16_bf16(kf[2],qr[1],C0,0,0,0),   P0[10],P0[11],P0[12],P0[13], pw1[0]=PKW(P0,8), pw1[1]=PKW(P0,10), pw1); \
    VRD(5); SBAR(); GAPA(C1=__builtin_amdgcn_mfma_f32_32x32x16_bf16(kf[3],qr[1],C1,0,0,0),   P0[14],P0[15],P1[0],P1[1],   pw1[2]=PKW(P0,12),pw1[3]=PKW(P0,14), pw1); \
    VRD(2); SBAR(); GAPA(C0=__builtin_amdgcn_mfma_f32_32x32x16_bf16(kf[4],qr[2],C0,0,0,0),   P1[2],P1[3],P1[4],P1[5],     pw2[0]=PKW(P1,0), pw2[1]=PKW(P1,2), pw2); \
    VRD(6); SBAR(); GAPA(C1=__builtin_amdgcn_mfma_f32_32x32x16_bf16(kf[5],qr[2],C1,0,0,0),   P1[6],P1[7],P1[8],P1[9],     pw2[2]=PKW(P1,4), pw2[3]=PKW(P1,6), pw2); \
    VRD(3); SBAR(); GAPA(C0=__builtin_amdgcn_mfma_f32_32x32x16_bf16(kf[6],qr[3],C0,0,0,0),   P1[10],P1[11],P1[12],P1[13], pw3[0]=PKW(P1,8), pw3[1]=PKW(P1,10), pw3); \
    VRD(7); SBAR(); GAPA(C1=__builtin_amdgcn_mfma_f32_32x32x16_bf16(kf[7],qr[3],C1,0,0,0),   P1[14],P1[15],0.f,0.f,       pw3[2]=PKW(P1,12),pw3[3]=PKW(P1,14), pw3); \
    l_reg+=sacc; \
    if(GK){DMA_K((t)+3,sl_cur);} if(GV){DMA_V((t)+1,sl_next);} \
    CMASK(C0,C1,t); \
    { float a=MX3(C0[0],C0[1],C1[0]),b=MX3(C0[2],C0[3],C1[1]); a=MX3(a,C1[2],C1[3]); \
      _Pragma("unroll") for(int r=4;r<16;r+=4){a=MX3(a,C0[r],C0[r+1]);b=MX3(b,C0[r+2],C0[r+3]);a=MX3(a,C1[r],C1[r+1]);b=MX3(b,C1[r+2],C1[r+3]);} \
      float rm=__builtin_fmaxf(a,b); { auto rr=__builtin_amdgcn_permlane32_swap(__float_as_uint(rm),__float_as_uint(rm),false,false); rm=__builtin_fmaxf(__uint_as_float(rr[0]),__uint_as_float(rr[1])); } \
      resc=false; \
      if(__builtin_expect(__any(rm>(float)THRL),0)){ const float dl=__builtin_fmaxf(rm,0.f); fqm-=dl; \
        _Pragma("unroll") for(int r=0;r<16;++r){C0[r]-=dl;C1[r]-=dl;} \
        const float f=__builtin_amdgcn_exp2f(-dl); l_reg*=f; if(hi==0)wsf[r32]=f; resc=true; } } \
    SBAR(); BLOAD(P0,P1,(t)+1); SBAR(); \
    GAPB(o[0]=__builtin_amdgcn_mfma_f32_32x32x16_bf16(PAF(0),VFR(0),o[0],0,0,0), C0,0); \
    GAPB(o[1]=__builtin_amdgcn_mfma_f32_32x32x16_bf16(PAF(0),VFR(4),o[1],0,0,0), C0,4); \
    KRD(GL,0); GAPB(o[0]=__builtin_amdgcn_mfma_f32_32x32x16_bf16(PAF(1),VFR(1),o[0],0,0,0), C0,8); \
    KRD(GL,1); GAPB(o[1]=__builtin_amdgcn_mfma_f32_32x32x16_bf16(PAF(1),VFR(5),o[1],0,0,0), C0,12); \
    KRD(GL,2); GAPB(o[0]=__builtin_amdgcn_mfma_f32_32x32x16_bf16(PAF(2),VFR(2),o[0],0,0,0), C1,0); \
    KRD(GL,3); GAPB(o[1]=__builtin_amdgcn_mfma_f32_32x32x16_bf16(PAF(2),VFR(6),o[1],0,0,0), C1,4); \
    GAPB(o[0]=__builtin_amdgcn_mfma_f32_32x32x16_bf16(PAF(3),VFR(3),o[0],0,0,0), C1,8); \
    GAPB(o[1]=__builtin_amdgcn_mfma_f32_32x32x16_bf16(PAF(3),VFR(7),o[1],0,0,0), C1,12); \
    }while(0)
  BLOAD(pB0,pB1,1);
  int t=1;
  #undef CMASK
  #define CMASK(P0,P1,t) do{}while(0)
  for(;t+5<NT;t+=2){
    STEP(pB0,pB1,pA0,pA1,t,true,true,true);     WAIT_BAR(2); RESC(); ROT();
    STEP(pA0,pA1,pB0,pB1,t+1,true,true,true);   WAIT_BAR(2); RESC(); ROT();
  }
  #undef CMASK
  #define CMASK(P0,P1,t) do{int jb_=(t)-(NT-4); if(jb_>=0)cmask(P0,P1,jb_,qrel,hi);}while(0)
  #define ENDW(tt) do{ if((tt)+3<NT){WAIT_BAR(2);} else if((tt)+2<NT){WAIT_BAR(1);} else {WAIT_BAR(0);} }while(0)
  for(;t+1<NT;t+=2){
    STEP(pB0,pB1,pA0,pA1,t,(t+3<NT),(t+1<NT),(t+1<NT));       ENDW(t);   RESC(); ROT();
    STEP(pA0,pA1,pB0,pB1,t+1,(t+4<NT),(t+2<NT),(t+2<NT));     ENDW(t+1); RESC(); ROT();
  }
  STEP(pB0,pB1,pA0,pA1,NT-1,false,false,false); RESC();
  { float sacc=pB0[0]+pB0[1]; _Pragma("unroll") for(int r=2;r<16;++r)sacc+=pB0[r]; _Pragma("unroll") for(int r=0;r<16;++r)sacc+=pB1[r]; l_reg+=sacc;
    pw0=(u32x4){PKW(pB0,0),PKW(pB0,2),PKW(pB0,4),PKW(pB0,6)};pw1=(u32x4){PKW(pB0,8),PKW(pB0,10),PKW(pB0,12),PKW(pB0,14)};pw2=(u32x4){PKW(pB1,0),PKW(pB1,2),PKW(pB1,4),PKW(pB1,6)};pw3=(u32x4){PKW(pB1,8),PKW(pB1,10),PKW(pB1,12),PKW(pB1,14)};
    SBAR(); pv(o,vb0+sl_cur,PAF(0),PAF(1),PAF(2),PAF(3)); }
  #undef PKW
  #undef PAF
  #undef VFR
  #undef PIN
  #undef MX3
  #undef GAPA
  #undef GAPB
  #undef EX
  #undef VRD
  #undef KRD
  #undef STEP
  #undef ENDW
  {auto rr=__builtin_amdgcn_permlane32_swap(__float_as_uint(l_reg),__float_as_uint(l_reg),false,false);l_reg=__uint_as_float(rr[0])+__uint_as_float(rr[1]);}
  if(hi==0)wsf[32+r32]=l_reg;asm volatile("s_waitcnt lgkmcnt(0)":::"memory");
  float rli[16];
  #pragma unroll
  for(int r=0;r<16;++r)rli[r]=__builtin_amdgcn_rcpf(wsf[32+crow(r,hi)]);
  bf16*Ow=O+(rowbase+q0+wid*QBLK)*DM+h*D;
  { bf16*stg=(bf16*)(shm+LDS_OST)+wid*2048;
    #pragma unroll
    for(int r=0;r<16;++r){const int orow=crow(r,hi);
      #pragma unroll
      for(int d0=0;d0<2;++d0)stg[orow*64+d0*32+r32]=__float2bfloat16(o[d0][r]*rli[r]);}
    asm volatile("s_waitcnt lgkmcnt(0)":::"memory");
    const bf16*SZw=SZ+(rowbase+q0+wid*QBLK)*DM+h*D;
    #pragma unroll
    for(int i=0;i<4;++i){const int row=i*8+(lane>>3),ch=lane&7; const u32x4 v=*(const u32x4*)(stg+row*64+ch*8); const u32x4 g=*(const u32x4*)(SZw+(long)row*DM+ch*8); u32x4 w;
      #pragma unroll
      for(int k=0;k<4;++k){ const float a0=__uint_as_float(v[k]<<16)*__uint_as_float(g[k]<<16), a1=__uint_as_float(v[k]&0xffff0000u)*__uint_as_float(g[k]&0xffff0000u); w[k]=cvtpk_s(a0,a1); }
      ATTN_STORE16(Ow+(long)row*DM+ch*8,w);} }
  asm volatile("s_waitcnt lgkmcnt(0)\n\ts_barrier":::"memory");
  #undef DMA_K
  #undef DMA_V
  #undef CMASK
  #undef START
  #undef RESC
  #undef ROT
  #undef BIAS
}
constexpr int ATTN_LDS_BYTES=LDS_BYTES;
struct AttnTensors { const bf16* Q; const bf16* K; const bf16* V; bf16* O; const bf16* SZ; const float* LF; const float* gq; const float* gk; };
template<int THRL=8> __device__ __forceinline__ void attn_phase(char*lds,const AttnTensors&T,int vcu,int G){
  float skip_thr;
  { const int l0=threadIdx.x&63; float mq=fabsf(T.gq[l0]),mk=fabsf(T.gk[l0]);
    #pragma unroll
    for(int o_=1;o_<64;o_<<=1){mq=fmaxf(mq,__shfl_xor(mq,o_));mk=fmaxf(mk,__shfl_xor(mk,o_));}
    skip_thr=2.0f*(64.0f*mq*mk*C2)+32.0f; }
  #pragma unroll 1
  for(int task=vcu;task<BATCH*NHEAD*2;task+=G){
    const int b=task>>5,rr=task&31,s=rr&1,hb=rr>>1;
    #pragma unroll 1
    for(int i=0;i<4;++i){ const int qb=(i==0)?7-s:(i==1)?s:(i==2)?4+s:3-s; const int h=(hb+4*i)&15;
      { int tid=threadIdx.x; asm volatile("":"+v"(tid)); const int lane=tid&63,wid=tid>>6;
        __attribute__((address_space(3))) float* Fs=(__attribute__((address_space(3))) float*)((lds_cptr)lds+LDS_FS);
        __attribute__((address_space(3))) float* WT=(__attribute__((address_space(3))) float*)((lds_cptr)lds+LDS_SCAN);
        const f32x4v lf4=*(const f32x4v*)(T.LF+((long)(b*NHEAD+h)*SEQ+4*tid));
        const float v0=lf4[0],v1=lf4[1],v2=lf4[2],v3=lf4[3];
        const float p1=v0+v1,p2=p1+v2,p3=p2+v3; float x=p3;
        #pragma unroll
        for(int off=1;off<64;off<<=1){const float y=__shfl_up(x,off); if(lane>=off)x+=y;}
        if(lane==63)WT[wid]=x;
        __syncthreads();
        float offs=0.f;
        #pragma unroll
        for(int w=0;w<NW;++w){const float tv=WT[w]; if(w<wid)offs+=tv;}
        const float ex=x-p3+offs; const float L2E=1.4426950408889634f;
        f32x4v o4; o4[0]=(ex+v0)*L2E; o4[1]=(ex+p1)*L2E; o4[2]=(ex+p2)*L2E; o4[3]=(ex+p3)*L2E;
        *(__attribute__((address_space(3))) f32x4v*)(Fs+4*tid)=o4;
        __syncthreads(); }
      attn_unit<THRL>(b,h,qb,T.Q,T.K,T.V,T.O,T.SZ,lds,skip_thr); }
  }
}
#undef SBAR
#undef WAIT_BAR
}
#define GAS __attribute__((address_space(1)))
#define LAS __attribute__((address_space(3)))
typedef unsigned short bf16u;
typedef unsigned v4u __attribute__((ext_vector_type(4)));
typedef float f32x4 __attribute__((ext_vector_type(4)));
typedef float f32x16 __attribute__((ext_vector_type(16)));
typedef short bf16x8 __attribute__((ext_vector_type(8)));
#define LDS_WAIT() asm volatile("s_waitcnt lgkmcnt(0)" ::: "memory")

constexpr int NWAVES = 8;
constexpr int BATCH = 8, SEQ = 2048, D = 1024, M = BATCH * SEQ, NG = 64, NST = 64, NH = 16;
constexpr float EPS = 1e-6f;
constexpr float C2 = 0.125f * 1.4426950408889634f;

constexpr size_t MiB = 1u << 20;
constexpr size_t WS_W_IN_A = 0 * MiB, WS_W_GLU = 4 * MiB, WS_W_OUT_A = 6 * MiB, WS_W_KV = 8 * MiB, WS_W_IN_B = 12 * MiB, WS_W_OUT_B = 16 * MiB;
constexpr size_t WS_W_F = 18 * MiB;
constexpr size_t WS_MODP = 220 * MiB;
constexpr size_t WS_GATE = 21 * MiB;
constexpr size_t WS_ABAR = 21 * MiB + 128 * 1024, WS_AL = WS_ABAR + 32 * 1024, WS_BFRAG = WS_AL + 32 * 1024, WS_CFRAG = WS_BFRAG + 256 * 1024;
constexpr size_t WS_CTL = 21 * MiB + 768 * 1024, CTL_ZERO_BYTES = 16384;
constexpr size_t WS_E = 22 * MiB;
constexpr size_t WS_UZ = 24 * MiB;
constexpr size_t WS_K = 24 * MiB, WS_V = 56 * MiB;
constexpr size_t WS_R2 = 88 * MiB;
constexpr size_t WS_R3 = 120 * MiB;
constexpr size_t WS_QO = 152 * MiB, WS_SZ = 184 * MiB;
constexpr size_t WS_LF = 216 * MiB;
constexpr size_t WS_GSV = 22 * MiB + 768 * 1024;
constexpr size_t WS_POW = 22 * MiB, WS_BBT = 23 * MiB;
constexpr size_t WS_T1 = 224 * MiB, WS_T2 = 228 * MiB, WS_T3 = 232 * MiB;
constexpr size_t WS_END = 240 * MiB;
constexpr int LDS_BYTES = 147456;

__device__ __forceinline__ unsigned f2bf(float f) { unsigned u = __builtin_bit_cast(unsigned, f); return (u + 0x7fffu + ((u >> 16) & 1u)) >> 16; }
__device__ __forceinline__ unsigned pk2(float lo, float hi) { return f2bf(lo) | (f2bf(hi) << 16); }
__device__ __forceinline__ float wave_sum(float v) {
#pragma unroll
    for (int o = 1; o < 64; o <<= 1) v += __shfl_xor(v, o);
    return v;
}
__host__ __device__ __forceinline__ int phys_row(int n) { const int q = n & 255; return (n - q) + 128 * ((q >> 5) & 1) + 32 * (q >> 6) + (q & 31); }

struct Args { const float* in[29]; float* out; unsigned char* ws; };

__device__ __forceinline__ void p0_transpose_item(const float* W, int ldw, int K, int N, bf16u* WT, LAS float* scr, int item, int lane) {
    const int nblk = N / 32, kb = item / nblk, nb = item % nblk, k0 = 64 * kb, n0 = 32 * nb;
    f32x4 tv[8];
#pragma unroll
    for (int i = 0; i < 8; ++i) tv[i] = __builtin_nontemporal_load((const f32x4*)(W + (size_t)(k0 + 8 * i + (lane >> 3)) * ldw + n0 + 4 * (lane & 7)));
#pragma unroll
    for (int i = 0; i < 8; ++i) { LAS float* d = scr + (8 * i + (lane >> 3)) * 33 + 4 * (lane & 7); d[0] = tv[i].x; d[1] = tv[i].y; d[2] = tv[i].z; d[3] = tv[i].w; }
    LDS_WAIT(); asm volatile("" ::: "memory");
    const int c = lane & 7; const int pr0 = phys_row(n0);
#pragma unroll
    for (int j = 0; j < 4; ++j) { const int n = (lane >> 3) + 8 * j; const LAS float* s = scr + (8 * c) * 33 + n;
        v4u o; o.x = pk2(s[0 * 33], s[1 * 33]); o.y = pk2(s[2 * 33], s[3 * 33]); o.z = pk2(s[4 * 33], s[5 * 33]); o.w = pk2(s[6 * 33], s[7 * 33]);
        *(v4u*)(WT + (size_t)(pr0 + n) * K + k0 + 8 * c) = o; }
    LDS_WAIT(); asm volatile("" ::: "memory");
}

__device__ __forceinline__ void sincos_d(double x, double& s, double& c) {
    const double kq = rint(x * 0.63661977236758134308), r = fma(-kq, 1.57079632679489661923, x) - kq * 6.123233995736766e-17, r2 = r * r;
    double sp = -7.6471637318198165e-13; sp = fma(sp, r2, 1.6059043836821613e-10); sp = fma(sp, r2, -2.5052108385441720e-08); sp = fma(sp, r2, 2.7557319223985893e-06);
    sp = fma(sp, r2, -1.9841269841269841e-04); sp = fma(sp, r2, 8.3333333333333332e-03); sp = fma(sp, r2, -1.6666666666666666e-01); sp = fma(sp * r2, r, r);
    double cp = 4.7794773323873853e-14; cp = fma(cp, r2, -1.1470745597729725e-11); cp = fma(cp, r2, 2.0876756987868100e-09); cp = fma(cp, r2, -2.7557319223985888e-07);
    cp = fma(cp, r2, 2.4801587301587302e-05); cp = fma(cp, r2, -1.3888888888888889e-03); cp = fma(cp, r2, 4.1666666666666664e-02); cp = fma(cp, r2, -0.5); cp = fma(cp, r2, 1.0);
    const int q = ((int)kq) & 3;
    s = (q == 0) ? sp : (q == 1) ? cp : (q == 2) ? -sp : -cp;
    c = (q == 0) ? cp : (q == 1) ? -sp : (q == 2) ? -cp : sp;
}

#define XB_TMO      128
#define XB_XCNT(j)  (256  + 64 * (j))
#define XB_XSUB(j)  (1280 + 64 * (j))
#define XB_XGEN(j)  (2304 + 64 * (j))
#define XB_TOP      3328
#define XB_TOPGEN   3392
#define XCD_BAR_WORDS 3456
#define XB_SPIN_CAP (1u << 18)

__device__ __forceinline__ unsigned xb_ld(unsigned* p)              { return __hip_atomic_load(p, __ATOMIC_RELAXED, __HIP_MEMORY_SCOPE_AGENT); }
__device__ __forceinline__ unsigned xb_add(unsigned* p, unsigned v) { return __hip_atomic_fetch_add(p, v, __ATOMIC_RELAXED, __HIP_MEMORY_SCOPE_AGENT); }
__device__ __forceinline__ unsigned xb_xcc_id() { return (unsigned)__builtin_amdgcn_s_getreg((3 << 11) | 20) & 0xFu; }
#define XB_SPIN(cond, bar) do { unsigned _sp = 0; while (cond) { __builtin_amdgcn_s_sleep(1); \
    if ((++_sp & 255u) == 0u) { if (xb_ld(&(bar)[XB_TMO])) break; if (_sp > XB_SPIN_CAP) { atomicAdd(&(bar)[XB_TMO], 1u); break; } } } } while (0)

struct XcdBarrier {
    unsigned* bar; unsigned x;
    volatile LAS unsigned* st;
};

__device__ __forceinline__ XcdBarrier xcd_barrier_post(unsigned* bar, volatile LAS unsigned* st) {
    XcdBarrier b; b.bar = bar; b.x = xb_xcc_id(); b.st = st;
    if (threadIdx.x == 0) st[2] = xb_add(&bar[XB_XCNT(b.x)], 1u);
    return b;
}
__device__ __forceinline__ void xcd_barrier_complete(unsigned* bar, unsigned x, unsigned& nloc, unsigned& nx) {
    const unsigned G = gridDim.x * gridDim.y * gridDim.z;
    unsigned sum, cnt, mine, sp = 0u;
    for (;;) {
        sum = 0u; cnt = 0u; mine = 0u;
#pragma unroll
        for (unsigned j = 0; j < 16; ++j) { const unsigned c = xb_ld(&bar[XB_XCNT(j)]); sum += c; cnt += (c > 0u) ? 1u : 0u; mine = (j == x) ? c : mine; }
        if (sum == G) break;
        __builtin_amdgcn_s_sleep(1);
        if ((++sp & 255u) == 0u) { if (xb_ld(&bar[XB_TMO])) break; if (sp > XB_SPIN_CAP) { atomicAdd(&bar[XB_TMO], 1u); break; } }
    }
    nloc = mine > 0u ? mine : 1u; nx = cnt > 0u ? cnt : 1u;
}

__device__ __forceinline__ void xcd_barrier(const XcdBarrier& b) {
    asm volatile("s_waitcnt vmcnt(0)" ::: "memory");
    __syncthreads();
    if (threadIdx.x == 0) {
        unsigned* bar = b.bar;
        __builtin_amdgcn_s_waitcnt(0);
        unsigned nloc = b.st[0], nx = b.st[1];
        if (nloc == 0u) { xcd_barrier_complete(bar, b.x, nloc, nx); b.st[0] = nloc; b.st[1] = nx; }
        const unsigned bidx = b.st[3]; b.st[3] = bidx + 1u;
        const unsigned old = xb_add(&bar[XB_XSUB(b.x)], 1u);
        const unsigned gen = old / nloc;
        if (old + 1u == (gen + 1u) * nloc) {
            __builtin_amdgcn_fence(__ATOMIC_RELEASE, "agent");
            asm volatile("s_waitcnt vmcnt(0)" ::: "memory");
            const unsigned og = xb_add(&bar[XB_TOP], 1u);
            const unsigned tg = og / nx;
            if (og + 1u == (tg + 1u) * nx) xb_add(&bar[XB_TOPGEN], 1u);
            else XB_SPIN(xb_ld(&bar[XB_TOPGEN]) == tg, bar);
            __builtin_amdgcn_fence(__ATOMIC_ACQUIRE, "agent");
            asm volatile("s_waitcnt vmcnt(0)" ::: "memory");
        } else {
            XB_SPIN(xb_ld(&bar[XB_TOPGEN]) == bidx, bar);
            __builtin_amdgcn_fence(__ATOMIC_ACQUIRE, "agent");
            asm volatile("s_waitcnt vmcnt(0)" ::: "memory");
        }
    }
    __syncthreads();
}

__device__ __forceinline__ void xcd_local_barrier(const XcdBarrier& b) {
    asm volatile("s_waitcnt vmcnt(0)" ::: "memory");
    __syncthreads();
    if (threadIdx.x == 0) {
        unsigned* bar = b.bar;
        __builtin_amdgcn_s_waitcnt(0);
        const unsigned nloc = b.st[0];
        const unsigned lidx = b.st[5]; b.st[5] = lidx + 1u;
        (void)xb_add(&bar[XB_XGEN(b.x)], 1u);
        const unsigned want = (lidx + 1u) * nloc;
        XB_SPIN(xb_ld(&bar[XB_XGEN(b.x)]) < want, bar);
        __builtin_amdgcn_fence(__ATOMIC_ACQUIRE, "agent");
        asm volatile("s_waitcnt vmcnt(0)" ::: "memory");
    }
    __syncthreads();
}
#define REP_LOOP(k) REP_LOOP_(REP_P##k)
#define REP_LOOP_(n) REP_LOOP__(n)
#define REP_LOOP__(n) REP_LOOP_##n
#define REP_LOOP_1
#define REP_LOOP_2 _Pragma("unroll 1") for (int rep_ = 0; rep_ < 2; ++rep_)
#define REP_LOOP_3 _Pragma("unroll 1") for (int rep_ = 0; rep_ < 3; ++rep_)
#ifndef REP_P0
#define REP_P0 1
#endif
#ifndef REP_P1
#define REP_P1 1
#endif
#ifndef REP_P2
#define REP_P2 1
#endif
#ifndef REP_P3
#define REP_P3 1
#endif
#ifndef REP_P4
#define REP_P4 1
#endif
#ifndef REP_P5
#define REP_P5 1
#endif
#ifndef REP_P6
#define REP_P6 1
#endif
#ifndef REP_P7
#define REP_P7 1
#endif
#ifndef PH_MASK
#define PH_MASK 0x3ff
#endif
__device__ __forceinline__ float sigm_f(float x) { return __builtin_amdgcn_rcpf(1.0f + __builtin_amdgcn_exp2f(-1.4426950408889634f * x)); }
__device__ __forceinline__ float gelu_tanh(float y) { const float t = 1.5957691216057308f * (y + 0.044715f * y * y * y); return y * sigm_f(t); }
__device__ __forceinline__ int crow16(int r, int hi) { return (r & 3) + 8 * (r >> 2) + 4 * hi; }

template <bool NT> __device__ __forceinline__ void norm_load(const float* X, int v, int wave, int lane, f32x4 (&x)[8][4]) {
#pragma unroll
    for (int i = 0; i < 8; ++i) { const f32x4* xr = (const f32x4*)(X + (size_t)(64 * v + wave + 8 * i) * D) + lane;
#pragma unroll
        for (int j = 0; j < 4; ++j) x[i][j] = NT ? __builtin_nontemporal_load(xr + 64 * j) : xr[64 * j]; }
}
template <int NOUT> __device__ __forceinline__ void norm_apply(const f32x4 (&x)[8][4], int v, int wave, int lane, const LAS float* GS0, const LAS float* SH0, bf16u* O0, const LAS float* GS1, const LAS float* SH1, bf16u* O1) {
    f32x4 gs0[4], sh0[4], gs1[4], sh1[4];
#pragma unroll
    for (int j = 0; j < 4; ++j) { gs0[j] = *(const LAS f32x4*)(GS0 + 256 * j + 4 * lane); sh0[j] = *(const LAS f32x4*)(SH0 + 256 * j + 4 * lane);
        if (NOUT == 2) { gs1[j] = *(const LAS f32x4*)(GS1 + 256 * j + 4 * lane); sh1[j] = *(const LAS f32x4*)(SH1 + 256 * j + 4 * lane); } }
#pragma unroll
    for (int i = 0; i < 8; ++i) { const size_t row = (size_t)(64 * v + wave + 8 * i);
        float s = 0.f;
#pragma unroll
        for (int j = 0; j < 4; ++j) s += (x[i][j].x * x[i][j].x + x[i][j].y * x[i][j].y) + (x[i][j].z * x[i][j].z + x[i][j].w * x[i][j].w);
        const float r = 1.0f / sqrtf(wave_sum(s) * (1.0f / D) + EPS);
        unsigned long long* o0 = (unsigned long long*)(O0 + row * D) + lane;
#pragma unroll
        for (int j = 0; j < 4; ++j) { const f32x4 h = x[i][j] * r * gs0[j] + sh0[j]; o0[64 * j] = (unsigned long long)pk2(h.x, h.y) | ((unsigned long long)pk2(h.z, h.w) << 32); }
        if (NOUT == 2) { unsigned long long* o1 = (unsigned long long*)(O1 + row * D) + lane;
#pragma unroll
            for (int j = 0; j < 4; ++j) { const f32x4 h = x[i][j] * r * gs1[j] + sh1[j]; o1[64 * j] = (unsigned long long)pk2(h.x, h.y) | ((unsigned long long)pk2(h.z, h.w) << 32); } }
    }
}
__device__ __forceinline__ void mod_vectors(const float* MODP, const float* bias, const float* g, int b, int cbase, LAS float* GS, LAS float* SH, int tid) {
    for (int k = tid; k < D; k += NWAVES * 64) { float sh = bias[k], sc = bias[D + k];
#pragma unroll
        for (int ks = 0; ks < 16; ++ks) { const float* p = MODP + (size_t)(ks * 8 + b) * 8192 + cbase + k; sh += p[0]; sc += p[D]; }
        GS[k] = g[k] * (1.0f + sc); SH[k] = sh; }
}

struct S5Stage { float2 pw[3]; float2 bb[2]; float cr[2], ci[2]; };
__device__ __forceinline__ void s5_tables_load(S5Stage& st, int g, int tid, const float2* POWp, const float2* BBTp, const float* Cre, const float* Cim) {
#pragma unroll
    for (int q = 0; q < 3; ++q) { const int e = q * (NWAVES * 64) + tid; st.pw[q] = (e < 64 * 17) ? POWp[(size_t)g * 64 * 17 + e] : make_float2(0.f, 0.f); }
#pragma unroll
    for (int q = 0; q < 2; ++q) { const int e = q * (NWAVES * 64) + tid; st.bb[q] = BBTp[(size_t)g * 64 * 16 + e]; st.cr[q] = Cre[(size_t)g * 1024 + e]; st.ci[q] = Cim[(size_t)g * 1024 + e]; }
}
__device__ __forceinline__ void s5_tables(LAS unsigned char* lds, int g, int qtr, int tid, const S5Stage& st, const float* Dvec, bf16u* T1, bf16u* T2, bf16u* T3) {
    LAS float* Kk = (LAS float*)(lds + 16384);
    typedef float f32x2l __attribute__((ext_vector_type(2)));
    LAS f32x2l* Pw = (LAS f32x2l*)(lds + 32768);
    LAS f32x2l* Bb = (LAS f32x2l*)(lds + 32768 + 8704);
    LAS float* Cr = (LAS float*)(lds + 32768 + 8704 + 8192);
    LAS float* Ci = Cr + 1024;
#pragma unroll
    for (int q = 0; q < 3; ++q) { const int e = q * (NWAVES * 64) + tid; if (e < 64 * 17) Pw[e] = (f32x2l){st.pw[q].x, st.pw[q].y}; }
#pragma unroll
    for (int q = 0; q < 2; ++q) { const int e = q * (NWAVES * 64) + tid; Bb[e] = (f32x2l){st.bb[q].x, st.bb[q].y}; Cr[e] = st.cr[q]; Ci[e] = st.ci[q]; }
    __syncthreads();
    for (int e = qtr * 1024 + tid; e < (qtr + 1) * 1024; e += NWAVES * 64) { const int k = e >> 8, c = (e >> 4) & 15, c2 = e & 15;
        float acc = 0.f;
#pragma unroll 8
        for (int p = 0; p < 64; ++p) { const f32x2l pw = Pw[p * 17 + k], bb = Bb[p * 16 + c2]; const float cr = Cr[c * 64 + p], ci = Ci[c * 64 + p];
            const float zr = pw.x * bb.x - pw.y * bb.y, zi = pw.x * bb.y + pw.y * bb.x; acc += cr * zr - ci * zi; }
        if (k == 0 && c == c2) acc += Dvec[g * 16 + c];
        Kk[e] = acc; }
    __syncthreads();
    for (int vid = tid; vid < 8192; vid += NWAVES * 64) {
        const int ln = vid & 63, nt2 = (vid >> 6) & 7, ks = vid >> 9, n = ln & 31, h = ln >> 5, t = 2 * nt2 + (n >> 4), c = n & 15;
        if (((t >= ks) ? ((t - ks) >> 2) : (ks & 3)) != qtr) continue;
        float vv[8];
#pragma unroll
        for (int jj = 0; jj < 8; ++jj) vv[jj] = (t >= ks) ? Kk[((t - ks) * 16 + c) * 16 + 8 * h + jj] : 0.f;
        v4u o; o.x = pk2(vv[0], vv[1]); o.y = pk2(vv[2], vv[3]); o.z = pk2(vv[4], vv[5]); o.w = pk2(vv[6], vv[7]);
        *(v4u*)(T3 + ((size_t)(g * 128 + (vid >> 6)) * 64 + ln) * 8) = o; }
    for (int vid = qtr * 1024 + tid; vid < (qtr + 1) * 1024; vid += NWAVES * 64) {
        const int ln = vid & 63, nt2 = (vid >> 6) & 7, ks2 = vid >> 9, n = ln & 31, h = ln >> 5, t = 2 * nt2 + (n >> 4), c = n & 15;
        float vv[8];
#pragma unroll
        for (int jj = 0; jj < 8; ++jj) { const int kap = 16 * ks2 + 8 * h + jj, nn = kap >> 2, sub = kap & 3, p = nn + 32 * (sub >> 1);
            const f32x2l pw = Pw[p * 17 + t + 1]; const float cr = Cr[c * 64 + p], ci = Ci[c * 64 + p];
            vv[jj] = (sub & 1) ? -(cr * pw.y + ci * pw.x) : (cr * pw.x - ci * pw.y); }
        v4u o; o.x = pk2(vv[0], vv[1]); o.y = pk2(vv[2], vv[3]); o.z = pk2(vv[4], vv[5]); o.w = pk2(vv[6], vv[7]);
        *(v4u*)(T2 + ((size_t)(g * 64 + (vid >> 6)) * 64 + ln) * 8) = o; }
    for (int vid = qtr * 1024 + tid; vid < (qtr + 1) * 1024; vid += NWAVES * 64) {
        const int ln = vid & 63, nt = (vid >> 6) & 3, r = vid >> 8, n = ln & 31, h = ln >> 5, p = (nt >> 1) * 32 + n;
        const f32x2l pw = Pw[p * 17 + 15 - r];
        float vv[8];
#pragma unroll
        for (int jj = 0; jj < 8; ++jj) { const f32x2l bb = Bb[p * 16 + 8 * h + jj]; vv[jj] = (nt & 1) ? (pw.x * bb.y + pw.y * bb.x) : (pw.x * bb.x - pw.y * bb.y); }
        v4u o; o.x = pk2(vv[0], vv[1]); o.y = pk2(vv[2], vv[3]); o.z = pk2(vv[4], vv[5]); o.w = pk2(vv[6], vv[7]);
        *(v4u*)(T1 + ((size_t)(g * 64 + (vid >> 6)) * 64 + ln) * 8) = o; }
}
__device__ __forceinline__ void s5_mfma(LAS unsigned char* lds, const bf16u* UZp, bf16u* Y1, const float2* POWp, const float2* ALp, const bf16u* T1, const bf16u* T2, const bf16u* T3, int v_, int wave, int lane) {
    const int tid = wave * 64 + lane;
    const int sq = wave >> 2, wq = wave & 3, n = lane & 31, hi = lane >> 5;
    const int b = v_ >> 5, g = (v_ & 31) + 32 * sq, g0 = v_ & 31;
    LAS unsigned char* Sl = lds + wave * 8704;
    LAS f32x4* El = (LAS f32x4*)(lds + 8 * 8704) + sq * 256;
    const int hiA = (n >> 2) & 1, rA = (n & 3) + 4 * (n >> 3);
    const bf16u* ap = UZp + ((size_t)(b * SEQ + (2 * wq + hiA) * 256 + 16 * rA)) * 2048 + g * 16 + 8 * hi;
    bf16x8 af[16];
#pragma unroll
    for (int ks = 0; ks < 16; ++ks) af[ks] = *(const bf16x8*)(ap + (size_t)ks * 2048);
    f32x16 X[4];
    {
#define S1_DMA(nt_, buf_) do { _Pragma("unroll") for (int q_ = 0; q_ < 4; ++q_) { const int cb_ = q_ * 512 + wave * 64, c_ = cb_ + lane, gq_ = g0 + 32 * (c_ >> 10), w_ = c_ & 1023; \
          __builtin_amdgcn_global_load_lds((const unsigned*)(T1 + ((size_t)((gq_ * 16 + (w_ >> 6)) * 4 + (nt_)) * 64 + (w_ & 63)) * 8), (LAS unsigned*)(lds + (buf_) * 32768 + cb_ * 16), 16, 0, 0); } } while (0)
      S1_DMA(0, 0); asm volatile("s_waitcnt vmcnt(0)" ::: "memory"); __syncthreads();
#pragma unroll
      for (int nt = 0; nt < 4; ++nt) {
          if (nt < 3) S1_DMA(nt + 1, (nt + 1) & 1);
          f32x16 z = {}; X[nt] = z;
#pragma unroll
          for (int ks = 0; ks < 16; ++ks) X[nt] = __builtin_amdgcn_mfma_f32_32x32x16_bf16(af[ks], *(const LAS bf16x8*)(lds + (nt & 1) * 32768 + sq * 16384 + ks * 1024 + lane * 16), X[nt], 0, 0, 0);
          asm volatile("s_waitcnt vmcnt(0)" ::: "memory");
          __syncthreads(); }
#undef S1_DMA
    }
    const float2 a0 = POWp[(g * 64 + n) * 17 + 16], a1 = POWp[(g * 64 + 32 + n) * 17 + 16];
    { float s0r = 0.f, s0i = 0.f, s1r = 0.f, s1i = 0.f;
#pragma unroll
      for (int r = 0; r < 16; ++r) { const float n0r = a0.x * s0r - a0.y * s0i + X[0][r], n0i = a0.x * s0i + a0.y * s0r + X[1][r]; s0r = n0r; s0i = n0i;
          const float n1r = a1.x * s1r - a1.y * s1i + X[2][r], n1i = a1.x * s1i + a1.y * s1r + X[3][r]; s1r = n1r; s1i = n1i; }
      El[(2 * wq + hi) * 32 + n] = (f32x4){s0r, s0i, s1r, s1i}; }
    __syncthreads();
    if (wq == 0 && lane < 32) { const float2 l0 = ALp[g * 64 + n], l1 = ALp[g * 64 + 32 + n]; f32x4 S = {0.f, 0.f, 0.f, 0.f};
#pragma unroll
        for (int k = 0; k < 8; ++k) { const f32x4 e = El[k * 32 + n]; El[k * 32 + n] = S;
            S = (f32x4){l0.x * S[0] - l0.y * S[1] + e[0], l0.x * S[1] + l0.y * S[0] + e[1], l1.x * S[2] - l1.y * S[3] + e[2], l1.x * S[3] + l1.y * S[2] + e[3]}; } }
    __syncthreads();
    { const f32x4 st = El[(2 * wq + hi) * 32 + n]; float s0r = st[0], s0i = st[1], s1r = st[2], s1i = st[3];
      typedef unsigned u32x2s __attribute__((ext_vector_type(2)));
#pragma unroll
      for (int r = 0; r < 16; ++r) { *(LAS u32x2s*)(Sl + crow16(r, hi) * 272 + 8 * n) = (u32x2s){pg8::cvt_pk_bf16(s0r, s0i), pg8::cvt_pk_bf16(s1r, s1i)};
          const float n0r = a0.x * s0r - a0.y * s0i + X[0][r], n0i = a0.x * s0i + a0.y * s0r + X[1][r]; s0r = n0r; s0i = n0i;
          const float n1r = a1.x * s1r - a1.y * s1i + X[2][r], n1i = a1.x * s1i + a1.y * s1r + X[3][r]; s1r = n1r; s1i = n1i; } }
    LDS_WAIT();
    bf16x8 sf[8];
#pragma unroll
    for (int ks2 = 0; ks2 < 8; ++ks2) sf[ks2] = *(const LAS bf16x8*)(Sl + n * 272 + (16 * ks2 + 8 * hi) * 2);
    LDS_WAIT();
    __syncthreads();
    {
#define S3_DMA(nt2_, buf_) do { _Pragma("unroll") for (int q_ = 0; q_ < 6; ++q_) { const int cb_ = q_ * 512 + wave * 64, c_ = cb_ + lane, sqs_ = (c_ >= 1536) ? 1 : 0, w_ = c_ - 1536 * sqs_, gq_ = g0 + 32 * sqs_; \
          const bf16u* src_ = (w_ < 1024) ? T3 + ((size_t)((gq_ * 16 + (w_ >> 6)) * 8 + (nt2_)) * 64 + (w_ & 63)) * 8 : T2 + ((size_t)((gq_ * 8 + ((w_ - 1024) >> 6)) * 8 + (nt2_)) * 64 + (w_ & 63)) * 8; \
          __builtin_amdgcn_global_load_lds((const unsigned*)src_, (LAS unsigned*)(lds + (buf_) * 49152 + cb_ * 16), 16, 0, 0); } } while (0)
      S3_DMA(0, 0); asm volatile("s_waitcnt vmcnt(0)" ::: "memory"); __syncthreads();
#pragma unroll 1
      for (int nt2 = 0; nt2 < 8; ++nt2) {
          if (nt2 < 7) S3_DMA(nt2 + 1, (nt2 + 1) & 1);
          LAS unsigned char* tb = lds + (nt2 & 1) * 49152 + sq * 24576 + lane * 16;
          f32x16 Y = {};
#pragma unroll
          for (int ks = 0; ks < 16; ++ks) Y = __builtin_amdgcn_mfma_f32_32x32x16_bf16(*(const LAS bf16x8*)(tb + ks * 1024), af[ks], Y, 0, 0, 0);
#pragma unroll
          for (int ks2 = 0; ks2 < 8; ++ks2) Y = __builtin_amdgcn_mfma_f32_32x32x16_bf16(*(const LAS bf16x8*)(tb + 16384 + ks2 * 1024), sf[ks2], Y, 0, 0, 0);
          asm volatile("s_waitcnt vmcnt(0)" :: "v"(Y) : "memory");
          unsigned yoff = (unsigned)(((b * SEQ + (2 * wq + hiA) * 256 + 16 * rA + 2 * nt2) * D + g * 16 + 8 * hi) * 2);
          asm volatile("" : "+v"(yoff));
#pragma unroll
          for (int tt = 0; tt < 2; ++tt) {
              unsigned ax = pg8::cvt_pk_bf16(gelu_tanh(Y[8 * tt + 0]), gelu_tanh(Y[8 * tt + 1])), ay = pg8::cvt_pk_bf16(gelu_tanh(Y[8 * tt + 2]), gelu_tanh(Y[8 * tt + 3]));
              unsigned bx = pg8::cvt_pk_bf16(gelu_tanh(Y[8 * tt + 4]), gelu_tanh(Y[8 * tt + 5])), by = pg8::cvt_pk_bf16(gelu_tanh(Y[8 * tt + 6]), gelu_tanh(Y[8 * tt + 7]));
              { auto r_ = __builtin_amdgcn_permlane32_swap(ax, bx, false, false); ax = r_[0]; bx = r_[1]; }
              { auto r_ = __builtin_amdgcn_permlane32_swap(ay, by, false, false); ay = r_[0]; by = r_[1]; }
              v4u o; o.x = ax; o.y = ay; o.z = bx; o.w = by;
              *(v4u*)((char*)Y1 + (yoff + (unsigned)(tt * D * 2))) = o; }
          __syncthreads(); }
#undef S3_DMA
    }
}


#define W_IN_A ((bf16u*)(GAS bf16u*)(ws + WS_W_IN_A))
#define W_GLU ((bf16u*)(GAS bf16u*)(ws + WS_W_GLU))
#define W_OUT_A ((bf16u*)(GAS bf16u*)(ws + WS_W_OUT_A))
#define W_KV ((bf16u*)(GAS bf16u*)(ws + WS_W_KV))
#define W_IN_B ((bf16u*)(GAS bf16u*)(ws + WS_W_IN_B))
#define W_OUT_B ((bf16u*)(GAS bf16u*)(ws + WS_W_OUT_B))
#define W_F ((bf16u*)(GAS bf16u*)(ws + WS_W_F))
#define MODP ((float*)(GAS float*)(ws + WS_MODP))
#define GATE ((float*)(GAS float*)(ws + WS_GATE))
#define ABAR ((float2*)(GAS float2*)(ws + WS_ABAR))
#define AL ((float2*)(GAS float2*)(ws + WS_AL))
#define BFRAG ((bf16u*)(GAS bf16u*)(ws + WS_BFRAG))
#define CFRAG ((bf16u*)(GAS bf16u*)(ws + WS_CFRAG))
#define E ((float4*)(GAS float4*)(ws + WS_E))
#define UZ ((bf16u*)(GAS bf16u*)(ws + WS_UZ))
#define KB ((bf16u*)(GAS bf16u*)(ws + WS_K))
#define VB ((bf16u*)(GAS bf16u*)(ws + WS_V))
#define R2 ((bf16u*)(GAS bf16u*)(ws + WS_R2))
#define R3 ((bf16u*)(GAS bf16u*)(ws + WS_R3))
#define QO ((bf16u*)(GAS bf16u*)(ws + WS_QO))
#define SZ ((bf16u*)(GAS bf16u*)(ws + WS_SZ))
#define LF ((float*)(GAS float*)(ws + WS_LF))
#define GSV ((float*)(GAS float*)(ws + WS_GSV))
#define POWT ((float2*)(GAS float2*)(ws + WS_POW))
#define BBT ((float2*)(GAS float2*)(ws + WS_BBT))
#define TB1 ((bf16u*)(GAS bf16u*)(ws + WS_T1))
#define TB2 ((bf16u*)(GAS bf16u*)(ws + WS_T2))
#define TB3 ((bf16u*)(GAS bf16u*)(ws + WS_T3))
__device__ __forceinline__ const float* arg_in(const Args& a, int k) { asm volatile("" : "+s"(k)); return (const float*)(const GAS float*)a.in[k]; }
#define AIN(k) arg_in(args, (k))
#define PHASE_WS GAS unsigned char* ws = (GAS unsigned char*)args.ws; asm volatile("" : "+s"(ws))

#ifdef PROBE_PH
#define TSTAMP(i) do { if ((i) == PROBE_PH) ts0_ = __builtin_amdgcn_s_memrealtime(); if ((i) == PROBE_PH + 1) ts1_ = __builtin_amdgcn_s_memrealtime(); } while (0)
#define TSPIN() do { if (blockIdx.x == 0) { const unsigned long long tgt_ = __builtin_amdgcn_s_memrealtime() + 4ull * (ts1_ - ts0_); while (__builtin_amdgcn_s_memrealtime() < tgt_) __builtin_amdgcn_s_sleep(8); } } while (0)
#else
#define TSTAMP(i) do {} while (0)
#define TSPIN() do {} while (0)
#endif
__global__ void __launch_bounds__(NWAVES * 64, 2) fwd_mega(Args args) {
#ifdef PROBE_PH
    unsigned long long ts0_ = 0, ts1_ = 0;
#endif
    extern __shared__ __attribute__((aligned(16))) unsigned char lds_raw[];
    cg::grid_group grid = cg::this_grid();
    TSTAMP(0);
    LAS unsigned char* lds = (LAS unsigned char*)lds_raw;
    const int tid = threadIdx.x, lane = tid & 63, wave = __builtin_amdgcn_readfirstlane(tid >> 6);
    const int G = gridDim.x, bx = blockIdx.x;
    int vcu = (G % 8 == 0) ? (bx % 8) * (G / 8) + bx / 8 : bx;
    int gw = vcu * NWAVES + wave; const int NGW = G * NWAVES; int cid = bx;
    int xmap = 0, xrank_ = 0, xcc_ = 0;
    float* const out = args.out;
    volatile LAS unsigned* MISC = (volatile LAS unsigned*)(lds + 131072 + 320);
    if (tid < 32) MISC[tid] = 0u;
    __syncthreads();
    XcdBarrier bar = xcd_barrier_post((unsigned*)(args.ws + WS_CTL), MISC + 8);
    if (args.ws == nullptr) grid.sync();
#define GRID_BAR() xcd_barrier(bar)
#define LOCAL_BAR() do { if (xmap) xcd_local_barrier(bar); else xcd_barrier(bar); } while (0)

#if (PH_MASK >> 0) & 1
    REP_LOOP(0) {
    PHASE_WS;
    {
        const float* cndp = AIN(1);
        LAS float* SC = (LAS float*)(lds + 73728);
        for (int idx = tid; idx < 8 * D; idx += NWAVES * 64) { const int b = idx >> 10, k = idx & 1023; const float cv = cndp[idx]; SC[k * 8 + b] = cv * sigm_f(cv); }
        __syncthreads();
        LAS float* scr = (LAS float*)(lds + wave * 8704);
        constexpr int I_2048 = (D / 64) * (2048 / 32), I_1024 = (D / 64) * (1024 / 32);
        constexpr int NT_ITEMS = 3 * I_2048 + 3 * I_1024, NITEMS = NT_ITEMS + 2048;
        for (int it = gw; it < NITEMS; it += NGW) {
            int r = it;
            if (r < NT_ITEMS) {
                if (r < I_2048) { p0_transpose_item(AIN(5), 2048, D, 2048, W_IN_A, scr, r, lane); continue; } r -= I_2048;
                if (r < I_2048) { p0_transpose_item(AIN(20), 2064, D, 2048, W_KV, scr, r, lane); continue; } r -= I_2048;
                if (r < I_2048) { p0_transpose_item(AIN(26), 2048, D, 2048, W_IN_B, scr, r, lane); continue; } r -= I_2048;
                if (r < I_1024) { p0_transpose_item(AIN(14), 1024, D, 1024, W_GLU, scr, r, lane); continue; } r -= I_1024;
                if (r < I_1024) { p0_transpose_item(AIN(16), 1024, D, 1024, W_OUT_A, scr, r, lane); continue; } r -= I_1024;
                p0_transpose_item(AIN(28), 1024, D, 1024, W_OUT_B, scr, r, lane); continue;
            }
            r -= NT_ITEMS;
            const int col = (r >> 4) * 64 + lane, ks = r & 15;
            const float* W; int ldw, cc;
            if (col < 3072) { W = AIN(3); ldw = 3072; cc = col; } else if (col < 5120) { W = AIN(18); ldw = 2048; cc = col - 3072; } else { W = AIN(24); ldw = 3072; cc = col - 5120; }
            float acc8[8] = {0.f, 0.f, 0.f, 0.f, 0.f, 0.f, 0.f, 0.f};
            const float* wp = W + (size_t)(ks * 64) * ldw + cc;
#pragma unroll 32
            for (int k = 0; k < 64; ++k) { const float w = __builtin_nontemporal_load(wp + (size_t)k * ldw);
                const f32x4 s0 = *(const LAS f32x4*)(SC + (ks * 64 + k) * 8), s1 = *(const LAS f32x4*)(SC + (ks * 64 + k) * 8 + 4);
                acc8[0] += s0.x * w; acc8[1] += s0.y * w; acc8[2] += s0.z * w; acc8[3] += s0.w * w; acc8[4] += s1.x * w; acc8[5] += s1.y * w; acc8[6] += s1.z * w; acc8[7] += s1.w * w; }
#pragma unroll
            for (int b = 0; b < 8; ++b) MODP[(size_t)(ks * 8 + b) * 8192 + col] = acc8[b];
        }
        const int gtid = vcu * (NWAVES * 64) + tid, NGT = G * NWAVES * 64;
        for (int idx = gtid; idx < 16 * D; idx += NGT) { const int jf = idx >> 10, k = idx & 1023; W_F[idx] = (bf16u)f2bf(AIN(20)[(size_t)k * 2064 + 2048 + jf]); }
        for (int it = gtid; it < NG * NST * 16; it += NGT) {
            const int idx = it >> 4, ch = it & 15, g = idx >> 6, p = idx & 63;
            const double dt = exp((double)AIN(6)[g]), ar = (double)AIN(7)[idx], ai = (double)AIN(8)[idx];
            const double mag = exp(ar * dt); double sn, cs; sincos_d(ai * dt, sn, cs);
            const double abr = mag * cs, abi = mag * sn, den = ar * ar + ai * ai, nr = abr - 1.0;
            const double cr = (nr * ar + abi * ai) / den, ci = (abi * ar - nr * ai) / den;
            if (ch == 0) { ABAR[idx] = make_float2((float)abr, (float)abi);
                double pr = 1.0, pi = 0.0;
#pragma unroll 1
                for (int k = 0; k <= 16; ++k) { POWT[(size_t)idx * 17 + k] = make_float2((float)pr, (float)pi); const double t = pr * abr - pi * abi; pi = pr * abi + pi * abr; pr = t; }
                pr = abr; pi = abi;
#pragma unroll
                for (int q = 0; q < 8; ++q) { const double t = pr * pr - pi * pi; pi = 2.0 * pr * pi; pr = t; }
                AL[idx] = make_float2((float)pr, (float)pi); }
            { const double br = AIN(9)[(size_t)idx * 16 + ch], bi = AIN(10)[(size_t)idx * 16 + ch]; const double bbr = cr * br - ci * bi, bbi = cr * bi + ci * br;
              BBT[(size_t)idx * 16 + ch] = make_float2((float)bbr, (float)bbi); }
        }
    }
#endif
    GRID_BAR();
    TSTAMP(1);
    }
    {
        if (tid == 0) { unsigned ok = (G % 8 == 0) ? 1u : 0u;
            for (unsigned jx = 0; jx < 16; ++jx) { const unsigned c = xb_ld(&bar.bar[XB_XCNT(jx)]); ok &= (jx < 8 ? (c == (unsigned)(G / 8)) : (c == 0u)) ? 1u : 0u; }
            MISC[12] = ok; }
        __syncthreads();
        const int okm = __builtin_amdgcn_readfirstlane((int)MISC[12]), xrank = __builtin_amdgcn_readfirstlane((int)MISC[10]), xcc = (int)bar.x;
        if (okm && G == 256) { cid = xrank * 8 + xcc; vcu = xcc * (G / 8) + xrank; gw = vcu * NWAVES + wave; xmap = 1; xrank_ = xrank; xcc_ = xcc; }
    }

#if (PH_MASK >> 1) & 1
    REP_LOOP(1) {
    PHASE_WS;
    {
        if (tid < 64) { const int idx = xmap ? ((((xrank_ * 64 + tid) >> 10) << 13) | (xcc_ << 10) | ((xrank_ * 64 + tid) & 1023)) : vcu * 64 + tid;
            if (idx < 2 * 8 * D) { const int which = idx >> 13, b = (idx >> 10) & 7, n = idx & 1023;
                const int col = which == 0 ? 2048 + n : 5120 + 2048 + n; float s = which == 0 ? AIN(4)[2048 + n] : AIN(25)[2048 + n];
#pragma unroll
                for (int ks = 0; ks < 16; ++ks) s += MODP[(size_t)(ks * 8 + b) * 8192 + col];
                GATE[idx] = s; } }
        if (tid >= 64 && tid < 192) { const int idx = vcu * 128 + (tid - 64), b = idx >> 12, vec = (idx >> 10) & 3, k = idx & 1023;
            const float* bias = (vec < 2) ? AIN(19) : AIN(25); const int cbase = (vec < 2) ? 3072 : 5120, off = (vec & 1) ? 0 : D;
            float sacc = bias[off + k];
#pragma unroll
            for (int ks = 0; ks < 16; ++ks) sacc += MODP[(size_t)(ks * 8 + b) * 8192 + cbase + off + k];
            GSV[idx] = (vec & 1) ? sacc : ((vec == 0) ? AIN(17)[k] : AIN(23)[k]) * (1.0f + sacc); }
        LAS float* GS = (LAS float*)lds; LAS float* SH = GS + D;
        for (int v = vcu; v < 256; v += G) {
            S5Stage stg; s5_tables_load(stg, v >> 2, tid, POWT, BBT, AIN(11), AIN(12));
            f32x4 xr[8][4]; norm_load<true>(AIN(0), v, wave, lane, xr);
            __syncthreads();
            s5_tables(lds, v >> 2, v & 3, tid, stg, AIN(13), TB1, TB2, TB3);
            mod_vectors(MODP, AIN(4), AIN(2), v >> 5, 0, GS, SH, tid);
            __syncthreads();
            norm_apply<1>(xr, v, wave, lane, GS, SH, R2, GS, SH, R2);
        }
    }
#endif
    GRID_BAR();
    TSTAMP(2);
    }

#if (PH_MASK >> 2) & 1
    REP_LOOP(2) {
    PHASE_WS;
    { pg8::Gemm g{R2, W_IN_A, M, 2048, D}; pg8::StaticOrder S; S.init(M, 2048, G, cid); pg8::EpiStore Ep{UZ, 2048};
      pg8::gemm_phase<pg8::EpiStore, pg8::StaticOrder, true, true>(lds, g, S, Ep); }
#endif
    LOCAL_BAR();
    TSTAMP(3);
    }

#if (PH_MASK >> 3) & 1
    REP_LOOP(3) {
    PHASE_WS;
    for (int v_ = vcu; v_ < 256; v_ += G) { __syncthreads(); s5_mfma(lds, UZ, R2, POWT, AL, TB1, TB2, TB3, v_, wave, lane); }
#endif
    LOCAL_BAR();
    TSTAMP(4);
    }

#if (PH_MASK >> 4) & 1
    REP_LOOP(4) {
    PHASE_WS;
    { pg8::Gemm g{R2, W_GLU, M, 1024, D}; pg8::StaticOrder S; S.init(M, 1024, G, cid); pg8::EpiGlu Ep{R2, UZ + 1024, AIN(15), R3};
      pg8::gemm_phase<pg8::EpiGlu, pg8::StaticOrder, true, true>(lds, g, S, Ep); }
#endif
    LOCAL_BAR();
    TSTAMP(5);
    }

#if (PH_MASK >> 5) & 1
    REP_LOOP(5) {
    PHASE_WS;
    { pg8::Gemm g{R3, W_OUT_A, M, 1024, D}; pg8::StaticOrder S; S.init(M, 1024, G, cid); pg8::EpiRes Ep{AIN(0), GATE, out};
      pg8::gemm_phase<pg8::EpiRes, pg8::StaticOrder, true, true>(lds, g, S, Ep); }
#endif
    LOCAL_BAR();
    TSTAMP(6);
    }

#if (PH_MASK >> 6) & 1
    REP_LOOP(6) {
    PHASE_WS;
    {
        LAS float* GS0 = (LAS float*)lds; LAS float* SH0 = GS0 + D; LAS float* GS1 = SH0 + D; LAS float* SH1 = GS1 + D;
        for (int v = vcu; v < M / 64; v += G) {
            __syncthreads();
            { const f32x4* gsrc = (const f32x4*)(GSV + (size_t)(v >> 5) * 4096);
              const f32x4 gv0 = gsrc[tid], gv1 = gsrc[tid + 512];
              f32x4 xr[8][4]; norm_load<false>(out, v, wave, lane, xr);
              LAS f32x4* gdst = (LAS f32x4*)GS0; gdst[tid] = gv0; gdst[tid + 512] = gv1;
              __syncthreads();
              norm_apply<2>(xr, v, wave, lane, GS0, SH0, R2, GS1, SH1, R3); }
        }
    }
#endif
    LOCAL_BAR();
    TSTAMP(7);
    }

#if (PH_MASK >> 7) & 1
    REP_LOOP(7) {
    PHASE_WS;
    {
        for (int v_ = vcu; v_ < M / 64; v_ += G) { const int t = 4 * v_ + (wave & 3), kh = wave >> 2;
            f32x4 acc = {0.f, 0.f, 0.f, 0.f};
            const bf16u* ap = R2 + (size_t)(16 * t + (lane & 15)) * D + 512 * kh + 8 * (lane >> 4); const bf16u* bp = W_F + (size_t)(lane & 15) * D + 512 * kh + 8 * (lane >> 4);
#pragma unroll
            for (int ks = 0; ks < 16; ++ks) acc = __builtin_amdgcn_mfma_f32_16x16x32_bf16(*(const bf16x8*)(ap + ks * 32), *(const bf16x8*)(bp + ks * 32), acc, 0, 0, 0);
            LAS f32x4* part = (LAS f32x4*)lds + (wave & 3) * 64 + lane;
            __syncthreads();
            if (kh == 1) *part = acc;
            __syncthreads();
            if (kh == 0) { acc += *part;
                const float fb = AIN(21)[lane & 15];
                f32x4 ls4;
#pragma unroll
                for (int r = 0; r < 4; ++r) { const float xl = acc[r] + fb; ls4[r] = fminf(xl, 0.f) - log1pf(__expf(-fabsf(xl))); }
                const int row = 16 * t + 4 * (lane >> 4), bq = row >> 11, tq = row & 2047;
                *(f32x4*)(LF + ((size_t)(bq * NH + (lane & 15)) * SEQ + tq)) = ls4; }
        }
        { pg8::Gemm g{R2, W_KV, M, 2048, D}; pg8::StaticOrder S; S.init(M, 2048, G, cid); pg8::EpiHeadNorm<false> Ep{KB, VB, AIN(22), 1.0f};
          pg8::gemm_phase<pg8::EpiHeadNorm<false>, pg8::StaticOrder, true, true>(lds, g, S, Ep); }
        { pg8::Gemm g{R3, W_IN_B, M, 2048, D}; pg8::StaticOrder S; S.init(M, 2048, G, cid); pg8::EpiHeadNorm<true> Ep{QO, SZ, AIN(27), C2};
          pg8::gemm_phase<pg8::EpiHeadNorm<true>, pg8::StaticOrder, true, true>(lds, g, S, Ep); }
    }
#endif
    LOCAL_BAR();
    TSTAMP(8);
    }

#if (PH_MASK >> 8) & 1
    { PHASE_WS; const attn_body::AttnTensors AT{(const attn_body::bf16*)QO, (const attn_body::bf16*)KB, (const attn_body::bf16*)VB, (attn_body::bf16*)QO, (const attn_body::bf16*)SZ, LF, AIN(27), AIN(22)};
      attn_body::attn_phase<60>((char*)lds_raw, AT, vcu, G); }
#endif
    LOCAL_BAR();
    TSTAMP(9);

#if (PH_MASK >> 9) & 1
    { PHASE_WS; pg8::Gemm g{QO, W_OUT_B, M, 1024, D}; pg8::StaticOrder S; S.init(M, 1024, G, cid); pg8::EpiResT<true> Ep{out, GATE + 8 * D, out};
      pg8::gemm_phase<pg8::EpiResT<true>, pg8::StaticOrder, true, true>(lds, g, S, Ep); }
#endif
    TSTAMP(10);
    TSPIN();
}

extern "C" void kernel_launch(void* const* d_in, const int* in_sizes, int n_in, void* d_out, int out_size, void* d_ws, size_t ws_size, hipStream_t stream) {
    static int grid = 0;
    if (grid == 0) {
        if (n_in != 29 || out_size != M * D || ws_size < WS_END) { fprintf(stderr, "kernel_launch: unexpected problem (n_in %d out %d ws %zu)\n", n_in, out_size, ws_size); grid = -1; return; }
        int dev = 0, cus = 0, per_cu = 0;
        (void)hipGetDevice(&dev); (void)hipDeviceGetAttribute(&cus, hipDeviceAttributeMultiprocessorCount, dev);
        if (hipFuncSetAttribute((const void*)fwd_mega, hipFuncAttributeMaxDynamicSharedMemorySize, LDS_BYTES) != hipSuccess) { fprintf(stderr, "kernel_launch: hipFuncSetAttribute failed\n"); grid = -1; return; }
        if (hipOccupancyMaxActiveBlocksPerMultiprocessor(&per_cu, (const void*)fwd_mega, NWAVES * 64, LDS_BYTES) != hipSuccess || per_cu < 1) { fprintf(stderr, "kernel_launch: occupancy query says %d\n", per_cu); per_cu = 1; }
        (void)hipGetLastError();
        grid = cus > 0 ? cus : 256;
    }
    if (grid < 0) return;
    if (hipMemsetAsync((char*)d_ws + WS_CTL, 0, CTL_ZERO_BYTES, stream) != hipSuccess) { fprintf(stderr, "kernel_launch: memset failed\n"); return; }
    Args a{};
    for (int i = 0; i < 29; ++i) a.in[i] = (const float*)d_in[i];
    a.out = (float*)d_out; a.ws = (unsigned char*)d_ws;
    void* kargs[] = {&a};
    const hipError_t e = hipLaunchCooperativeKernel((const void*)fwd_mega, dim3(grid), dim3(NWAVES * 64), kargs, LDS_BYTES, stream);
    if (e != hipSuccess) fprintf(stderr, "cooperative launch failed: %s (grid %d)\n", hipGetErrorString(e), grid);
}
```

```cpp
#include <hip/hip_runtime.h>
#include <hip/hip_cooperative_groups.h>
#include <cstdio>
#include <cstdint>
namespace cg = cooperative_groups;
namespace pg8 {
#define PG8_LAS __attribute__((address_space(3)))
typedef unsigned short bf16_t;
typedef short bf16x8 __attribute__((ext_vector_type(8)));
typedef float f32x4 __attribute__((ext_vector_type(4)));
typedef unsigned u32x4 __attribute__((ext_vector_type(4)));
constexpr int BM = 256, BK = 64, HALF = 128, HTB = HALF * BK * 2  , STAGE_BYTES = 8 * HTB, NXCD = 8, WGM = 8;

__host__ __device__ __forceinline__ int lds_byte(int r, int c) { const int st = (r >> 4) * 2 + (c >> 5), rr = r & 15, cc = c & 31, ob = rr * 64 + cc * 2; return st * 1024 + (ob ^ (((ob >> 9) & 1) << 5)); }
__host__ __device__ __forceinline__ void stage_rc(int b, int& R, int& C) { const int st = b / 1024, sb = b % 1024, swz = sb ^ (((sb >> 9) & 1) << 5); R = (st >> 1) * 16 + swz / 64; C = (st & 1) * 32 + (swz % 64) / 2; }
__host__ __device__ __forceinline__ int perm32(int rho) { const int n = rho >> 4, i = rho & 15; return 8 * (i >> 2) + 4 * n + (i & 3); }

struct Unit { int pm, pn; };
struct Gemm { const bf16_t* A; const bf16_t* Bt; int M, N, K; };

struct StaticOrder {
    int nM, nN, nwg, G, c;
    __host__ __device__ void init(int M, int N, int G_, int c_) { nM = M / BM; nN = N / BM; nwg = nM * nN; G = G_; c = c_; }
    __host__ __device__ bool next(int i, Unit& u) const {
        const long L = (long)i * G + c; if (L >= nwg) return false;
        int wgid = (int)L; { const int q = nwg / NXCD, r = nwg % NXCD, xcd = wgid % NXCD, off = wgid / NXCD; wgid = (xcd < r ? xcd * (q + 1) : r * (q + 1) + (xcd - r) * q) + off; }
        const int nig = WGM * nN, gid = wgid / nig, fm = gid * WGM, gsz = (nM - fm) < WGM ? (nM - fm) : WGM;
        u.pm = fm + ((wgid % nig) % gsz); u.pn = (wgid % nig) / gsz; return true;
    }
    __device__ __forceinline__ void a_ready(const Unit&) const {}
    __device__ __forceinline__ void done(const Unit&) const {}
};

__device__ __forceinline__ unsigned cvt_pk_bf16(float lo, float hi) { unsigned r; asm volatile("v_cvt_pk_bf16_f32 %0, %1, %2" : "=v"(r) : "v"(lo), "v"(hi)); return r; }
typedef float f32x2 __attribute__((ext_vector_type(2)));
typedef unsigned u32x4e __attribute__((ext_vector_type(4)));
__device__ __forceinline__ float bf_lo(unsigned u) { return __uint_as_float(u << 16); }
__device__ __forceinline__ float bf_hi(unsigned u) { return __uint_as_float(u & 0xffff0000u); }
__device__ __forceinline__ float sigm(float x) { return __builtin_amdgcn_rcpf(1.0f + __builtin_amdgcn_exp2f(-1.4426950408889634f * x)); }
__device__ __forceinline__ u32x4e pack8(const f32x4& a, const f32x4& b) { u32x4e w; w.x = cvt_pk_bf16(a[0], a[1]); w.y = cvt_pk_bf16(a[2], a[3]); w.z = cvt_pk_bf16(b[0], b[1]); w.w = cvt_pk_bf16(b[2], b[3]); return w; }

struct EpiStore {
    static constexpr bool PERM = true, AFTER_DRAIN = false;
    bf16_t* O; int ldc;
    __device__ __forceinline__ void operator()(const f32x4 (&acc)[2][2][4][2], const Unit& u, int wr, int wc, int fr, int fq) const {
        const int row0 = u.pm * BM + wr * 64 + fr, colb = u.pn * BM + wc * 64 + 8 * fq;
#pragma unroll
        for (int ai = 0; ai < 2; ++ai)
#pragma unroll
            for (int m = 0; m < 4; ++m) { bf16_t* rowp = O + (size_t)(row0 + ai * HALF + m * 16) * ldc + colb;
#pragma unroll
                for (int bj = 0; bj < 2; ++bj) *(u32x4e*)(rowp + bj * 32) = pack8(acc[ai][bj][m][0], acc[ai][bj][m][1]); }
    }
};
struct EpiGlu {
    static constexpr bool PERM = true, AFTER_DRAIN = false;
    const bf16_t* Y1; const bf16_t* Z; const float* bias; bf16_t* O;
    __device__ __forceinline__ void operator()(const f32x4 (&acc)[2][2][4][2], const Unit& u, int wr, int wc, int fr, int fq) const {
        constexpr int PD = 6;
        const int row0 = u.pm * BM + wr * 64 + fr, colb = u.pn * BM + wc * 64 + 8 * fq;
        f32x4 bv[2][2];
#pragma unroll
        for (int bj = 0; bj < 2; ++bj)
#pragma unroll
            for (int n = 0; n < 2; ++n) bv[bj][n] = *(const f32x4*)(bias + colb + bj * 32 + 4 * n);
        u32x4e yb[PD], zb[PD];
#define EG_ROW(it) ((size_t)(row0 + ((it) >> 3) * HALF + (((it) >> 1) & 3) * 16))
#define EG_COL(it) (colb + ((it) & 1) * 32)
#pragma unroll
        for (int it = 0; it < PD; ++it) { yb[it] = __builtin_nontemporal_load((const u32x4e*)(Y1 + EG_ROW(it) * 1024 + EG_COL(it))); zb[it] = __builtin_nontemporal_load((const u32x4e*)(Z + EG_ROW(it) * 2048 + EG_COL(it)));     }
#pragma unroll
        for (int it = 0; it < 16; ++it) { const int ai = it >> 3, m = (it >> 1) & 3, bj = it & 1;
            const u32x4e yv = yb[it % PD], zv = zb[it % PD];
            if (it + PD < 16) { yb[it % PD] = __builtin_nontemporal_load((const u32x4e*)(Y1 + EG_ROW(it + PD) * 1024 + EG_COL(it + PD))); zb[it % PD] = __builtin_nontemporal_load((const u32x4e*)(Z + EG_ROW(it + PD) * 2048 + EG_COL(it + PD))); }
            asm volatile("" ::: "memory");
            f32x4 o0, o1;
#pragma unroll
            for (int k = 0; k < 2; ++k) { const float g0 = acc[ai][bj][m][0][2 * k] + bv[bj][0][2 * k], g1 = acc[ai][bj][m][0][2 * k + 1] + bv[bj][0][2 * k + 1];
                const float z0 = bf_lo(zv[k]), z1 = bf_hi(zv[k]);
                o0[2 * k] = bf_lo(yv[k]) * sigm(g0) * z0 * sigm(z0); o0[2 * k + 1] = bf_hi(yv[k]) * sigm(g1) * z1 * sigm(z1); }
#pragma unroll
            for (int k = 0; k < 2; ++k) { const float g0 = acc[ai][bj][m][1][2 * k] + bv[bj][1][2 * k], g1 = acc[ai][bj][m][1][2 * k + 1] + bv[bj][1][2 * k + 1];
                const float z0 = bf_lo(zv[2 + k]), z1 = bf_hi(zv[2 + k]);
                o1[2 * k] = bf_lo(yv[2 + k]) * sigm(g0) * z0 * sigm(z0); o1[2 * k + 1] = bf_hi(yv[2 + k]) * sigm(g1) * z1 * sigm(z1); }
            *(u32x4e*)(O + EG_ROW(it) * 1024 + EG_COL(it)) = pack8(o0, o1);
            asm volatile("" ::: "memory"); }
    }
};
template <bool NT> struct EpiResT {
    static constexpr bool PERM = true, AFTER_DRAIN = false;
    const float* X; const float* gate; float* OUT;
    __device__ __forceinline__ void operator()(const f32x4 (&acc)[2][2][4][2], const Unit& u, int wr, int wc, int fr, int fq) const {
        constexpr int PD = 6;
        const int row0 = u.pm * BM + wr * 64 + fr, colb = u.pn * BM + wc * 64 + 8 * fq;
        const float* gp = gate + (size_t)(u.pm >> 3) * 1024 + colb;
        f32x4 gv[2][2];
#pragma unroll
        for (int bj = 0; bj < 2; ++bj)
#pragma unroll
            for (int n = 0; n < 2; ++n) gv[bj][n] = *(const f32x4*)(gp + bj * 32 + 4 * n);
        f32x4 xb[PD][2];
#pragma unroll
        for (int it = 0; it < PD; ++it) { const float* p = X + EG_ROW(it) * 1024 + EG_COL(it); xb[it][0] = __builtin_nontemporal_load((const f32x4*)p); xb[it][1] = __builtin_nontemporal_load((const f32x4*)(p + 4));     }
#pragma unroll
        for (int it = 0; it < 16; ++it) { const int ai = it >> 3, m = (it >> 1) & 3, bj = it & 1;
            const f32x4 x0 = xb[it % PD][0], x1 = xb[it % PD][1];
            if (it + PD < 16) { const float* p = X + EG_ROW(it + PD) * 1024 + EG_COL(it + PD); xb[it % PD][0] = __builtin_nontemporal_load((const f32x4*)p); xb[it % PD][1] = __builtin_nontemporal_load((const f32x4*)(p + 4)); }
            asm volatile("" ::: "memory");
            float* q = OUT + EG_ROW(it) * 1024 + EG_COL(it);
            const f32x4 o0 = x0 + gv[bj][0] * acc[ai][bj][m][0], o1 = x1 + gv[bj][1] * acc[ai][bj][m][1];
            if (NT) { __builtin_nontemporal_store(o0, (f32x4*)q); __builtin_nontemporal_store(o1, (f32x4*)(q + 4)); }
            else { *(f32x4*)q = o0; *(f32x4*)(q + 4) = o1; }
            asm volatile("" ::: "memory"); }
#undef EG_ROW
#undef EG_COL
    }
};
typedef EpiResT<false> EpiRes;
template <bool SILU> struct EpiHeadNorm {
    static constexpr bool PERM = true, AFTER_DRAIN = false;
    bf16_t* O0; bf16_t* O1; const float* g; float scale;
    __device__ __forceinline__ void operator()(const f32x4 (&acc)[2][2][4][2], const Unit& u, int wr, int wc, int fr, int fq) const {
        const int row0 = u.pm * BM + wr * 64 + fr;
        if (u.pn < 4) {
            const int colb = u.pn * BM + wc * 64 + 8 * fq;
            f32x4 gv[2][2];
#pragma unroll
            for (int bj = 0; bj < 2; ++bj)
#pragma unroll
                for (int n = 0; n < 2; ++n) gv[bj][n] = *(const f32x4*)(g + bj * 32 + 8 * fq + 4 * n) * scale;
#pragma unroll
            for (int ai = 0; ai < 2; ++ai)
#pragma unroll
                for (int m = 0; m < 4; ++m) { float s = 0.f;
#pragma unroll
                    for (int bj = 0; bj < 2; ++bj)
#pragma unroll
                        for (int n = 0; n < 2; ++n) { const f32x4 x = acc[ai][bj][m][n]; s += (x[0] * x[0] + x[1] * x[1]) + (x[2] * x[2] + x[3] * x[3]); }
                    s += __shfl_xor(s, 16); s += __shfl_xor(s, 32);
                    const float r = 1.0f / sqrtf(s * (1.0f / 64.0f) + 1e-6f);
                    bf16_t* rowp = O0 + (size_t)(row0 + ai * HALF + m * 16) * 1024 + colb;
#pragma unroll
                    for (int bj = 0; bj < 2; ++bj) *(u32x4e*)(rowp + bj * 32) = pack8(acc[ai][bj][m][0] * r * gv[bj][0], acc[ai][bj][m][1] * r * gv[bj][1]); }
        } else {
            const int colb = (u.pn - 4) * BM + wc * 64 + 8 * fq;
#pragma unroll
            for (int ai = 0; ai < 2; ++ai)
#pragma unroll
                for (int m = 0; m < 4; ++m) { bf16_t* rowp = O1 + (size_t)(row0 + ai * HALF + m * 16) * 1024 + colb;
#pragma unroll
                    for (int bj = 0; bj < 2; ++bj) { f32x4 a = acc[ai][bj][m][0], b = acc[ai][bj][m][1];
                        if (SILU) {
#pragma unroll
                            for (int k = 0; k < 4; ++k) { a[k] = a[k] * sigm(a[k]); b[k] = b[k] * sigm(b[k]); } }
                        *(u32x4e*)(rowp + bj * 32) = pack8(a, b); } }
        }
    }
};
template <class Epi, class Sched, bool ALIGN_EPI = false, bool SP2 = false>
__device__ __forceinline__ void gemm_phase(PG8_LAS unsigned char* lds, const Gemm g, const Sched& S, const Epi& E) {
    int tid_ = threadIdx.x; asm volatile("" : "+v"(tid_));
    const int tid = tid_, wid = __builtin_amdgcn_readfirstlane(tid >> 6), lane = tid & 63, wr = wid >> 2, wc = wid & 3, fr = lane & 15, fq = lane >> 4;
    const int K = g.K, nt = K / BK;
    unsigned voffA[2], voffB[2];
#pragma unroll
    for (int i = 0; i < 2; ++i) { int R, C; stage_rc(tid * 16 + i * 8192, R, C); const int Rb = Epi::PERM ? ((R & ~31) + perm32(R & 31)) : R;
        voffA[i] = (unsigned)(R * K + C) * 2u; voffB[i] = (unsigned)(Rb * K + C) * 2u; }
    const size_t kstep = (size_t)(BK * 2);
    const size_t hstep = (size_t)HALF * K * 2;
    const size_t tstep = 2 * hstep;
    const unsigned ldsw = (unsigned)wid * 1024u;
    const int aoff = lds_byte(wr * 64 + fr, fq * 8), boff = lds_byte(wc * 32 + fr, fq * 8);
#define PG8_SA(b, h) (((b) * 2 + (h)) * HTB)
#define PG8_SB(b, h) ((4 + (b) * 2 + (h)) * HTB)
#define PG8_STAGE(bufoff, gbase, voff) do { _Pragma("unroll") for (int _i = 0; _i < 2; ++_i) \
        __builtin_amdgcn_global_load_lds((const unsigned*)((const char*)(gbase) + (voff)[_i]), (PG8_LAS unsigned*)(lds + (bufoff) + ldsw + _i * 8192), 16, 0, 0); } while (0)
#define PG8_LDA(dst, b, h) do { _Pragma("unroll") for (int m = 0; m < 4; ++m) _Pragma("unroll") for (int k = 0; k < 2; ++k) dst[m][k] = *(const PG8_LAS bf16x8*)(lds + PG8_SA(b, h) + aoff + m * 2048 + k * 1024); } while (0)
#define PG8_LDB(dst, b, h) do { _Pragma("unroll") for (int n = 0; n < 2; ++n) _Pragma("unroll") for (int k = 0; k < 2; ++k) dst[n][k] = *(const PG8_LAS bf16x8*)(lds + PG8_SB(b, h) + boff + n * 2048 + k * 1024); } while (0)
#define PG8_MMA(ai, bj, At, Bt) do { __builtin_amdgcn_s_setprio(1); _Pragma("unroll") for (int m = 0; m < 4; ++m) _Pragma("unroll") for (int n = 0; n < 2; ++n) _Pragma("unroll") for (int k = 0; k < 2; ++k) \
        acc[ai][bj][m][n] = __builtin_amdgcn_mfma_f32_16x16x32_bf16(Bt[n][k], At[m][k], acc[ai][bj][m][n], 0, 0, 0); __builtin_amdgcn_s_setprio(0); } while (0)
#define PG8_WAIT_V(n) asm volatile("s_waitcnt vmcnt(" #n ")" ::: "memory")
#define PG8_WAIT_L(n) asm volatile("s_waitcnt lgkmcnt(" #n ")" ::: "memory")
#define PG8_BAR __builtin_amdgcn_s_barrier()
#define PG8_SCHED __builtin_amdgcn_sched_barrier(0)
    Unit cur, nxt; int ui = 0;
    if (!S.next(0, cur)) return;
    f32x4 acc[2][2][4][2];
#pragma unroll
    for (int a = 0; a < 2; ++a)
#pragma unroll
        for (int b = 0; b < 2; ++b)
#pragma unroll
            for (int m = 0; m < 4; ++m)
#pragma unroll
                for (int n = 0; n < 2; ++n) acc[a][b][m][n] = (f32x4){0.f, 0.f, 0.f, 0.f};
    bf16x8 At[4][2], B0[2][2], B1[2][2];
    const char* cA = (const char*)g.A + (size_t)cur.pm * tstep; const char* cB = (const char*)g.Bt + (size_t)cur.pn * tstep;
    S.a_ready(cur);
    if constexpr (SP2) {
        PG8_STAGE(PG8_SB(0, 0), cB, voffB); PG8_STAGE(PG8_SB(0, 1), cB + hstep, voffB); PG8_STAGE(PG8_SA(0, 0), cA, voffA); PG8_STAGE(PG8_SA(0, 1), cA + hstep, voffA);
        if (wr == 1) PG8_BAR;
        PG8_WAIT_V(2); PG8_BAR;
        PG8_STAGE(PG8_SB(1, 0), cB + kstep, voffB); PG8_STAGE(PG8_SA(1, 0), cA + kstep, voffA); PG8_STAGE(PG8_SB(1, 1), cB + hstep + kstep, voffB);
        PG8_WAIT_V(6); PG8_BAR;
    } else {
        PG8_STAGE(PG8_SB(0, 0), cB, voffB); PG8_STAGE(PG8_SA(0, 0), cA, voffA); PG8_STAGE(PG8_SB(0, 1), cB + hstep, voffB); PG8_STAGE(PG8_SA(0, 1), cA + hstep, voffA);
        if (wr == 1) PG8_BAR;
        PG8_WAIT_V(4); PG8_BAR;
        PG8_STAGE(PG8_SB(1, 0), cB + kstep, voffB); PG8_STAGE(PG8_SA(1, 0), cA + kstep, voffA); PG8_STAGE(PG8_SB(1, 1), cB + hstep + kstep, voffB);
        PG8_WAIT_V(6); PG8_BAR;
    }
    for (;;) {
        const bool has_next = S.next(ui + 1, nxt);
        const char* nA = has_next ? (const char*)g.A + (size_t)nxt.pm * tstep : cA; const char* nB = has_next ? (const char*)g.Bt + (size_t)nxt.pn * tstep : cB;
        for (int t = 0; t < nt; t += 2) {
            const bool last = (t == nt - 2);
            const char* a1 = cA + (size_t)(t + 1) * kstep;
            const char* a2 = last ? nA : cA + (size_t)(t + 2) * kstep; const char* b2 = last ? nB : cB + (size_t)(t + 2) * kstep;
            const char* a3 = a2 + kstep; const char* b3 = b2 + kstep;
            if (last && has_next) S.a_ready(nxt);
            if constexpr (SP2) {
            PG8_LDB(B0, 0, 0); PG8_LDB(B1, 0, 1); PG8_SCHED; PG8_LDA(At, 0, 0); PG8_STAGE(PG8_SA(1, 1), a1 + hstep, voffA);
            PG8_WAIT_V(8); PG8_WAIT_L(0); PG8_BAR; PG8_MMA(0, 0, At, B0); PG8_MMA(0, 1, At, B1); PG8_BAR; PG8_SCHED;
            PG8_LDA(At, 0, 1); PG8_STAGE(PG8_SB(0, 0), b2, voffB); PG8_STAGE(PG8_SB(0, 1), b2 + hstep, voffB); PG8_STAGE(PG8_SA(0, 0), a2, voffA);
            PG8_WAIT_V(8); PG8_WAIT_L(0); PG8_BAR; PG8_MMA(1, 0, At, B0); PG8_MMA(1, 1, At, B1); PG8_BAR; PG8_SCHED;
            PG8_LDB(B0, 1, 0); PG8_LDB(B1, 1, 1); PG8_SCHED; PG8_LDA(At, 1, 0); PG8_STAGE(PG8_SA(0, 1), a2 + hstep, voffA);
            PG8_WAIT_V(8); PG8_WAIT_L(0); PG8_BAR; PG8_MMA(0, 0, At, B0); PG8_MMA(0, 1, At, B1); PG8_BAR; PG8_SCHED;
            PG8_LDA(At, 1, 1); PG8_STAGE(PG8_SB(1, 0), b3, voffB); PG8_STAGE(PG8_SB(1, 1), b3 + hstep, voffB); PG8_STAGE(PG8_SA(1, 0), a3, voffA);
            PG8_WAIT_V(8); PG8_WAIT_L(0); PG8_BAR; PG8_MMA(1, 0, At, B0); PG8_MMA(1, 1, At, B1); PG8_BAR; PG8_SCHED;
            } else {
            PG8_LDB(B0, 0, 0); PG8_SCHED; PG8_LDA(At, 0, 0); PG8_STAGE(PG8_SA(1, 1), a1 + hstep, voffA);
            PG8_WAIT_L(8); PG8_BAR; PG8_WAIT_L(0); PG8_MMA(0, 0, At, B0); PG8_BAR; PG8_SCHED;
            PG8_LDB(B1, 0, 1); PG8_STAGE(PG8_SB(0, 0), b2, voffB);
            PG8_BAR; PG8_WAIT_L(0); PG8_MMA(0, 1, At, B1); PG8_BAR;
            PG8_LDA(At, 0, 1); PG8_STAGE(PG8_SA(0, 0), a2, voffA);
            PG8_BAR; PG8_WAIT_L(0); PG8_MMA(1, 0, At, B0); PG8_BAR; PG8_SCHED;
            PG8_STAGE(PG8_SB(0, 1), b2 + hstep, voffB);
            PG8_WAIT_V(6); PG8_BAR; PG8_MMA(1, 1, At, B1); PG8_BAR;
            PG8_LDB(B0, 1, 0); PG8_SCHED; PG8_LDA(At, 1, 0); PG8_STAGE(PG8_SA(0, 1), a2 + hstep, voffA);
            PG8_WAIT_L(8); PG8_BAR; PG8_WAIT_L(0); PG8_MMA(0, 0, At, B0); PG8_BAR; PG8_SCHED;
            PG8_LDB(B1, 1, 1); PG8_STAGE(PG8_SB(1, 0), b3, voffB);
            PG8_BAR; PG8_WAIT_L(0); PG8_MMA(0, 1, At, B1); PG8_BAR;
            PG8_LDA(At, 1, 1); PG8_STAGE(PG8_SA(1, 0), a3, voffA);
            PG8_BAR; PG8_WAIT_L(0); PG8_MMA(1, 0, At, B0); PG8_BAR; PG8_SCHED;
            PG8_STAGE(PG8_SB(1, 1), b3 + hstep, voffB);
            PG8_WAIT_V(6); PG8_BAR; PG8_MMA(1, 1, At, B1); PG8_BAR;
            }
        }
        if constexpr (ALIGN_EPI) { if (wr == 0) PG8_BAR; }
        if constexpr (!Epi::AFTER_DRAIN) { E(acc, cur, wr, wc, fr, fq); S.done(cur); }
        if (!has_next) break;
#pragma unroll
        for (int a = 0; a < 2; ++a)
#pragma unroll
            for (int b = 0; b < 2; ++b)
#pragma unroll
                for (int m = 0; m < 4; ++m)
#pragma unroll
                    for (int n = 0; n < 2; ++n) acc[a][b][m][n] = (f32x4){0.f, 0.f, 0.f, 0.f};
        cur = nxt; cA = nA; cB = nB; ++ui;
        if constexpr (ALIGN_EPI) { if (wr == 1) PG8_BAR; }
    }
    PG8_WAIT_V(0);
    if constexpr (!ALIGN_EPI) { if (wr == 0) PG8_BAR; }
    PG8_BAR;
    if constexpr (Epi::AFTER_DRAIN) { E.fused(acc, cur, wr, wc, fr, fq, lds, wid, lane); S.done(cur); }
#undef PG8_SA
#undef PG8_SB
#undef PG8_STAGE
#undef PG8_LDA
#undef PG8_LDB
#undef PG8_MMA
#undef PG8_WAIT_V
#undef PG8_WAIT_L
#undef PG8_BAR
#undef PG8_SCHED
}
}
#include <hip/hip_bf16.h>
#include <cmath>
namespace attn_body {
using bf16=__hip_bfloat16;
using bf16x8=__attribute__((ext_vector_type(8)))short;
using s16x4=__attribute__((ext_vector_type(4)))short;
using f32x16=__attribute__((ext_vector_type(16)))float;
using u32x4=__attribute__((ext_vector_type(4)))unsigned;
constexpr int BATCH=8,NHEAD=16,SEQ=2048,D=64,DM=NHEAD*D;
constexpr int NW=8,QBLK=32,QB=QBLK*NW,KVBLK=64,NQB=SEQ/QB;
constexpr int ATTN_PITCH=DM, ATTN_UNIT_ROWS=QB;
__device__ __forceinline__ int crow(int r,int hi){return (r&3)+8*(r>>2)+4*hi;}
#define SBAR() __builtin_amdgcn_sched_barrier(0)
__device__ __forceinline__ void cmask(f32x16&p0,f32x16&p1,int jb,int qrel,int hi){
  const float NEG=-INFINITY; int d=qrel-(64*jb+4*hi); asm volatile("":"+v"(d));
  #pragma unroll
  for(int r=0;r<16;++r){const int c=(r&3)+8*(r>>2); if(c>d)p0[r]=NEG; if(c+32>d)p1[r]=NEG;}
}

constexpr int NSLOT=3, SLOTB=8192;
constexpr int LDS_K=0, LDS_V=NSLOT*SLOTB, LDS_WS=2*NSLOT*SLOTB, LDS_OST=LDS_WS+NW*64*4, LDS_FS=LDS_OST+NW*4096, LDS_SCAN=LDS_FS+SEQ*4, LDS_BYTES=LDS_SCAN+256; typedef float f32x4v __attribute__((ext_vector_type(4)));
constexpr float C2=0.125f*1.4426950408889634f;
__device__ __forceinline__ void glds16(const void*gsrc,unsigned lds_dst){unsigned keep;
  asm volatile("s_mov_b32 %0, m0\n\ts_mov_b32 m0, %2\n\ts_nop 0\n\tglobal_load_lds_dwordx4 %1, off\n\ts_mov_b32 m0, %0":"=&s"(keep):"v"(gsrc),"s"(lds_dst):"memory");}
__device__ __forceinline__ float max3f(float a,float b,float c){float r;asm("v_max3_f32 %0, %1, %2, %3":"=v"(r):"v"(a),"v"(b),"v"(c));return r;}
__device__ __forceinline__ float max2f(float a,float b){float r;asm("v_max_f32_e32 %0, %1, %2":"=v"(r):"v"(a),"v"(b));return r;}
__device__ __forceinline__ float fadd_s(float a,float b){float r;asm("v_add_f32_e32 %0, %1, %2":"=v"(r):"v"(a),"v"(b));return r;}
__device__ __forceinline__ float fsub_s(float a,float b){float r;asm("v_sub_f32_e32 %0, %1, %2":"=v"(r):"v"(a),"v"(b));return r;}
typedef float f32x2_t __attribute__((ext_vector_type(2))); typedef __bf16 bf16x2_t __attribute__((ext_vector_type(2)));
__device__ __forceinline__ unsigned cvtpk_s(float lo,float hi){f32x2_t v={lo,hi};bf16x2_t b=__builtin_convertvector(v,bf16x2_t);return __builtin_bit_cast(unsigned,b);}
#define WAIT_BAR(N) asm volatile("s_waitcnt vmcnt(" #N ") lgkmcnt(0)\n\ts_barrier":::"memory")

__device__ __forceinline__ void qkt(f32x16&p0,f32x16&p1,const char*Kslot,const bf16x8*qr,int r32,int hi){
  const char*kb=Kslot+hi*1024+r32*16;
  #pragma unroll
  for(int d0=0;d0<4;++d0){
    const bf16x8 b0=*reinterpret_cast<const bf16x8*>(kb+d0*2048);
    const bf16x8 b1=*reinterpret_cast<const bf16x8*>(kb+d0*2048+512);
    p0=__builtin_amdgcn_mfma_f32_32x32x16_bf16(b0,qr[d0],p0,0,0,0);p1=__builtin_amdgcn_mfma_f32_32x32x16_bf16(b1,qr[d0],p1,0,0,0);}
}
typedef __attribute__((address_space(3))) const char* lds_cptr;
typedef short v4i16_t __attribute__((ext_vector_type(4)));
__device__ __forceinline__ void kload8(bf16x8*kf,lds_cptr kp){
  kf[0]=*(const __attribute__((address_space(3))) bf16x8*)(kp);      kf[1]=*(const __attribute__((address_space(3))) bf16x8*)(kp+512);
  kf[2]=*(const __attribute__((address_space(3))) bf16x8*)(kp+2048); kf[3]=*(const __attribute__((address_space(3))) bf16x8*)(kp+2560);
  kf[4]=*(const __attribute__((address_space(3))) bf16x8*)(kp+4096); kf[5]=*(const __attribute__((address_space(3))) bf16x8*)(kp+4608);
  kf[6]=*(const __attribute__((address_space(3))) bf16x8*)(kp+6144); kf[7]=*(const __attribute__((address_space(3))) bf16x8*)(kp+6656);
}
__device__ __forceinline__ void kload2(bf16x8*kf,lds_cptr kp,int j){ kf[2*j]=*(const __attribute__((address_space(3))) bf16x8*)(kp+j*2048); kf[2*j+1]=*(const __attribute__((address_space(3))) bf16x8*)(kp+j*2048+512); }
__device__ __forceinline__ s16x4 vtr(lds_cptr p){ return __builtin_bit_cast(s16x4,__builtin_amdgcn_ds_read_tr16_b64_v4i16((__attribute__((address_space(3))) v4i16_t*)p)); }
__device__ __forceinline__ float rowmax(const f32x16&p0,const f32x16&p1){
  float a=max3f(p0[0],p0[1],p1[0]),b=max3f(p0[2],p0[3],p1[1]);a=max3f(a,p1[2],p1[3]);
  #pragma unroll
  for(int r=4;r<16;r+=4){a=max3f(a,p0[r],p0[r+1]);b=max3f(b,p0[r+2],p0[r+3]);a=max3f(a,p1[r],p1[r+1]);b=max3f(b,p1[r+2],p1[r+3]);}
  const float m=max2f(a,b);
  auto rr=__builtin_amdgcn_permlane32_swap(__float_as_uint(m),__float_as_uint(m),false,false);
  return max2f(__uint_as_float(rr[0]),__uint_as_float(rr[1]));
}
__device__ __forceinline__ void pv(f32x16*o,int vb,bf16x8 pa0,bf16x8 pa1,bf16x8 pa2,bf16x8 pa3){
  #pragma unroll
  for(int d0=0;d0<2;++d0){s16x4 lo[4],hi[4];
    #pragma unroll
    for(int ks=0;ks<4;++ks){
      asm volatile("ds_read_b64_tr_b16 %0,%1 offset:%c2":"=&v"(lo[ks]):"v"(vb),"i"(d0*4096+ks*1024):"memory");
      asm volatile("ds_read_b64_tr_b16 %0,%1 offset:%c2":"=&v"(hi[ks]):"v"(vb),"i"(d0*4096+ks*1024+512):"memory");}
    asm volatile("s_waitcnt lgkmcnt(0)":::"memory");SBAR();
    #define PK(k) (bf16x8){lo[k][0],lo[k][1],lo[k][2],lo[k][3],hi[k][0],hi[k][1],hi[k][2],hi[k][3]}
    o[d0]=__builtin_amdgcn_mfma_f32_32x32x16_bf16(pa0,PK(0),o[d0],0,0,0);
    o[d0]=__builtin_amdgcn_mfma_f32_32x32x16_bf16(pa1,PK(1),o[d0],0,0,0);
    o[d0]=__builtin_amdgcn_mfma_f32_32x32x16_bf16(pa2,PK(2),o[d0],0,0,0);
    o[d0]=__builtin_amdgcn_mfma_f32_32x32x16_bf16(pa3,PK(3),o[d0],0,0,0);
    #undef PK
  }
}

#ifndef ATTN_STORE16
#define ATTN_STORE16(p,v) (*(u32x4*)(p)=(v))
#endif
template<int THRL> __device__ __forceinline__ void attn_unit(int b,int h,int qb,const bf16*Q,const bf16*__restrict__ K,const bf16*__restrict__ V,bf16*O,const bf16*__restrict__ SZ,char*shm,float skip_thr){
  int tid_=threadIdx.x; asm volatile("":"+v"(tid_)); const int tid=tid_,lane=tid&63,r32=lane&31,hi=lane>>5; const int wid=__builtin_amdgcn_readfirstlane(tid>>6);
  const long rowbase=(long)b*SEQ; const int q0=qb*QB;
  const bf16*Qw=Q+(rowbase+q0+wid*QBLK)*DM+h*D;
  const __attribute__((address_space(3))) float* Fs3=(const __attribute__((address_space(3))) float*)((lds_cptr)shm+LDS_FS);
  int t0s;
  { const int NT0=(q0+QB)/KVBLK; const int tl=lane&31; const float fq0=Fs3[q0];
    const bool sk=(tl<NT0)&&(fq0-Fs3[64*tl+63]<-skip_thr);
    const unsigned long long mb=__ballot(sk);
    int cnt=__popcll(mb&0xffffffffull); cnt=__builtin_amdgcn_readfirstlane(cnt)&~1; t0s=cnt<NT0-4?cnt:NT0-4; }
  const __attribute__((address_space(3))) float* FsK=Fs3+64*t0s;
  const bf16*Kh=K+(rowbase+64*t0s)*DM+h*D,*Vh=V+(rowbase+64*t0s)*DM+h*D;
  const unsigned lds0=(unsigned)(uintptr_t)shm;
  float*wsf=(float*)(shm+LDS_WS)+wid*64;
  const bf16*ksrc=Kh+(long)lane*DM+wid*8;
  const bf16*vsrc=Vh+(long)(16*(wid&3)+(lane>>2))*DM+(wid>>2)*32+(lane&3)*8;
  const unsigned kdst=lds0+LDS_K+wid*1024, vdst=lds0+LDS_V+wid*1024;
  #define DMA_K(t,slot) glds16(ksrc+(long)(t)*KVBLK*DM,(unsigned)__builtin_amdgcn_readfirstlane(kdst+(slot)))
  #define DMA_V(t,slot) glds16(vsrc+(long)(t)*KVBLK*DM,(unsigned)__builtin_amdgcn_readfirstlane(vdst+(slot)))
  const int vb0=(int)(lds0+LDS_V)+((lane>>4)&1)*32+(lane&3)*8+(4*hi+((lane&15)>>2))*64;
  const char*Kbase=shm+LDS_K; bf16x8 kf[8];
  const lds_cptr shm3=(lds_cptr)shm; const lds_cptr kp0=shm3+LDS_K+hi*1024+r32*16; const lds_cptr vp0=shm3+LDS_V+((lane>>4)&1)*32+(lane&3)*8+(4*hi+((lane&15)>>2))*64;
  const int NT=(q0+QB)/KVBLK-t0s;
  DMA_K(0,0);DMA_V(0,0);DMA_K(1,SLOTB);
  bf16x8 qr[4];
  #pragma unroll
  for(int d0=0;d0<4;++d0)qr[d0]=*reinterpret_cast<const bf16x8*>(&Qw[(long)r32*DM+d0*16+hi*8]);
  float l_reg=0.f;f32x16 o[2];o[0]=f32x16{};o[1]=f32x16{};
  const int qrel=wid*QBLK+r32;
  float fqm=Fs3[q0+qrel];
  #define BLOAD(C0,C1,t) do{ const __attribute__((address_space(3))) f32x4v* fk_=(const __attribute__((address_space(3))) f32x4v*)(FsK+(t)*64+4*hi); \
    _Pragma("unroll") for(int i_=0;i_<4;++i_){ const f32x4v a_=fk_[2*i_], b_=fk_[2*i_+8]; \
      _Pragma("unroll") for(int k_=0;k_<4;++k_){ C0[4*i_+k_]=a_[k_]; C1[4*i_+k_]=b_[k_]; } } }while(0)
  #define BSUB(C0,C1) do{ _Pragma("unroll") for(int r_=0;r_<16;++r_){ C0[r_]=fqm-C0[r_]; C1[r_]=fqm-C1[r_]; } }while(0)
  #define BIAS(C0,C1,t) do{ const __attribute__((address_space(3))) f32x4v* fk_=(const __attribute__((address_space(3))) f32x4v*)(FsK+(t)*64+4*hi); \
    _Pragma("unroll") for(int i_=0;i_<4;++i_){ const f32x4v a_=fk_[2*i_], b_=fk_[2*i_+8]; \
      _Pragma("unroll") for(int k_=0;k_<4;++k_){ C0[4*i_+k_]=fqm-a_[k_]; C1[4*i_+k_]=fqm-b_[k_]; } } }while(0)
  #define CMASK(P0,P1,t) do{int jb_=(t)-(NT-4); if(jb_>=0)cmask(P0,P1,jb_,qrel,hi);}while(0)
  bool resc=false;
  #define START(P0,P1) do{ const float rm=rowmax(P0,P1); resc=false; \
    { const float dl=rm; fqm=fsub_s(fqm,dl); \
      _Pragma("unroll") for(int r=0;r<16;++r){P0[r]=fsub_s(P0[r],dl);P1[r]=fsub_s(P1[r],dl);} } \
    _Pragma("unroll") for(int r=0;r<16;++r)P0[r]=__builtin_amdgcn_exp2f(P0[r]); }while(0)
  #define RESC() do{ if(resc){ asm volatile("s_waitcnt lgkmcnt(0)":::"memory"); \
      _Pragma("unroll") for(int d_=0;d_<2;++d_) _Pragma("unroll") for(int r=0;r<16;++r)o[d_][r]*=wsf[crow(r,hi)]; } }while(0)
  f32x16 pA0,pA1,pB0,pB1;
  int sl_prev=0,sl_cur=0,sl_next=SLOTB;
  #define ROT() do{sl_prev=sl_cur;sl_cur=sl_next;sl_next=(sl_next==(NSLOT-1)*SLOTB)?0:sl_next+SLOTB;}while(0)
  DMA_K(2,2*SLOTB);
  WAIT_BAR(3);
  BIAS(pA0,pA1,0); qkt(pA0,pA1,Kbase,qr,r32,hi);asm volatile("s_nop 15\n\ts_nop 7":"+v"(pA0),"+v"(pA1));CMASK(pA0,pA1,0);
  START(pA0,pA1);
  _Pragma("unroll") for(int r=0;r<16;++r)pA1[r]=__builtin_amdgcn_exp2f(pA1[r]);
  WAIT_BAR(0);
  DMA_K(3,0);DMA_V(1,SLOTB);
  ROT();
  kload8(kf,kp0+sl_cur);
  WAIT_BAR(2);
  s16x4 vlo[8],vhi[8]; u32x4 pw0,pw1,pw2,pw3;
  #define PKW(P,B) cvtpk_s(P[B],P[B+1])
  #define PAF(k) __builtin_bit_cast(bf16x8,pw##k)
  #define VFR(i) (bf16x8){vlo[i][0],vlo[i][1],vlo[i][2],vlo[i][3],vhi[i][0],vhi[i][1],vhi[i][2],vhi[i][3]}
  #define PIN(x) asm volatile("":"+v"(x))
  #define MX3(a,b,c) __builtin_fmaxf(__builtin_fmaxf((a),(b)),(c))
  #define GAPA(MF,A0,A1,A2,A3,W0,W1,PW) do{ MF; sacc+=A0; sacc+=A1; sacc+=A2; sacc+=A3; PIN(sacc); W0; W1; PIN(PW); SBAR(); }while(0)
  #define EX(v) __builtin_amdgcn_exp2f(v)
  #define GAPB(MF,X,B) do{ MF; X[B]=EX(X[B]); X[B+1]=EX(X[B+1]); X[B+2]=EX(X[B+2]); X[B+3]=EX(X[B+3]); PIN(X); SBAR(); }while(0)
  #define VRD(i) do{ vlo[i]=vtr(vp_+(((i)>>2)*4096+((i)&3)*1024)); vhi[i]=vtr(vp_+(((i)>>2)*4096+((i)&3)*1024+512)); }while(0)
  #define KRD(G,j) do{ if(G){ kload2(kf,kp0+sl_next,j); SBAR(); } }while(0)
  #define STEP(C0,C1,P0,P1,t,GK,GV,GL) do{ SBAR(); BSUB(C0,C1); SBAR(); \
    const lds_cptr vp_=vp0+sl_prev; \
    VRD(0); SBAR(); float sacc=(P0[0]+P0[1]); \
    GAPA(C0=__builtin_amdgcn_mfma_f32_32x32x16_bf16(kf[0],qr[0],C0,0,0,0), P0[2],P0[3],P0[4],P0[5],     pw0[0]=PKW(P0,0), pw0[1]=PKW(P0,2), pw0); \
    VRD(4); SBAR(); GAPA(C1=__builtin_amdgcn_mfma_f32_32x32x16_bf16(kf[1],qr[0],C1,0,0,0), P0[6],P0[7],P0[8],P0[9],     pw0[2]=PKW(P0,4), pw0[3]=PKW(P0,6), pw0); \
    VRD(1); SBAR(); GAPA(C0=__builtin_amdgcn_mfma_f32_32x32x16_bf16(kf[2],qr[1],C0,0,0,0),   P0[10],P0[11],P0[12],P0[13], pw1[0]=PKW(P0,8), pw1[1]=PKW(P0,10), pw1); \
    VRD(5); SBAR(); GAPA(C1=__builtin_amdgcn_mfma_f32_32x32x16_bf16(kf[3],qr[1],C1,0,0,0),   P0[14],P0[15],P1[0],P1[1],   pw1[2]=PKW(P0,12),pw1[3]=PKW(P0,14), pw1); \
    VRD(2); SBAR(); GAPA(C0=__builtin_amdgcn_mfma_f32_32x32x16_bf16(kf[4],qr[2],C0,0,0,0),   P1[2],P1[3],P1[4],P1[5],     pw2[0]=PKW(P1,0), pw2[1]=PKW(P1,2), pw2); \
    VRD(6); SBAR(); GAPA(C1=__builtin_amdgcn_mfma_f32_32x32x16_bf16(kf[5],qr[2],C1,0,0,0),   P1[6],P1[7],P1[8],P1[9],     pw2[2]=PKW(P1,4), pw2[3]=PKW(P1,6), pw2); \
    VRD(3); SBAR(); GAPA(C0=__builtin_amdgcn_mfma_f32_32x32x16_bf16(kf[6],qr[3],C0,0,0,0),   P1[10],P1[11],P1[12],P1[13], pw3[0]=PKW(P1,8), pw3[1]=PKW(P1,10), pw3); \
    VRD(7); SBAR(); GAPA(C1=__builtin_amdgcn_mfma_f32_32x32x16_bf16(kf[7],qr[3],C1,0,0,0),   P1[14],P1[15],0.f,0.f,       pw3[2]=PKW(P1,12),pw3[3]=PKW(P1,14), pw3); \
    l_reg+=sacc; \
    if(GK){DMA_K((t)+3,sl_cur);} if(GV){DMA_V((t)+1,sl_next);} \
    CMASK(C0,C1,t); \
    { float a=MX3(C0[0],C0[1],C1[0]),b=MX3(C0[2],C0[3],C1[1]); a=MX3(a,C1[2],C1[3]); \
      _Pragma("unroll") for(int r=4;r<16;r+=4){a=MX3(a,C0[r],C0[r+1]);b=MX3(b,C0[r+2],C0[r+3]);a=MX3(a,C1[r],C1[r+1]);b=MX3(b,C1[r+2],C1[r+3]);} \
      float rm=__builtin_fmaxf(a,b); { auto rr=__builtin_amdgcn_permlane32_swap(__float_as_uint(rm),__float_as_uint(rm),false,false); rm=__builtin_fmaxf(__uint_as_float(rr[0]),__uint_as_float(rr[1])); } \
      resc=false; \
      if(__builtin_expect(__any(rm>(float)THRL),0)){ const float dl=__builtin_fmaxf(rm,0.f); fqm-=dl; \
        _Pragma("unroll") for(int r=0;r<16;++r){C0[r]-=dl;C1[r]-=dl;} \
        const float f=__builtin_amdgcn_exp2f(-dl); l_reg*=f; if(hi==0)wsf[r32]=f; resc=true; } } \
    SBAR(); BLOAD(P0,P1,(t)+1); SBAR(); \
    GAPB(o[0]=__builtin_amdgcn_mfma_f32_32x32x16_bf16(PAF(0),VFR(0),o[0],0,0,0), C0,0); \
    GAPB(o[1]=__builtin_amdgcn_mfma_f32_32x32x16_bf16(PAF(0),VFR(4),o[1],0,0,0), C0,4); \
    KRD(GL,0); GAPB(o[0]=__builtin_amdgcn_mfma_f32_32x32x16_bf16(PAF(1),VFR(1),o[0],0,0,0), C0,8); \
    KRD(GL,1); GAPB(o[1]=__builtin_amdgcn_mfma_f32_32x32x16_bf16(PAF(1),VFR(5),o[1],0,0,0), C0,12); \
    KRD(GL,2); GAPB(o[0]=__builtin_amdgcn_mfma_f32_32x32x16_bf16(PAF(2),VFR(2),o[0],0,0,0), C1,0); \
    KRD(GL,3); GAPB(o[1]=__builtin_amdgcn_mfma_f32_32x32x16_bf16(PAF(2),VFR(6),o[1],0,0,0), C1,4); \
    GAPB(o[0]=__builtin_amdgcn_mfma_f32_32x32x16_bf16(PAF(3),VFR(3),o[0],0,0,0), C1,8); \
    GAPB(o[1]=__builtin_amdgcn_mfma_f32_32x32x16_bf16(PAF(3),VFR(7),o[1],0,0,0), C1,12); \
    }while(0)
  BLOAD(pB0,pB1,1);
  int t=1;
  #undef CMASK
  #define CMASK(P0,P1,t) do{}while(0)
  for(;t+5<NT;t+=2){
    STEP(pB0,pB1,pA0,pA1,t,true,true,true);     WAIT_BAR(2); RESC(); ROT();
    STEP(pA0,pA1,pB0,pB1,t+1,true,true,true);   WAIT_BAR(2); RESC(); ROT();
  }
  #undef CMASK
  #define CMASK(P0,P1,t) do{int jb_=(t)-(NT-4); if(jb_>=0)cmask(P0,P1,jb_,qrel,hi);}while(0)
  #define ENDW(tt) do{ if((tt)+3<NT){WAIT_BAR(2);} else if((tt)+2<NT){WAIT_BAR(1);} else {WAIT_BAR(0);} }while(0)
  for(;t+1<NT;t+=2){
    STEP(pB0,pB1,pA0,pA1,t,(t+3<NT),(t+1<NT),(t+1<NT));       ENDW(t);   RESC(); ROT();
    STEP(pA0,pA1,pB0,pB1,t+1,(t+4<NT),(t+2<NT),(t+2<NT));     ENDW(t+1); RESC(); ROT();
  }
  STEP(pB0,pB1,pA0,pA1,NT-1,false,false,false); RESC();
  { float sacc=pB0[0]+pB0[1]; _Pragma("unroll") for(int r=2;r<16;++r)sacc+=pB0[r]; _Pragma("unroll") for(int r=0;r<16;++r)sacc+=pB1[r]; l_reg+=sacc;
    pw0=(u32x4){PKW(pB0,0),PKW(pB0,2),PKW(pB0,4),PKW(pB0,6)};pw1=(u32x4){PKW(pB0,8),PKW(pB0,10),PKW(pB0,12),PKW(pB0,14)};pw2=(u32x4){PKW(pB1,0),PKW(pB1,2),PKW(pB1,4),PKW(pB1,6)};pw3=(u32x4){PKW(pB1,8),PKW(pB1,10),PKW(pB1,12),PKW(pB1,14)};
    SBAR(); pv(o,vb0+sl_cur,PAF(0),PAF(1),PAF(2),PAF(3)); }
  #undef PKW
  #undef PAF
  #undef VFR
  #undef PIN
  #undef MX3
  #undef GAPA
  #undef GAPB
  #undef EX
  #undef VRD
  #undef KRD
  #undef STEP
  #undef ENDW
  {auto rr=__builtin_amdgcn_permlane32_swap(__float_as_uint(l_reg),__float_as_uint(l_reg),false,false);l_reg=__uint_as_float(rr[0])+__uint_as_float(rr[1]);}
  if(hi==0)wsf[32+r32]=l_reg;asm volatile("s_waitcnt lgkmcnt(0)":::"memory");
  float rli[16];
  #pragma unroll
  for(int r=0;r<16;++r)rli[r]=__builtin_amdgcn_rcpf(wsf[32+crow(r,hi)]);
  bf16*Ow=O+(rowbase+q0+wid*QBLK)*DM+h*D;
  { bf16*stg=(bf16*)(shm+LDS_OST)+wid*2048;
    #pragma unroll
    for(int r=0;r<16;++r){const int orow=crow(r,hi);
      #pragma unroll
      for(int d0=0;d0<2;++d0)stg[orow*64+d0*32+r32]=__float2bfloat16(o[d0][r]*rli[r]);}
    asm volatile("s_waitcnt lgkmcnt(0)":::"memory");
    const bf16*SZw=SZ+(rowbase+q0+wid*QBLK)*DM+h*D;
    #pragma unroll
    for(int i=0;i<4;++i){const int row=i*8+(lane>>3),ch=lane&7; const u32x4 v=*(const u32x4*)(stg+row*64+ch*8); const u32x4 g=*(const u32x4*)(SZw+(long)row*DM+ch*8); u32x4 w;
      #pragma unroll
      for(int k=0;k<4;++k){ const float a0=__uint_as_float(v[k]<<16)*__uint_as_float(g[k]<<16), a1=__uint_as_float(v[k]&0xffff0000u)*__uint_as_float(g[k]&0xffff0000u); w[k]=cvtpk_s(a0,a1); }
      ATTN_STORE16(Ow+(long)row*DM+ch*8,w);} }
  asm volatile("s_waitcnt lgkmcnt(0)\n\ts_barrier":::"memory");
  #undef DMA_K
  #undef DMA_V
  #undef CMASK
  #undef START
  #undef RESC
  #undef ROT
  #undef BIAS
}
constexpr int ATTN_LDS_BYTES=LDS_BYTES;
struct AttnTensors { const bf16* Q; const bf16* K; const bf16* V; bf16* O; const bf16* SZ; const float* LF; const float* gq; const float* gk; };
template<int THRL=8> __device__ __forceinline__ void attn_phase(char*lds,const AttnTensors&T,int vcu,int G){
  float skip_thr;
  { const int l0=threadIdx.x&63; float mq=fabsf(T.gq[l0]),mk=fabsf(T.gk[l0]);
    #pragma unroll
    for(int o_=1;o_<64;o_<<=1){mq=fmaxf(mq,__shfl_xor(mq,o_));mk=fmaxf(mk,__shfl_xor(mk,o_));}
    skip_thr=2.0f*(64.0f*mq*mk*C2)+32.0f; }
  #pragma unroll 1
  for(int task=vcu;task<BATCH*NHEAD*2;task+=G){
    const int b=task>>5,rr=task&31,s=rr&1,hb=rr>>1;
    #pragma unroll 1
    for(int i=0;i<4;++i){ const int qb=(i==0)?7-s:(i==1)?s:(i==2)?4+s:3-s; const int h=(hb+4*i)&15;
      { int tid=threadIdx.x; asm volatile("":"+v"(tid)); const int lane=tid&63,wid=tid>>6;
        __attribute__((address_space(3))) float* Fs=(__attribute__((address_space(3))) float*)((lds_cptr)lds+LDS_FS);
        __attribute__((address_space(3))) float* WT=(__attribute__((address_space(3))) float*)((lds_cptr)lds+LDS_SCAN);
        const f32x4v lf4=*(const f32x4v*)(T.LF+((long)(b*NHEAD+h)*SEQ+4*tid));
        const float v0=lf4[0],v1=lf4[1],v2=lf4[2],v3=lf4[3];
        const float p1=v0+v1,p2=p1+v2,p3=p2+v3; float x=p3;
        #pragma unroll
        for(int off=1;off<64;off<<=1){const float y=__shfl_up(x,off); if(lane>=off)x+=y;}
        if(lane==63)WT[wid]=x;
        __syncthreads();
        float offs=0.f;
        #pragma unroll
        for(int w=0;w<NW;++w){const float tv=WT[w]; if(w<wid)offs+=tv;}
        const float ex=x-p3+offs; const float L2E=1.4426950408889634f;
        f32x4v o4; o4[0]=(ex+v0)*L2E; o4[1]=(ex+p1)*L2E; o4[2]=(ex+p2)*L2E; o4[3]=(ex+p3)*L2E;
        *(__attribute__((address_space(3))) f32x4v*)(Fs+4*tid)=o4;
        __syncthreads(); }
      attn_unit<THRL>(b,h,qb,T.Q,T.K,T.V,T.O,T.SZ,lds,skip_thr); }
  }
}
#undef SBAR
#undef WAIT_BAR
}
#define GAS __attribute__((address_space(1)))
#define LAS __attribute__((address_space(3)))
typedef unsigned short bf16u;
typedef unsigned v4u __attribute__((ext_vector_type(4)));
typedef float f32x4 __attribute__((ext_vector_type(4)));
typedef float f32x16 __attribute__((ext_vector_type(16)));
typedef short bf16x8 __attribute__((ext_vector_type(8)));
#define LDS_WAIT() asm volatile("s_waitcnt lgkmcnt(0)" ::: "memory")

constexpr int NWAVES = 8;
constexpr int BATCH = 8, SEQ = 2048, D = 1024, M = BATCH * SEQ, NG = 64, NST = 64, NH = 16;
constexpr float EPS = 1e-6f;
constexpr float C2 = 0.125f * 1.4426950408889634f;

constexpr size_t MiB = 1u << 20;
constexpr size_t WS_W_IN_A = 0 * MiB, WS_W_GLU = 4 * MiB, WS_W_OUT_A = 6 * MiB, WS_W_KV = 8 * MiB, WS_W_IN_B = 12 * MiB, WS_W_OUT_B = 16 * MiB;
constexpr size_t WS_W_F = 18 * MiB;
constexpr size_t WS_MODP = 220 * MiB;
constexpr size_t WS_GATE = 21 * MiB;
constexpr size_t WS_ABAR = 21 * MiB + 128 * 1024, WS_AL = WS_ABAR + 32 * 1024, WS_BFRAG = WS_AL + 32 * 1024, WS_CFRAG = WS_BFRAG + 256 * 1024;
constexpr size_t WS_CTL = 21 * MiB + 768 * 1024, CTL_ZERO_BYTES = 16384;
constexpr size_t WS_E = 22 * MiB;
constexpr size_t WS_UZ = 24 * MiB;
constexpr size_t WS_K = 24 * MiB, WS_V = 56 * MiB;
constexpr size_t WS_R2 = 88 * MiB;
constexpr size_t WS_R3 = 120 * MiB;
constexpr size_t WS_QO = 152 * MiB, WS_SZ = 184 * MiB;
constexpr size_t WS_LF = 216 * MiB;
constexpr size_t WS_GSV = 22 * MiB + 768 * 1024;
constexpr size_t WS_POW = 22 * MiB, WS_BBT = 23 * MiB;
constexpr size_t WS_T1 = 224 * MiB, WS_T2 = 228 * MiB, WS_T3 = 232 * MiB;
constexpr size_t WS_END = 240 * MiB;
constexpr int LDS_BYTES = 147456;

__device__ __forceinline__ unsigned f2bf(float f) { unsigned u = __builtin_bit_cast(unsigned, f); return (u + 0x7fffu + ((u >> 16) & 1u)) >> 16; }
__device__ __forceinline__ unsigned pk2(float lo, float hi) { return f2bf(lo) | (f2bf(hi) << 16); }
__device__ __forceinline__ float wave_sum(float v) {
#pragma unroll
    for (int o = 1; o < 64; o <<= 1) v += __shfl_xor(v, o);
    return v;
}
__host__ __device__ __forceinline__ int phys_row(int n) { const int q = n & 255; return (n - q) + 128 * ((q >> 5) & 1) + 32 * (q >> 6) + (q & 31); }

struct Args { const float* in[29]; float* out; unsigned char* ws; };

__device__ __forceinline__ void p0_transpose_item(const float* W, int ldw, int K, int N, bf16u* WT, LAS float* scr, int item, int lane) {
    const int nblk = N / 32, kb = item / nblk, nb = item % nblk, k0 = 64 * kb, n0 = 32 * nb;
    f32x4 tv[8];
#pragma unroll
    for (int i = 0; i < 8; ++i) tv[i] = __builtin_nontemporal_load((const f32x4*)(W + (size_t)(k0 + 8 * i + (lane >> 3)) * ldw + n0 + 4 * (lane & 7)));
#pragma unroll
    for (int i = 0; i < 8; ++i) { LAS float* d = scr + (8 * i + (lane >> 3)) * 33 + 4 * (lane & 7); d[0] = tv[i].x; d[1] = tv[i].y; d[2] = tv[i].z; d[3] = tv[i].w; }
    LDS_WAIT(); asm volatile("" ::: "memory");
    const int c = lane & 7; const int pr0 = phys_row(n0);
#pragma unroll
    for (int j = 0; j < 4; ++j) { const int n = (lane >> 3) + 8 * j; const LAS float* s = scr + (8 * c) * 33 + n;
        v4u o; o.x = pk2(s[0 * 33], s[1 * 33]); o.y = pk2(s[2 * 33], s[3 * 33]); o.z = pk2(s[4 * 33], s[5 * 33]); o.w = pk2(s[6 * 33], s[7 * 33]);
        *(v4u*)(WT + (size_t)(pr0 + n) * K + k0 + 8 * c) = o; }
    LDS_WAIT(); asm volatile("" ::: "memory");
}

__device__ __forceinline__ void sincos_d(double x, double& s, double& c) {
    const double kq = rint(x * 0.63661977236758134308), r = fma(-kq, 1.57079632679489661923, x) - kq * 6.123233995736766e-17, r2 = r * r;
    double sp = -7.6471637318198165e-13; sp = fma(sp, r2, 1.6059043836821613e-10); sp = fma(sp, r2, -2.5052108385441720e-08); sp = fma(sp, r2, 2.7557319223985893e-06);
    sp = fma(sp, r2, -1.9841269841269841e-04); sp = fma(sp, r2, 8.3333333333333332e-03); sp = fma(sp, r2, -1.6666666666666666e-01); sp = fma(sp * r2, r, r);
    double cp = 4.7794773323873853e-14; cp = fma(cp, r2, -1.1470745597729725e-11); cp = fma(cp, r2, 2.0876756987868100e-09); cp = fma(cp, r2, -2.7557319223985888e-07);
    cp = fma(cp, r2, 2.4801587301587302e-05); cp = fma(cp, r2, -1.3888888888888889e-03); cp = fma(cp, r2, 4.1666666666666664e-02); cp = fma(cp, r2, -0.5); cp = fma(cp, r2, 1.0);
    const int q = ((int)kq) & 3;
    s = (q == 0) ? sp : (q == 1) ? cp : (q == 2) ? -sp : -cp;
    c = (q == 0) ? cp : (q == 1) ? -sp : (q == 2) ? -cp : sp;
}

#define XB_TMO      128
#define XB_XCNT(j)  (256  + 64 * (j))
#define XB_XSUB(j)  (1280 + 64 * (j))
#define XB_XGEN(j)  (2304 + 64 * (j))
#define XB_TOP      3328
#define XB_TOPGEN   3392
#define XCD_BAR_WORDS 3456
#define XB_SPIN_CAP (1u << 18)

__device__ __forceinline__ unsigned xb_ld(unsigned* p)              { return __hip_atomic_load(p, __ATOMIC_RELAXED, __HIP_MEMORY_SCOPE_AGENT); }
__device__ __forceinline__ unsigned xb_add(unsigned* p, unsigned v) { return __hip_atomic_fetch_add(p, v, __ATOMIC_RELAXED, __HIP_MEMORY_SCOPE_AGENT); }
__device__ __forceinline__ unsigned xb_xcc_id() { return (unsigned)__builtin_amdgcn_s_getreg((3 << 11) | 20) & 0xFu; }
#define XB_SPIN(cond, bar) do { unsigned _sp = 0; while (cond) { __builtin_amdgcn_s_sleep(1); \
    if ((++_sp & 255u) == 0u) { if (xb_ld(&(bar)[XB_TMO])) break; if (_sp > XB_SPIN_CAP) { atomicAdd(&(bar)[XB_TMO], 1u); break; } } } } while (0)

struct XcdBarrier {
    unsigned* bar; unsigned x;
    volatile LAS unsigned* st;
};

__device__ __forceinline__ XcdBarrier xcd_barrier_post(unsigned* bar, volatile LAS unsigned* st) {
    XcdBarrier b; b.bar = bar; b.x = xb_xcc_id(); b.st = st;
    if (threadIdx.x == 0) st[2] = xb_add(&bar[XB_XCNT(b.x)], 1u);
    return b;
}
__device__ __forceinline__ void xcd_barrier_complete(unsigned* bar, unsigned x, unsigned& nloc, unsigned& nx) {
    const unsigned G = gridDim.x * gridDim.y * gridDim.z;
    unsigned sum, cnt, mine, sp = 0u;
    for (;;) {
        sum = 0u; cnt = 0u; mine = 0u;
#pragma unroll
        for (unsigned j = 0; j < 16; ++j) { const unsigned c = xb_ld(&bar[XB_XCNT(j)]); sum += c; cnt += (c > 0u) ? 1u : 0u; mine = (j == x) ? c : mine; }
        if (sum == G) break;
        __builtin_amdgcn_s_sleep(1);
        if ((++sp & 255u) == 0u) { if (xb_ld(&bar[XB_TMO])) break; if (sp > XB_SPIN_CAP) { atomicAdd(&bar[XB_TMO], 1u); break; } }
    }
    nloc = mine > 0u ? mine : 1u; nx = cnt > 0u ? cnt : 1u;
}

__device__ __forceinline__ void xcd_barrier(const XcdBarrier& b) {
    asm volatile("s_waitcnt vmcnt(0)" ::: "memory");
    __syncthreads();
    if (threadIdx.x == 0) {
        unsigned* bar = b.bar;
        __builtin_amdgcn_s_waitcnt(0);
        unsigned nloc = b.st[0], nx = b.st[1];
        if (nloc == 0u) { xcd_barrier_complete(bar, b.x, nloc, nx); b.st[0] = nloc; b.st[1] = nx; }
        const unsigned bidx = b.st[3]; b.st[3] = bidx + 1u;
        const unsigned old = xb_add(&bar[XB_XSUB(b.x)], 1u);
        const unsigned gen = old / nloc;
        if (old + 1u == (gen + 1u) * nloc) {
            __builtin_amdgcn_fence(__ATOMIC_RELEASE, "agent");
            asm volatile("s_waitcnt vmcnt(0)" ::: "memory");
            const unsigned og = xb_add(&bar[XB_TOP], 1u);
            const unsigned tg = og / nx;
            if (og + 1u == (tg + 1u) * nx) xb_add(&bar[XB_TOPGEN], 1u);
            else XB_SPIN(xb_ld(&bar[XB_TOPGEN]) == tg, bar);
            __builtin_amdgcn_fence(__ATOMIC_ACQUIRE, "agent");
            asm volatile("s_waitcnt vmcnt(0)" ::: "memory");
        } else {
            XB_SPIN(xb_ld(&bar[XB_TOPGEN]) == bidx, bar);
            __builtin_amdgcn_fence(__ATOMIC_ACQUIRE, "agent");
            asm volatile("s_waitcnt vmcnt(0)" ::: "memory");
        }
    }
    __syncthreads();
}

__device__ __forceinline__ void xcd_local_barrier(const XcdBarrier& b) {
    asm volatile("s_waitcnt vmcnt(0)" ::: "memory");
    __syncthreads();
    if (threadIdx.x == 0) {
        unsigned* bar = b.bar;
        __builtin_amdgcn_s_waitcnt(0);
        const unsigned nloc = b.st[0];
        const unsigned lidx = b.st[5]; b.st[5] = lidx + 1u;
        (void)xb_add(&bar[XB_XGEN(b.x)], 1u);
        const unsigned want = (lidx + 1u) * nloc;
        XB_SPIN(xb_ld(&bar[XB_XGEN(b.x)]) < want, bar);
        __builtin_amdgcn_fence(__ATOMIC_ACQUIRE, "agent");
        asm volatile("s_waitcnt vmcnt(0)" ::: "memory");
    }
    __syncthreads();
}
#define REP_LOOP(k) REP_LOOP_(REP_P##k)
#define REP_LOOP_(n) REP_LOOP__(n)
#define REP_LOOP__(n) REP_LOOP_##n
#define REP_LOOP_1
#define REP_LOOP_2 _Pragma("unroll 1") for (int rep_ = 0; rep_ < 2; ++rep_)
#define REP_LOOP_3 _Pragma("unroll 1") for (int rep_ = 0; rep_ < 3; ++rep_)
#ifndef REP_P0
#define REP_P0 1
#endif
#ifndef REP_P1
#define REP_P1 1
#endif
#ifndef REP_P2
#define REP_P2 1
#endif
#ifndef REP_P3
#define REP_P3 1
#endif
#ifndef REP_P4
#define REP_P4 1
#endif
#ifndef REP_P5
#define REP_P5 1
#endif
#ifndef REP_P6
#define REP_P6 1
#endif
#ifndef REP_P7
#define REP_P7 1
#endif
#ifndef PH_MASK
#define PH_MASK 0x3ff
#endif
__device__ __forceinline__ float sigm_f(float x) { return __builtin_amdgcn_rcpf(1.0f + __builtin_amdgcn_exp2f(-1.4426950408889634f * x)); }
__device__ __forceinline__ float gelu_tanh(float y) { const float t = 1.5957691216057308f * (y + 0.044715f * y * y * y); return y * sigm_f(t); }
__device__ __forceinline__ int crow16(int r, int hi) { return (r & 3) + 8 * (r >> 2) + 4 * hi; }

template <bool NT> __device__ __forceinline__ void norm_load(const float* X, int v, int wave, int lane, f32x4 (&x)[8][4]) {
#pragma unroll
    for (int i = 0; i < 8; ++i) { const f32x4* xr = (const f32x4*)(X + (size_t)(64 * v + wave + 8 * i) * D) + lane;
#pragma unroll
        for (int j = 0; j < 4; ++j) x[i][j] = NT ? __builtin_nontemporal_load(xr + 64 * j) : xr[64 * j]; }
}
template <int NOUT> __device__ __forceinline__ void norm_apply(const f32x4 (&x)[8][4], int v, int wave, int lane, const LAS float* GS0, const LAS float* SH0, bf16u* O0, const LAS float* GS1, const LAS float* SH1, bf16u* O1) {
    f32x4 gs0[4], sh0[4], gs1[4], sh1[4];
#pragma unroll
    for (int j = 0; j < 4; ++j) { gs0[j] = *(const LAS f32x4*)(GS0 + 256 * j + 4 * lane); sh0[j] = *(const LAS f32x4*)(SH0 + 256 * j + 4 * lane);
        if (NOUT == 2) { gs1[j] = *(const LAS f32x4*)(GS1 + 256 * j + 4 * lane); sh1[j] = *(const LAS f32x4*)(SH1 + 256 * j + 4 * lane); } }
#pragma unroll
    for (int i = 0; i < 8; ++i) { const size_t row = (size_t)(64 * v + wave + 8 * i);
        float s = 0.f;
#pragma unroll
        for (int j = 0; j < 4; ++j) s += (x[i][j].x * x[i][j].x + x[i][j].y * x[i][j].y) + (x[i][j].z * x[i][j].z + x[i][j].w * x[i][j].w);
        const float r = 1.0f / sqrtf(wave_sum(s) * (1.0f / D) + EPS);
        unsigned long long* o0 = (unsigned long long*)(O0 + row * D) + lane;
#pragma unroll
        for (int j = 0; j < 4; ++j) { const f32x4 h = x[i][j] * r * gs0[j] + sh0[j]; o0[64 * j] = (unsigned long long)pk2(h.x, h.y) | ((unsigned long long)pk2(h.z, h.w) << 32); }
        if (NOUT == 2) { unsigned long long* o1 = (unsigned long long*)(O1 + row * D) + lane;
#pragma unroll
            for (int j = 0; j < 4; ++j) { const f32x4 h = x[i][j] * r * gs1[j] + sh1[j]; o1[64 * j] = (unsigned long long)pk2(h.x, h.y) | ((unsigned long long)pk2(h.z, h.w) << 32); } }
    }
}
__device__ __forceinline__ void mod_vectors(const float* MODP, const float* bias, const float* g, int b, int cbase, LAS float* GS, LAS float* SH, int tid) {
    for (int k = tid; k < D; k += NWAVES * 64) { float sh = bias[k], sc = bias[D + k];
#pragma unroll
        for (int ks = 0; ks < 16; ++ks) { const float* p = MODP + (size_t)(ks * 8 + b) * 8192 + cbase + k; sh += p[0]; sc += p[D]; }
        GS[k] = g[k] * (1.0f + sc); SH[k] = sh; }
}

struct S5Stage { float2 pw[3]; float2 bb[2]; float cr[2], ci[2]; };
__device__ __forceinline__ void s5_tables_load(S5Stage& st, int g, int tid, const float2* POWp, const float2* BBTp, const float* Cre, const float* Cim) {
#pragma unroll
    for (int q = 0; q < 3; ++q) { const int e = q * (NWAVES * 64) + tid; st.pw[q] = (e < 64 * 17) ? POWp[(size_t)g * 64 * 17 + e] : make_float2(0.f, 0.f); }
#pragma unroll
    for (int q = 0; q < 2; ++q) { const int e = q * (NWAVES * 64) + tid; st.bb[q] = BBTp[(size_t)g * 64 * 16 + e]; st.cr[q] = Cre[(size_t)g * 1024 + e]; st.ci[q] = Cim[(size_t)g * 1024 + e]; }
}
__device__ __forceinline__ void s5_tables(LAS unsigned char* lds, int g, int qtr, int tid, const S5Stage& st, const float* Dvec, bf16u* T1, bf16u* T2, bf16u* T3) {
    LAS float* Kk = (LAS float*)(lds + 16384);
    typedef float f32x2l __attribute__((ext_vector_type(2)));
    LAS f32x2l* Pw = (LAS f32x2l*)(lds + 32768);
    LAS f32x2l* Bb = (LAS f32x2l*)(lds + 32768 + 8704);
    LAS float* Cr = (LAS float*)(lds + 32768 + 8704 + 8192);
    LAS float* Ci = Cr + 1024;
#pragma unroll
    for (int q = 0; q < 3; ++q) { const int e = q * (NWAVES * 64) + tid; if (e < 64 * 17) Pw[e] = (f32x2l){st.pw[q].x, st.pw[q].y}; }
#pragma unroll
    for (int q = 0; q < 2; ++q) { const int e = q * (NWAVES * 64) + tid; Bb[e] = (f32x2l){st.bb[q].x, st.bb[q].y}; Cr[e] = st.cr[q]; Ci[e] = st.ci[q]; }
    __syncthreads();
    for (int e = qtr * 1024 + tid; e < (qtr + 1) * 1024; e += NWAVES * 64) { const int k = e >> 8, c = (e >> 4) & 15, c2 = e & 15;
        float acc = 0.f;
#pragma unroll 8
        for (int p = 0; p < 64; ++p) { const f32x2l pw = Pw[p * 17 + k], bb = Bb[p * 16 + c2]; const float cr = Cr[c * 64 + p], ci = Ci[c * 64 + p];
            const float zr = pw.x * bb.x - pw.y * bb.y, zi = pw.x * bb.y + pw.y * bb.x; acc += cr * zr - ci * zi; }
        if (k == 0 && c == c2) acc += Dvec[g * 16 + c];
        Kk[e] = acc; }
    __syncthreads();
    for (int vid = tid; vid < 8192; vid += NWAVES * 64) {
        const int ln = vid & 63, nt2 = (vid >> 6) & 7, ks = vid >> 9, n = ln & 31, h = ln >> 5, t = 2 * nt2 + (n >> 4), c = n & 15;
        if (((t >= ks) ? ((t - ks) >> 2) : (ks & 3)) != qtr) continue;
        float vv[8];
#pragma unroll
        for (int jj = 0; jj < 8; ++jj) vv[jj] = (t >= ks) ? Kk[((t - ks) * 16 + c) * 16 + 8 * h + jj] : 0.f;
        v4u o; o.x = pk2(vv[0], vv[1]); o.y = pk2(vv[2], vv[3]); o.z = pk2(vv[4], vv[5]); o.w = pk2(vv[6], vv[7]);
        *(v4u*)(T3 + ((size_t)(g * 128 + (vid >> 6)) * 64 + ln) * 8) = o; }
    for (int vid = qtr * 1024 + tid; vid < (qtr + 1) * 1024; vid += NWAVES * 64) {
        const int ln = vid & 63, nt2 = (vid >> 6) & 7, ks2 = vid >> 9, n = ln & 31, h = ln >> 5, t = 2 * nt2 + (n >> 4), c = n & 15;
        float vv[8];
#pragma unroll
        for (int jj = 0; jj < 8; ++jj) { const int kap = 16 * ks2 + 8 * h + jj, nn = kap >> 2, sub = kap & 3, p = nn + 32 * (sub >> 1);
            const f32x2l pw = Pw[p * 17 + t + 1]; const float cr = Cr[c * 64 + p], ci = Ci[c * 64 + p];
            vv[jj] = (sub & 1) ? -(cr * pw.y + ci * pw.x) : (cr * pw.x - ci * pw.y); }
        v4u o; o.x = pk2(vv[0], vv[1]); o.y = pk2(vv[2], vv[3]); o.z = pk2(vv[4], vv[5]); o.w = pk2(vv[6], vv[7]);
        *(v4u*)(T2 + ((size_t)(g * 64 + (vid >> 6)) * 64 + ln) * 8) = o; }
    for (int vid = qtr * 1024 + tid; vid < (qtr + 1) * 1024; vid += NWAVES * 64) {
        const int ln = vid & 63, nt = (vid >> 6) & 3, r = vid >> 8, n = ln & 31, h = ln >> 5, p = (nt >> 1) * 32 + n;
        const f32x2l pw = Pw[p * 17 + 15 - r];
        float vv[8];
#pragma unroll
        for (int jj = 0; jj < 8; ++jj) { const f32x2l bb = Bb[p * 16 + 8 * h + jj]; vv[jj] = (nt & 1) ? (pw.x * bb.y + pw.y * bb.x) : (pw.x * bb.x - pw.y * bb.y); }
        v4u o; o.x = pk2(vv[0], vv[1]); o.y = pk2(vv[2], vv[3]); o.z = pk2(vv[4], vv[5]); o.w = pk2(vv[6], vv[7]);
        *(v4u*)(T1 + ((size_t)(g * 64 + (vid >> 6)) * 64 + ln) * 8) = o; }
}
__device__ __forceinline__ void s5_mfma(LAS unsigned char* lds, const bf16u* UZp, bf16u* Y1, const float2* POWp, const float2* ALp, const bf16u* T1, const bf16u* T2, const bf16u* T3, int v_, int wave, int lane) {
    const int tid = wave * 64 + lane;
    const int sq = wave >> 2, wq = wave & 3, n = lane & 31, hi = lane >> 5;
    const int b = v_ >> 5, g = (v_ & 31) + 32 * sq, g0 = v_ & 31;
    LAS unsigned char* Sl = lds + wave * 8704;
    LAS f32x4* El = (LAS f32x4*)(lds + 8 * 8704) + sq * 256;
    const int hiA = (n >> 2) & 1, rA = (n & 3) + 4 * (n >> 3);
    const bf16u* ap = UZp + ((size_t)(b * SEQ + (2 * wq + hiA) * 256 + 16 * rA)) * 2048 + g * 16 + 8 * hi;
    bf16x8 af[16];
#pragma unroll
    for (int ks = 0; ks < 16; ++ks) af[ks] = *(const bf16x8*)(ap + (size_t)ks * 2048);
    f32x16 X[4];
    {
#define S1_DMA(nt_, buf_) do { _Pragma("unroll") for (int q_ = 0; q_ < 4; ++q_) { const int cb_ = q_ * 512 + wave * 64, c_ = cb_ + lane, gq_ = g0 + 32 * (c_ >> 10), w_ = c_ & 1023; \
          __builtin_amdgcn_global_load_lds((const unsigned*)(T1 + ((size_t)((gq_ * 16 + (w_ >> 6)) * 4 + (nt_)) * 64 + (w_ & 63)) * 8), (LAS unsigned*)(lds + (buf_) * 32768 + cb_ * 16), 16, 0, 0); } } while (0)
      S1_DMA(0, 0); asm volatile("s_waitcnt vmcnt(0)" ::: "memory"); __syncthreads();
#pragma unroll
      for (int nt = 0; nt < 4; ++nt) {
          if (nt < 3) S1_DMA(nt + 1, (nt + 1) & 1);
          f32x16 z = {}; X[nt] = z;
#pragma unroll
          for (int ks = 0; ks < 16; ++ks) X[nt] = __builtin_amdgcn_mfma_f32_32x32x16_bf16(af[ks], *(const LAS bf16x8*)(lds + (nt & 1) * 32768 + sq * 16384 + ks * 1024 + lane * 16), X[nt], 0, 0, 0);
          asm volatile("s_waitcnt vmcnt(0)" ::: "memory");
          __syncthreads(); }
#undef S1_DMA
    }
    const float2 a0 = POWp[(g * 64 + n) * 17 + 16], a1 = POWp[(g * 64 + 32 + n) * 17 + 16];
    { float s0r = 0.f, s0i = 0.f, s1r = 0.f, s1i = 0.f;
#pragma unroll
      for (int r = 0; r < 16; ++r) { const float n0r = a0.x * s0r - a0.y * s0i + X[0][r], n0i = a0.x * s0i + a0.y * s0r + X[1][r]; s0r = n0r; s0i = n0i;
          const float n1r = a1.x * s1r - a1.y * s1i + X[2][r], n1i = a1.x * s1i + a1.y * s1r + X[3][r]; s1r = n1r; s1i = n1i; }
      El[(2 * wq + hi) * 32 + n] = (f32x4){s0r, s0i, s1r, s1i}; }
    __syncthreads();
    if (wq == 0 && lane < 32) { const float2 l0 = ALp[g * 64 + n], l1 = ALp[g * 64 + 32 + n]; f32x4 S = {0.f, 0.f, 0.f, 0.f};
#pragma unroll
        for (int k = 0; k < 8; ++k) { const f32x4 e = El[k * 32 + n]; El[k * 32 + n] = S;
            S = (f32x4){l0.x * S[0] - l0.y * S[1] + e[0], l0.x * S[1] + l0.y * S[0] + e[1], l1.x * S[2] - l1.y * S[3] + e[2], l1.x * S[3] + l1.y * S[2] + e[3]}; } }
    __syncthreads();
    { const f32x4 st = El[(2 * wq + hi) * 32 + n]; float s0r = st[0], s0i = st[1], s1r = st[2], s1i = st[3];
      typedef unsigned u32x2s __attribute__((ext_vector_type(2)));
#pragma unroll
      for (int r = 0; r < 16; ++r) { *(LAS u32x2s*)(Sl + crow16(r, hi) * 272 + 8 * n) = (u32x2s){pg8::cvt_pk_bf16(s0r, s0i), pg8::cvt_pk_bf16(s1r, s1i)};
          const float n0r = a0.x * s0r - a0.y * s0i + X[0][r], n0i = a0.x * s0i + a0.y * s0r + X[1][r]; s0r = n0r; s0i = n0i;
          const float n1r = a1.x * s1r - a1.y * s1i + X[2][r], n1i = a1.x * s1i + a1.y * s1r + X[3][r]; s1r = n1r; s1i = n1i; } }
    LDS_WAIT();
    bf16x8 sf[8];
#pragma unroll
    for (int ks2 = 0; ks2 < 8; ++ks2) sf[ks2] = *(const LAS bf16x8*)(Sl + n * 272 + (16 * ks2 + 8 * hi) * 2);
    LDS_WAIT();
    __syncthreads();
    {
#define S3_DMA(nt2_, buf_) do { _Pragma("unroll") for (int q_ = 0; q_ < 6; ++q_) { const int cb_ = q_ * 512 + wave * 64, c_ = cb_ + lane, sqs_ = (c_ >= 1536) ? 1 : 0, w_ = c_ - 1536 * sqs_, gq_ = g0 + 32 * sqs_; \
          const bf16u* src_ = (w_ < 1024) ? T3 + ((size_t)((gq_ * 16 + (w_ >> 6)) * 8 + (nt2_)) * 64 + (w_ & 63)) * 8 : T2 + ((size_t)((gq_ * 8 + ((w_ - 1024) >> 6)) * 8 + (nt2_)) * 64 + (w_ & 63)) * 8; \
          __builtin_amdgcn_global_load_lds((const unsigned*)src_, (LAS unsigned*)(lds + (buf_) * 49152 + cb_ * 16), 16, 0, 0); } } while (0)
      S3_DMA(0, 0); asm volatile("s_waitcnt vmcnt(0)" ::: "memory"); __syncthreads();
#pragma unroll 1
      for (int nt2 = 0; nt2 < 8; ++nt2) {
          if (nt2 < 7) S3_DMA(nt2 + 1, (nt2 + 1) & 1);
          LAS unsigned char* tb = lds + (nt2 & 1) * 49152 + sq * 24576 + lane * 16;
          f32x16 Y = {};
#pragma unroll
          for (int ks = 0; ks < 16; ++ks) Y = __builtin_amdgcn_mfma_f32_32x32x16_bf16(*(const LAS bf16x8*)(tb + ks * 1024), af[ks], Y, 0, 0, 0);
#pragma unroll
          for (int ks2 = 0; ks2 < 8; ++ks2) Y = __builtin_amdgcn_mfma_f32_32x32x16_bf16(*(const LAS bf16x8*)(tb + 16384 + ks2 * 1024), sf[ks2], Y, 0, 0, 0);
          asm volatile("s_waitcnt vmcnt(0)" :: "v"(Y) : "memory");
          unsigned yoff = (unsigned)(((b * SEQ + (2 * wq + hiA) * 256 + 16 * rA + 2 * nt2) * D + g * 16 + 8 * hi) * 2);
          asm volatile("" : "+v"(yoff));
#pragma unroll
          for (int tt = 0; tt < 2; ++tt) {
              unsigned ax = pg8::cvt_pk_bf16(gelu_tanh(Y[8 * tt + 0]), gelu_tanh(Y[8 * tt + 1])), ay = pg8::cvt_pk_bf16(gelu_tanh(Y[8 * tt + 2]), gelu_tanh(Y[8 * tt + 3]));
              unsigned bx = pg8::cvt_pk_bf16(gelu_tanh(Y[8 * tt + 4]), gelu_tanh(Y[8 * tt + 5])), by = pg8::cvt_pk_bf16(gelu_tanh(Y[8 * tt + 6]), gelu_tanh(Y[8 * tt + 7]));
              { auto r_ = __builtin_amdgcn_permlane32_swap(ax, bx, false, false); ax = r_[0]; bx = r_[1]; }
              { auto r_ = __builtin_amdgcn_permlane32_swap(ay, by, false, false); ay = r_[0]; by = r_[1]; }
              v4u o; o.x = ax; o.y = ay; o.z = bx; o.w = by;
              *(v4u*)((char*)Y1 + (yoff + (unsigned)(tt * D * 2))) = o; }
          __syncthreads(); }
#undef S3_DMA
    }
}


#define W_IN_A ((bf16u*)(GAS bf16u*)(ws + WS_W_IN_A))
#define W_GLU ((bf16u*)(GAS bf16u*)(ws + WS_W_GLU))
#define W_OUT_A ((bf16u*)(GAS bf16u*)(ws + WS_W_OUT_A))
#define W_KV ((bf16u*)(GAS bf16u*)(ws + WS_W_KV))
#define W_IN_B ((bf16u*)(GAS bf16u*)(ws + WS_W_IN_B))
#define W_OUT_B ((bf16u*)(GAS bf16u*)(ws + WS_W_OUT_B))
#define W_F ((bf16u*)(GAS bf16u*)(ws + WS_W_F))
#define MODP ((float*)(GAS float*)(ws + WS_MODP))
#define GATE ((float*)(GAS float*)(ws + WS_GATE))
#define ABAR ((float2*)(GAS float2*)(ws + WS_ABAR))
#define AL ((float2*)(GAS float2*)(ws + WS_AL))
#define BFRAG ((bf16u*)(GAS bf16u*)(ws + WS_BFRAG))
#define CFRAG ((bf16u*)(GAS bf16u*)(ws + WS_CFRAG))
#define E ((float4*)(GAS float4*)(ws + WS_E))
#define UZ ((bf16u*)(GAS bf16u*)(ws + WS_UZ))
#define KB ((bf16u*)(GAS bf16u*)(ws + WS_K))
#define VB ((bf16u*)(GAS bf16u*)(ws + WS_V))
#define R2 ((bf16u*)(GAS bf16u*)(ws + WS_R2))
#define R3 ((bf16u*)(GAS bf16u*)(ws + WS_R3))
#define QO ((bf16u*)(GAS bf16u*)(ws + WS_QO))
#define SZ ((bf16u*)(GAS bf16u*)(ws + WS_SZ))
#define LF ((float*)(GAS float*)(ws + WS_LF))
#define GSV ((float*)(GAS float*)(ws + WS_GSV))
#define POWT ((float2*)(GAS float2*)(ws + WS_POW))
#define BBT ((float2*)(GAS float2*)(ws + WS_BBT))
#define TB1 ((bf16u*)(GAS bf16u*)(ws + WS_T1))
#define TB2 ((bf16u*)(GAS bf16u*)(ws + WS_T2))
#define TB3 ((bf16u*)(GAS bf16u*)(ws + WS_T3))
__device__ __forceinline__ const float* arg_in(const Args& a, int k) { asm volatile("" : "+s"(k)); return (const float*)(const GAS float*)a.in[k]; }
#define AIN(k) arg_in(args, (k))
#define PHASE_WS GAS unsigned char* ws = (GAS unsigned char*)args.ws; asm volatile("" : "+s"(ws))

#ifdef PROBE_PH
#define TSTAMP(i) do { if ((i) == PROBE_PH) ts0_ = __builtin_amdgcn_s_memrealtime(); if ((i) == PROBE_PH + 1) ts1_ = __builtin_amdgcn_s_memrealtime(); } while (0)
#define TSPIN() do { if (blockIdx.x == 0) { const unsigned long long tgt_ = __builtin_amdgcn_s_memrealtime() + 4ull * (ts1_ - ts0_); while (__builtin_amdgcn_s_memrealtime() < tgt_) __builtin_amdgcn_s_sleep(8); } } while (0)
#else
#define TSTAMP(i) do {} while (0)
#define TSPIN() do {} while (0)
#endif
__global__ void __launch_bounds__(NWAVES * 64, 2) fwd_mega(Args args) {
#ifdef PROBE_PH
    unsigned long long ts0_ = 0, ts1_ = 0;
#endif
    extern __shared__ __attribute__((aligned(16))) unsigned char lds_raw[];
    cg::grid_group grid = cg::this_grid();
    TSTAMP(0);
    LAS unsigned char* lds = (LAS unsigned char*)lds_raw;
    const int tid = threadIdx.x, lane = tid & 63, wave = __builtin_amdgcn_readfirstlane(tid >> 6);
    const int G = gridDim.x, bx = blockIdx.x;
    int vcu = (G % 8 == 0) ? (bx % 8) * (G / 8) + bx / 8 : bx;
    int gw = vcu * NWAVES + wave; const int NGW = G * NWAVES; int cid = bx;
    int xmap = 0, xrank_ = 0, xcc_ = 0;
    float* const out = args.out;
    volatile LAS unsigned* MISC = (volatile LAS unsigned*)(lds + 131072 + 320);
    if (tid < 32) MISC[tid] = 0u;
    __syncthreads();
    XcdBarrier bar = xcd_barrier_post((unsigned*)(args.ws + WS_CTL), MISC + 8);
    if (args.ws == nullptr) grid.sync();
#define GRID_BAR() xcd_barrier(bar)
#define LOCAL_BAR() do { if (xmap) xcd_local_barrier(bar); else xcd_barrier(bar); } while (0)

#if (PH_MASK >> 0) & 1
    REP_LOOP(0) {
    PHASE_WS;
    {
        const float* cndp = AIN(1);
        LAS float* SC = (LAS float*)(lds + 73728);
        for (int idx = tid; idx < 8 * D; idx += NWAVES * 64) { const int b = idx >> 10, k = idx & 1023; const float cv = cndp[idx]; SC[k * 8 + b] = cv * sigm_f(cv); }
        __syncthreads();
        LAS float* scr = (LAS float*)(lds + wave * 8704);
        constexpr int I_2048 = (D / 64) * (2048 / 32), I_1024 = (D / 64) * (1024 / 32);
        constexpr int NT_ITEMS = 3 * I_2048 + 3 * I_1024, NITEMS = NT_ITEMS + 2048;
        for (int it = gw; it < NITEMS; it += NGW) {
            int r = it;
            if (r < NT_ITEMS) {
                if (r < I_2048) { p0_transpose_item(AIN(5), 2048, D, 2048, W_IN_A, scr, r, lane); continue; } r -= I_2048;
                if (r < I_2048) { p0_transpose_item(AIN(20), 2064, D, 2048, W_KV, scr, r, lane); continue; } r -= I_2048;
                if (r < I_2048) { p0_transpose_item(AIN(26), 2048, D, 2048, W_IN_B, scr, r, lane); continue; } r -= I_2048;
                if (r < I_1024) { p0_transpose_item(AIN(14), 1024, D, 1024, W_GLU, scr, r, lane); continue; } r -= I_1024;
                if (r < I_1024) { p0_transpose_item(AIN(16), 1024, D, 1024, W_OUT_A, scr, r, lane); continue; } r -= I_1024;
                p0_transpose_item(AIN(28), 1024, D, 1024, W_OUT_B, scr, r, lane); continue;
            }
            r -= NT_ITEMS;
            const int col = (r >> 4) * 64 + lane, ks = r & 15;
            const float* W; int ldw, cc;
            if (col < 3072) { W = AIN(3); ldw = 3072; cc = col; } else if (col < 5120) { W = AIN(18); ldw = 2048; cc = col - 3072; } else { W = AIN(24); ldw = 3072; cc = col - 5120; }
            float acc8[8] = {0.f, 0.f, 0.f, 0.f, 0.f, 0.f, 0.f, 0.f};
            const float* wp = W + (size_t)(ks * 64) * ldw + cc;
#pragma unroll 32
            for (int k = 0; k < 64; ++k) { const float w = __builtin_nontemporal_load(wp + (size_t)k * ldw);
                const f32x4 s0 = *(const LAS f32x4*)(SC + (ks * 64 + k) * 8), s1 = *(const LAS f32x4*)(SC + (ks * 64 + k) * 8 + 4);
                acc8[0] += s0.x * w; acc8[1] += s0.y * w; acc8[2] += s0.z * w; acc8[3] += s0.w * w; acc8[4] += s1.x * w; acc8[5] += s1.y * w; acc8[6] += s1.z * w; acc8[7] += s1.w * w; }
#pragma unroll
            for (int b = 0; b < 8; ++b) MODP[(size_t)(ks * 8 + b) * 8192 + col] = acc8[b];
        }
        const int gtid = vcu * (NWAVES * 64) + tid, NGT = G * NWAVES * 64;
        for (int idx = gtid; idx < 16 * D; idx += NGT) { const int jf = idx >> 10, k = idx & 1023; W_F[idx] = (bf16u)f2bf(AIN(20)[(size_t)k * 2064 + 2048 + jf]); }
        for (int it = vcu * 256 + tid; tid < 256 && it < NG * NST * 16; it += G * 256) {
            const int idx = it >> 4, ch = it & 15, g = idx >> 6, p = idx & 63;
            const double dt = exp((double)AIN(6)[g]), ar = (double)AIN(7)[idx], ai = (double)AIN(8)[idx];
            const double mag = exp(ar * dt); double sn, cs; sincos_d(ai * dt, sn, cs);
            const double abr = mag * cs, abi = mag * sn, den = ar * ar + ai * ai, nr = abr - 1.0;
            const double cr = (nr * ar + abi * ai) / den, ci = (abi * ar - nr * ai) / den;
            if (ch == 0) { ABAR[idx] = make_float2((float)abr, (float)abi);
                double pr = 1.0, pi = 0.0;
#pragma unroll 1
                for (int k = 0; k <= 16; ++k) { POWT[(size_t)idx * 17 + k] = make_float2((float)pr, (float)pi); const double t = pr * abr - pi * abi; pi = pr * abi + pi * abr; pr = t; }
                pr = abr; pi = abi;
#pragma unroll
                for (int q = 0; q < 8; ++q) { const double t = pr * pr - pi * pi; pi = 2.0 * pr * pi; pr = t; }
                AL[idx] = make_float2((float)pr, (float)pi); }
            { const double br = AIN(9)[(size_t)idx * 16 + ch], bi = AIN(10)[(size_t)idx * 16 + ch]; const double bbr = cr * br - ci * bi, bbi = cr * bi + ci * br;
              BBT[(size_t)idx * 16 + ch] = make_float2((float)bbr, (float)bbi); }
        }
    }
#endif
    GRID_BAR();
    TSTAMP(1);
    }
    {
        if (tid == 0) { unsigned ok = (G % 8 == 0) ? 1u : 0u;
            for (unsigned jx = 0; jx < 16; ++jx) { const unsigned c = xb_ld(&bar.bar[XB_XCNT(jx)]); ok &= (jx < 8 ? (c == (unsigned)(G / 8)) : (c == 0u)) ? 1u : 0u; }
            MISC[12] = ok; }
        __syncthreads();
        const int okm = __builtin_amdgcn_readfirstlane((int)MISC[12]), xrank = __builtin_amdgcn_readfirstlane((int)MISC[10]), xcc = (int)bar.x;
        if (okm && G == 256) { cid = xrank * 8 + xcc; vcu = xcc * (G / 8) + xrank; gw = vcu * NWAVES + wave; xmap = 1; xrank_ = xrank; xcc_ = xcc; }
    }

#if (PH_MASK >> 1) & 1
    REP_LOOP(1) {
    PHASE_WS;
    {
        if (tid < 64) { const int idx = xmap ? ((((xrank_ * 64 + tid) >> 10) << 13) | (xcc_ << 10) | ((xrank_ * 64 + tid) & 1023)) : vcu * 64 + tid;
            if (idx < 2 * 8 * D) { const int which = idx >> 13, b = (idx >> 10) & 7, n = idx & 1023;
                const int col = which == 0 ? 2048 + n : 5120 + 2048 + n; float s = which == 0 ? AIN(4)[2048 + n] : AIN(25)[2048 + n];
#pragma unroll
                for (int ks = 0; ks < 16; ++ks) s += MODP[(size_t)(ks * 8 + b) * 8192 + col];
                GATE[idx] = s; } }
        if (tid >= 64 && tid < 192) { const int idx = vcu * 128 + (tid - 64), b = idx >> 12, vec = (idx >> 10) & 3, k = idx & 1023;
            const float* bias = (vec < 2) ? AIN(19) : AIN(25); const int cbase = (vec < 2) ? 3072 : 5120, off = (vec & 1) ? 0 : D;
            float sacc = bias[off + k];
#pragma unroll
            for (int ks = 0; ks < 16; ++ks) sacc += MODP[(size_t)(ks * 8 + b) * 8192 + cbase + off + k];
            GSV[idx] = (vec & 1) ? sacc : ((vec == 0) ? AIN(17)[k] : AIN(23)[k]) * (1.0f + sacc); }
        LAS float* GS = (LAS float*)lds; LAS float* SH = GS + D;
        for (int v = vcu; v < 256; v += G) {
            S5Stage stg; s5_tables_load(stg, v >> 2, tid, POWT, BBT, AIN(11), AIN(12));
            f32x4 xr[8][4]; norm_load<true>(AIN(0), v, wave, lane, xr);
            __syncthreads();
            s5_tables(lds, v >> 2, v & 3, tid, stg, AIN(13), TB1, TB2, TB3);
            mod_vectors(MODP, AIN(4), AIN(2), v >> 5, 0, GS, SH, tid);
            __syncthreads();
            norm_apply<1>(xr, v, wave, lane, GS, SH, R2, GS, SH, R2);
        }
    }
#endif
    GRID_BAR();
    TSTAMP(2);
    }

#if (PH_MASK >> 2) & 1
    REP_LOOP(2) {
    PHASE_WS;
    { pg8::Gemm g{R2, W_IN_A, M, 2048, D}; pg8::StaticOrder S; S.init(M, 2048, G, cid); pg8::EpiStore Ep{UZ, 2048};
      pg8::gemm_phase<pg8::EpiStore, pg8::StaticOrder, true, true>(lds, g, S, Ep); }
#endif
    LOCAL_BAR();
    TSTAMP(3);
    }

#if (PH_MASK >> 3) & 1
    REP_LOOP(3) {
    PHASE_WS;
    for (int v_ = vcu; v_ < 256; v_ += G) { __syncthreads(); s5_mfma(lds, UZ, R2, POWT, AL, TB1, TB2, TB3, v_, wave, lane); }
#endif
    LOCAL_BAR();
    TSTAMP(4);
    }

#if (PH_MASK >> 4) & 1
    REP_LOOP(4) {
    PHASE_WS;
    { pg8::Gemm g{R2, W_GLU, M, 1024, D}; pg8::StaticOrder S; S.init(M, 1024, G, cid); pg8::EpiGlu Ep{R2, UZ + 1024, AIN(15), R3};
      pg8::gemm_phase<pg8::EpiGlu, pg8::StaticOrder, true, true>(lds, g, S, Ep); }
#endif
    LOCAL_BAR();
    TSTAMP(5);
    }

#if (PH_MASK >> 5) & 1
    REP_LOOP(5) {
    PHASE_WS;
    { pg8::Gemm g{R3, W_OUT_A, M, 1024, D}; pg8::StaticOrder S; S.init(M, 1024, G, cid); pg8::EpiRes Ep{AIN(0), GATE, out};
      pg8::gemm_phase<pg8::EpiRes, pg8::StaticOrder, true, true>(lds, g, S, Ep); }
#endif
    LOCAL_BAR();
    TSTAMP(6);
    }

#if (PH_MASK >> 6) & 1
    REP_LOOP(6) {
    PHASE_WS;
    {
        LAS float* GS0 = (LAS float*)lds; LAS float* SH0 = GS0 + D; LAS float* GS1 = SH0 + D; LAS float* SH1 = GS1 + D;
        for (int v = vcu; v < M / 64; v += G) {
            __syncthreads();
            { const f32x4* gsrc = (const f32x4*)(GSV + (size_t)(v >> 5) * 4096);
              LAS f32x4* gdst = (LAS f32x4*)GS0; gdst[tid] = gsrc[tid]; gdst[tid + 512] = gsrc[tid + 512]; }
            __syncthreads();
            { f32x4 xr[8][4]; norm_load<false>(out, v, wave, lane, xr); norm_apply<2>(xr, v, wave, lane, GS0, SH0, R2, GS1, SH1, R3); }
        }
    }
#endif
    LOCAL_BAR();
    TSTAMP(7);
    }

#if (PH_MASK >> 7) & 1
    REP_LOOP(7) {
    PHASE_WS;
    {
        for (int v_ = vcu; v_ < M / 64; v_ += G) { const int t = 4 * v_ + (wave & 3), kh = wave >> 2;
            f32x4 acc = {0.f, 0.f, 0.f, 0.f};
            const bf16u* ap = R2 + (size_t)(16 * t + (lane & 15)) * D + 512 * kh + 8 * (lane >> 4); const bf16u* bp = W_F + (size_t)(lane & 15) * D + 512 * kh + 8 * (lane >> 4);
#pragma unroll
            for (int ks = 0; ks < 16; ++ks) acc = __builtin_amdgcn_mfma_f32_16x16x32_bf16(*(const bf16x8*)(ap + ks * 32), *(const bf16x8*)(bp + ks * 32), acc, 0, 0, 0);
            LAS f32x4* part = (LAS f32x4*)lds + (wave & 3) * 64 + lane;
            __syncthreads();
            if (kh == 1) *part = acc;
            __syncthreads();
            if (kh == 0) { acc += *part;
                const float fb = AIN(21)[lane & 15];
                f32x4 ls4;
#pragma unroll
                for (int r = 0; r < 4; ++r) { const float xl = acc[r] + fb; ls4[r] = fminf(xl, 0.f) - log1pf(__expf(-fabsf(xl))); }
                const int row = 16 * t + 4 * (lane >> 4), bq = row >> 11, tq = row & 2047;
                *(f32x4*)(LF + ((size_t)(bq * NH + (lane & 15)) * SEQ + tq)) = ls4; }
        }
        { pg8::Gemm g{R2, W_KV, M, 2048, D}; pg8::StaticOrder S; S.init(M, 2048, G, cid); pg8::EpiHeadNorm<false> Ep{KB, VB, AIN(22), 1.0f};
          pg8::gemm_phase<pg8::EpiHeadNorm<false>, pg8::StaticOrder, true, true>(lds, g, S, Ep); }
        { pg8::Gemm g{R3, W_IN_B, M, 2048, D}; pg8::StaticOrder S; S.init(M, 2048, G, cid); pg8::EpiHeadNorm<true> Ep{QO, SZ, AIN(27), C2};
          pg8::gemm_phase<pg8::EpiHeadNorm<true>, pg8::StaticOrder, true, true>(lds, g, S, Ep); }
    }
#endif
    LOCAL_BAR();
    TSTAMP(8);
    }

#if (PH_MASK >> 8) & 1
    { PHASE_WS; const attn_body::AttnTensors AT{(const attn_body::bf16*)QO, (const attn_body::bf16*)KB, (const attn_body::bf16*)VB, (attn_body::bf16*)QO, (const attn_body::bf16*)SZ, LF, AIN(27), AIN(22)};
      attn_body::attn_phase<60>((char*)lds_raw, AT, vcu, G); }
#endif
    LOCAL_BAR();
    TSTAMP(9);

#if (PH_MASK >> 9) & 1
    { PHASE_WS; pg8::Gemm g{QO, W_OUT_B, M, 1024, D}; pg8::StaticOrder S; S.init(M, 1024, G, cid); pg8::EpiResT<true> Ep{out, GATE + 8 * D, out};
      pg8::gemm_phase<pg8::EpiResT<true>, pg8::StaticOrder, true, true>(lds, g, S, Ep); }
#endif
    TSTAMP(10);
    TSPIN();
}

extern "C" void kernel_launch(void* const* d_in, const int* in_sizes, int n_in, void* d_out, int out_size, void* d_ws, size_t ws_size, hipStream_t stream) {
    static int grid = 0;
    if (grid == 0) {
        if (n_in != 29 || out_size != M * D || ws_size < WS_END) { fprintf(stderr, "kernel_launch: unexpected problem (n_in %d out %d ws %zu)\n", n_in, out_size, ws_size); grid = -1; return; }
        int dev = 0, cus = 0, per_cu = 0;
        (void)hipGetDevice(&dev); (void)hipDeviceGetAttribute(&cus, hipDeviceAttributeMultiprocessorCount, dev);
        if (hipFuncSetAttribute((const void*)fwd_mega, hipFuncAttributeMaxDynamicSharedMemorySize, LDS_BYTES) != hipSuccess) { fprintf(stderr, "kernel_launch: hipFuncSetAttribute failed\n"); grid = -1; return; }
        if (hipOccupancyMaxActiveBlocksPerMultiprocessor(&per_cu, (const void*)fwd_mega, NWAVES * 64, LDS_BYTES) != hipSuccess || per_cu < 1) { fprintf(stderr, "kernel_launch: occupancy query says %d\n", per_cu); per_cu = 1; }
        (void)hipGetLastError();
        grid = cus > 0 ? cus : 256;
    }
    if (grid < 0) return;
    if (hipMemsetAsync((char*)d_ws + WS_CTL, 0, CTL_ZERO_BYTES, stream) != hipSuccess) { fprintf(stderr, "kernel_launch: memset failed\n"); return; }
    Args a{};
    for (int i = 0; i < 29; ++i) a.in[i] = (const float*)d_in[i];
    a.out = (float*)d_out; a.ws = (unsigned char*)d_ws;
    void* kargs[] = {&a};
    const hipError_t e = hipLaunchCooperativeKernel((const void*)fwd_mega, dim3(grid), dim3(NWAVES * 64), kargs, LDS_BYTES, stream);
    if (e != hipSuccess) fprintf(stderr, "cooperative launch failed: %s (grid %d)\n", hipGetErrorString(e), grid);
}
```
